# Optimizing an MI355X kernel written in HIP

```python
import math
import jax, jax.numpy as jnp
from jax import lax
import numpy as np

D_MODEL = 4096
BATCH = 2
SEQ = 4096
DEPTH = 2

HEAD_DIM = 128
N_HEADS = D_MODEL // HEAD_DIM
N_HEADS_DIL = N_HEADS // 2
N_HEADS_DIFF = N_HEADS - N_HEADS_DIL
DIFF_QK_DIM = HEAD_DIM // 2
DIL_WIDTH = N_HEADS_DIL * HEAD_DIM
DIFF_WIDTH = N_HEADS_DIFF * HEAD_DIM
MIX_WIDTH = DIL_WIDTH + DIFF_WIDTH
IN_PROJ_WIDTH = 3 * DIL_WIDTH + 3 * DIFF_WIDTH
DILATED_CONFIGS = ((128, 1), (512, 4), (2048, 16))
D_FF = 4 * D_MODEL
NUM_BUCKETS = 32
MAX_DISTANCE = 1024
QUERY_BLOCK = 128
RMS_EPS = 1e-6
SUBLN_EPS = 1e-5
NEG_INF = -1e30

kernel_name = "hybrid_dilated_diff_attn_encoder"


def rmsnorm(x, g, eps=RMS_EPS):
    xf = x.astype(jnp.float32)
    y = xf * lax.rsqrt(jnp.mean(xf * xf, axis=-1, keepdims=True) + eps)
    return (y * g.astype(jnp.float32)).astype(x.dtype)


def t5_bucket(rel):
    half = NUM_BUCKETS // 2
    max_exact = half // 2
    ret = jnp.where(rel > 0, half, 0)
    n = jnp.abs(rel)
    nf = jnp.maximum(n, 1).astype(jnp.float32)
    large = max_exact + (jnp.log(nf / max_exact) / math.log(MAX_DISTANCE / max_exact)
                         * (half - max_exact)).astype(jnp.int32)
    large = jnp.minimum(large, half - 1)
    return ret + jnp.where(n < max_exact, n, large)


def dilated_branch(q, k, v, table, window, dil):
    Bsz, H, S, hd = q.shape
    radius = window // (2 * dil)
    blk = radius
    n_sub = -(-S // dil)
    L = -(-n_sub // blk) * blk
    S_pad = L * dil
    nb = L // blk

    def to_sub(z):
        z = jnp.pad(z, ((0, 0), (0, 0), (0, S_pad - S), (0, 0)))
        return z.reshape(Bsz, H, L, dil, z.shape[-1]).transpose(0, 1, 3, 2, 4)

    def key_windows(z):
        zs = to_sub(z)
        zs = jnp.pad(zs, ((0, 0), (0, 0), (0, 0), (blk, blk), (0, 0)))
        zs = zs.reshape(Bsz, H, dil, nb + 2, blk, zs.shape[-1])
        return jnp.concatenate([zs[:, :, :, :-2], zs[:, :, :, 1:-1], zs[:, :, :, 2:]], axis=4)

    qs = to_sub(q).reshape(Bsz, H, dil, nb, blk, hd)
    ks = key_windows(k)
    vs = key_windows(v)

    valid = (jnp.arange(S_pad) < S).reshape(L, dil).T
    valid = jnp.pad(valid, ((0, 0), (blk, blk))).reshape(dil, nb + 2, blk)
    valid = jnp.concatenate([valid[:, :-2], valid[:, 1:-1], valid[:, 2:]], axis=2)

    off = jnp.arange(3 * blk)[None, :] - blk - jnp.arange(blk)[:, None]
    band = jnp.abs(off) <= radius
    bias = table[t5_bucket(off * dil)].astype(jnp.float32).transpose(2, 0, 1)

    s = jnp.einsum('bhrnqd,bhrnkd->bhrnqk', qs, ks).astype(jnp.float32)
    s = s + bias[None, :, None, None]
    mask = band[None, None, None, None] & valid[None, None, :, :, None, :]
    s = jnp.where(mask, s, NEG_INF)
    m = jnp.max(s, axis=-1, keepdims=True)
    p = jnp.exp(s - m)
    l = jnp.sum(p, axis=-1, keepdims=True)
    n = jnp.einsum('bhrnqk,bhrnkd->bhrnqd', p, vs.astype(jnp.float32))

    def from_sub(z):
        c = z.shape[-1]
        z = z.reshape(Bsz, H, dil, L, c).transpose(0, 1, 3, 2, 4).reshape(Bsz, H, S_pad, c)
        return z[:, :, :S]

    return from_sub(m), from_sub(l), from_sub(n)


def dilated_attention(q, k, v, table):
    outs = [dilated_branch(q, k, v, table, w, d) for (w, d) in DILATED_CONFIGS]
    m_all = outs[0][0]
    for m, _, _ in outs[1:]:
        m_all = jnp.maximum(m_all, m)
    num = 0.0
    den = 0.0
    for m, l, n in outs:
        scale = jnp.exp(m - m_all)
        num = num + scale * n
        den = den + scale * l
    return num / den


def diff_attention(q, k, v, table, lam):
    Bsz, H, _, S, dq = q.shape
    nq = S // QUERY_BLOCK
    qb = q.reshape(Bsz, H, 2, nq, QUERY_BLOCK, dq).transpose(3, 0, 1, 2, 4, 5)
    vf = v.astype(jnp.float32)
    kpos = jnp.arange(S)

    def body(args):
        qblk, bi = args
        s = jnp.einsum('bhmqd,bhmkd->bhmqk', qblk, k).astype(jnp.float32)
        qpos = bi * QUERY_BLOCK + jnp.arange(QUERY_BLOCK)
        bias = table[t5_bucket(kpos[None, :] - qpos[:, None])].astype(jnp.float32)
        s = s + bias.transpose(2, 0, 1)[None, :, None]
        p = jax.nn.softmax(s, axis=-1)
        a = p[:, :, 0] - lam * p[:, :, 1]
        return jnp.einsum('bhqk,bhkd->bhqd', a, vf)

    o = lax.map(body, (qb, jnp.arange(nq)))
    return o.transpose(1, 0, 3, 2, 4).reshape(Bsz, S, H, 2 * dq)


def setup_inputs(seed: int = 0) -> dict:
    key = jax.random.key(seed)
    ks = jax.random.split(key, 16)
    f32 = jnp.float32
    nrm = lambda k, shape, s: jax.random.normal(k, shape, f32) * s
    gain = lambda k, shape: 1.0 + 0.05 * jax.random.normal(k, shape, f32)
    return {
        "x": jax.random.normal(ks[0], (BATCH, SEQ, D_MODEL), f32),
        "rel_bias": nrm(ks[1], (NUM_BUCKETS, N_HEADS_DIL + N_HEADS_DIFF), 0.3),
        "g_pre_mix": gain(ks[2], (DEPTH, D_MODEL)),
        "w_in": nrm(ks[3], (DEPTH, D_MODEL, IN_PROJ_WIDTH), D_MODEL ** -0.5),
        "lambda_q1": nrm(ks[4], (DEPTH, DIFF_QK_DIM), 0.1),
        "lambda_k1": nrm(ks[5], (DEPTH, DIFF_QK_DIM), 0.1),
        "lambda_q2": nrm(ks[6], (DEPTH, DIFF_QK_DIM), 0.1),
        "lambda_k2": nrm(ks[7], (DEPTH, DIFF_QK_DIM), 0.1),
        "g_subln": gain(ks[8], (DEPTH, 2 * DIFF_QK_DIM)),
        "w_out": nrm(ks[9], (DEPTH, MIX_WIDTH, D_MODEL), MIX_WIDTH ** -0.5),
        "g_post_mix": gain(ks[10], (DEPTH, D_MODEL)),
        "g_pre_mlp": gain(ks[11], (DEPTH, D_MODEL)),
        "w_up": nrm(ks[12], (DEPTH, D_MODEL, D_FF), D_MODEL ** -0.5),
        "w_down": nrm(ks[13], (DEPTH, D_FF, D_MODEL), D_FF ** -0.5),
        "g_post_mlp": gain(ks[14], (DEPTH, D_MODEL)),
    }


def reference(x, rel_bias, g_pre_mix, w_in, lambda_q1, lambda_k1, lambda_q2, lambda_k2,
              g_subln, w_out, g_post_mix, g_pre_mlp, w_up, w_down, g_post_mlp):
    Bsz, S, _ = x.shape
    table_dil = rel_bias[:, :N_HEADS_DIL]
    table_diff = rel_bias[:, N_HEADS_DIL:]
    splits = np.cumsum([DIL_WIDTH, DIL_WIDTH, DIL_WIDTH, DIFF_WIDTH, DIFF_WIDTH]).tolist()
    for l in range(DEPTH):
        h = rmsnorm(x, g_pre_mix[l])
        proj = h @ w_in[l]
        qa, ka, va, qd, kd, vd = jnp.split(proj, splits, axis=-1)
        heads_a = lambda z: z.reshape(Bsz, S, N_HEADS_DIL, HEAD_DIM).transpose(0, 2, 1, 3)
        qa = heads_a(qa) * (HEAD_DIM ** -0.5)
        ka, va = heads_a(ka), heads_a(va)
        out_a = dilated_attention(qa, ka, va, table_dil)
        out_a = out_a.transpose(0, 2, 1, 3).reshape(Bsz, S, DIL_WIDTH)

        heads_d = lambda z: z.reshape(Bsz, S, N_HEADS_DIFF, 2, DIFF_QK_DIM).transpose(0, 2, 3, 1, 4)
        qd = heads_d(qd) * (DIFF_QK_DIM ** -0.5)
        kd = heads_d(kd)
        vd = vd.reshape(Bsz, S, N_HEADS_DIFF, 2 * DIFF_QK_DIM).transpose(0, 2, 1, 3)
        lambda_init = 0.8 - 0.6 * math.exp(-0.3 * l)
        lam = (jnp.exp(jnp.sum(lambda_q1[l].astype(jnp.float32) * lambda_k1[l].astype(jnp.float32)))
               - jnp.exp(jnp.sum(lambda_q2[l].astype(jnp.float32) * lambda_k2[l].astype(jnp.float32)))
               + lambda_init)
        out_d = diff_attention(qd, kd, vd, table_diff, lam)
        out_d = rmsnorm(out_d, g_subln[l], SUBLN_EPS) * (1.0 - lambda_init)
        out_d = out_d.reshape(Bsz, S, DIFF_WIDTH)

        mixed = jnp.concatenate([out_a, out_d.astype(out_a.dtype)], axis=-1).astype(x.dtype)
        x = x + rmsnorm(mixed @ w_out[l], g_post_mix[l])

        h = rmsnorm(x, g_pre_mlp[l])
        u = jnp.square(jax.nn.relu(h @ w_up[l]))
        x = x + rmsnorm(u @ w_down[l], g_post_mlp[l])
    return x
```

```cpp
#include <hip/hip_runtime.h>
#include <cstdio>
#include <cstdint>
namespace pg8 {
#define PG8_LAS __attribute__((address_space(3)))
typedef unsigned short bf16_t;
typedef short bf16x8 __attribute__((ext_vector_type(8)));
typedef float f32x4 __attribute__((ext_vector_type(4)));
typedef unsigned u32x4 __attribute__((ext_vector_type(4)));
constexpr int BM = 256, BK = 64, HALF = 128, HTB = HALF * BK * 2  , STAGE_BYTES = 8 * HTB, NXCD = 8, WGM = 8;

__host__ __device__ __forceinline__ int lds_byte(int r, int c) { const int st = (r >> 4) * 2 + (c >> 5), rr = r & 15, cc = c & 31, ob = rr * 64 + cc * 2; return st * 1024 + (ob ^ (((ob >> 9) & 1) << 5)); }
__host__ __device__ __forceinline__ void stage_rc(int b, int& R, int& C) { const int st = b / 1024, sb = b % 1024, swz = sb ^ (((sb >> 9) & 1) << 5); R = (st >> 1) * 16 + swz / 64; C = (st & 1) * 32 + (swz % 64) / 2; }
__host__ __device__ __forceinline__ int perm32(int rho) { const int n = rho >> 4, i = rho & 15; return 8 * (i >> 2) + 4 * n + (i & 3); }

struct Unit { int pm, pn; };
struct Gemm { const bf16_t* A; const bf16_t* Bt; int M, N, K; };

struct StaticOrder {
    int nM, nN, nwg, G, c;
    __host__ __device__ void init(int M, int N, int G_, int c_) { nM = M / BM; nN = N / BM; nwg = nM * nN; G = G_; c = c_; }
    __host__ __device__ bool next(int i, Unit& u) const {
        const long L = (long)i * G + c; if (L >= nwg) return false;
        int wgid = (int)L; { const int q = nwg / NXCD, r = nwg % NXCD, xcd = wgid % NXCD, off = wgid / NXCD; wgid = (xcd < r ? xcd * (q + 1) : r * (q + 1) + (xcd - r) * q) + off; }
        const int nig = WGM * nN, gid = wgid / nig, fm = gid * WGM, gsz = (nM - fm) < WGM ? (nM - fm) : WGM;
        u.pm = fm + ((wgid % nig) % gsz); u.pn = (wgid % nig) / gsz; return true;
    }
    __device__ __forceinline__ void a_ready(const Unit&) const {}
    __device__ __forceinline__ void done(const Unit&) const {}
};

__device__ __forceinline__ unsigned cvt_pk_bf16(float lo, float hi) { unsigned r; asm volatile("v_cvt_pk_bf16_f32 %0, %1, %2" : "=v"(r) : "v"(lo), "v"(hi)); return r; }
typedef float f32x2 __attribute__((ext_vector_type(2)));
template <int MODE> struct EpiBf16s {
    static constexpr bool PERM = true, AFTER_DRAIN = false;
    bf16_t* O; int ldc; int qa_end, qd_lo, qd_hi; float sc_a, sc_d;
    __device__ __forceinline__ void operator()(const f32x4 (&acc)[2][2][4][2], const Unit& u, int wr, int wc, int fr, int fq) const {
        const int row0 = u.pm * BM + wr * 64 + fr; const int colt = u.pn * BM;
        float sc = 1.f; if (MODE == 0) { if (colt < qa_end) sc = sc_a; else if (colt >= qd_lo && colt < qd_hi) sc = sc_d; }
        const int col0 = colt + wc * 32 + 8 * fq;
#pragma unroll
        for (int ai = 0; ai < 2; ++ai)
#pragma unroll
            for (int m = 0; m < 4; ++m) { bf16_t* rowp = O + (size_t)(row0 + ai * HALF + m * 16) * ldc + col0;
#pragma unroll
                for (int bj = 0; bj < 2; ++bj) { f32x4 v0 = acc[ai][bj][m][0], v1 = acc[ai][bj][m][1];
                    if (MODE == 1) {
#pragma unroll
                        for (int e = 0; e < 4; ++e) { const float a = fmaxf(v0[e], 0.f), b = fmaxf(v1[e], 0.f); v0[e] = a * a; v1[e] = b * b; }
                    } else { v0 = v0 * sc; v1 = v1 * sc; }
                    u32x4 w; w.x = cvt_pk_bf16(v0[0], v0[1]); w.y = cvt_pk_bf16(v0[2], v0[3]); w.z = cvt_pk_bf16(v1[0], v1[1]); w.w = cvt_pk_bf16(v1[2], v1[3]);
                    *(u32x4*)(rowp + bj * HALF) = w; } }
    }
};
struct EpiF32Ssq {
    static constexpr bool PERM = false, AFTER_DRAIN = false;
    float* C; int ldc; float* part; int npart;
    __device__ __forceinline__ void operator()(const f32x4 (&acc)[2][2][4][2], const Unit& u, int wr, int wc, int fr, int fq) const {
        const int row0 = u.pm * BM + wr * 64 + fr, col0 = u.pn * BM + wc * 32 + 4 * fq;
#pragma unroll
        for (int ai = 0; ai < 2; ++ai)
#pragma unroll
            for (int m = 0; m < 4; ++m) { const int row = row0 + ai * HALF + m * 16; float* rowp = C + (size_t)row * ldc + col0; float s = 0.f;
#pragma unroll
                for (int bj = 0; bj < 2; ++bj)
#pragma unroll
                    for (int n = 0; n < 2; ++n) { const f32x4 x = acc[ai][bj][m][n]; *(f32x4*)(rowp + bj * HALF + n * 16) = x; s += (x[0] * x[0] + x[1] * x[1]) + (x[2] * x[2] + x[3] * x[3]); }
                s += __shfl_xor(s, 16); s += __shfl_xor(s, 32);
                if (fq == 0) part[(size_t)row * npart + u.pn * 4 + wc] = s; }
    }
};

template <class Epi, class Sched, bool ALIGN_EPI = false, bool SP2 = false>
__device__ __forceinline__ void gemm_phase(PG8_LAS unsigned char* lds, const Gemm g, const Sched& S, const Epi& E) {
    const int tid = threadIdx.x, wid = __builtin_amdgcn_readfirstlane(tid >> 6), lane = tid & 63, wr = wid >> 2, wc = wid & 3, fr = lane & 15, fq = lane >> 4;
    const int K = g.K, nt = K / BK;
    unsigned voffA[2], voffB[2];
#pragma unroll
    for (int i = 0; i < 2; ++i) { int R, C; stage_rc(tid * 16 + i * 8192, R, C); const int Rb = Epi::PERM ? ((R & ~31) + perm32(R & 31)) : R;
        voffA[i] = (unsigned)(R * K + C) * 2u; voffB[i] = (unsigned)(Rb * K + C) * 2u; }
    const size_t kstep = (size_t)(BK * 2);
    const size_t hstep = (size_t)HALF * K * 2;
    const size_t tstep = 2 * hstep;
    const unsigned ldsw = (unsigned)wid * 1024u;
    const int aoff = lds_byte(wr * 64 + fr, fq * 8), boff = lds_byte(wc * 32 + fr, fq * 8);
#define PG8_SA(b, h) (((b) * 2 + (h)) * HTB)
#define PG8_SB(b, h) ((4 + (b) * 2 + (h)) * HTB)
#define PG8_STAGE(bufoff, gbase, voff) do { _Pragma("unroll") for (int _i = 0; _i < 2; ++_i) \
        __builtin_amdgcn_global_load_lds((const unsigned*)((const char*)(gbase) + (voff)[_i]), (PG8_LAS unsigned*)(lds + (bufoff) + ldsw + _i * 8192), 16, 0, 0); } while (0)
#define PG8_LDA(dst, b, h) do { _Pragma("unroll") for (int m = 0; m < 4; ++m) _Pragma("unroll") for (int k = 0; k < 2; ++k) dst[m][k] = *(const PG8_LAS bf16x8*)(lds + PG8_SA(b, h) + aoff + m * 2048 + k * 1024); } while (0)
#define PG8_LDB(dst, b, h) do { _Pragma("unroll") for (int n = 0; n < 2; ++n) _Pragma("unroll") for (int k = 0; k < 2; ++k) dst[n][k] = *(const PG8_LAS bf16x8*)(lds + PG8_SB(b, h) + boff + n * 2048 + k * 1024); } while (0)
#define PG8_MMA(ai, bj, At, Bt) do { __builtin_amdgcn_s_setprio(1); _Pragma("unroll") for (int m = 0; m < 4; ++m) _Pragma("unroll") for (int n = 0; n < 2; ++n) _Pragma("unroll") for (int k = 0; k < 2; ++k) \
        acc[ai][bj][m][n] = __builtin_amdgcn_mfma_f32_16x16x32_bf16(Bt[n][k], At[m][k], acc[ai][bj][m][n], 0, 0, 0); __builtin_amdgcn_s_setprio(0); } while (0)
#define PG8_WAIT_V(n) asm volatile("s_waitcnt vmcnt(" #n ")" ::: "memory")
#define PG8_WAIT_L(n) asm volatile("s_waitcnt lgkmcnt(" #n ")" ::: "memory")
#define PG8_BAR __builtin_amdgcn_s_barrier()
#define PG8_SCHED __builtin_amdgcn_sched_barrier(0)
    Unit cur, nxt; int ui = 0;
    if (!S.next(0, cur)) return;
    f32x4 acc[2][2][4][2];
#pragma unroll
    for (int a = 0; a < 2; ++a)
#pragma unroll
        for (int b = 0; b < 2; ++b)
#pragma unroll
            for (int m = 0; m < 4; ++m)
#pragma unroll
                for (int n = 0; n < 2; ++n) acc[a][b][m][n] = (f32x4){0.f, 0.f, 0.f, 0.f};
    bf16x8 At[4][2], B0[2][2], B1[2][2];
    const char* cA = (const char*)g.A + (size_t)cur.pm * tstep; const char* cB = (const char*)g.Bt + (size_t)cur.pn * tstep;
    S.a_ready(cur);
    if constexpr (SP2) {
        PG8_STAGE(PG8_SB(0, 0), cB, voffB); PG8_STAGE(PG8_SB(0, 1), cB + hstep, voffB); PG8_STAGE(PG8_SA(0, 0), cA, voffA); PG8_STAGE(PG8_SA(0, 1), cA + hstep, voffA);
        if (wr == 1) PG8_BAR;
        PG8_WAIT_V(2); PG8_BAR;
        PG8_STAGE(PG8_SB(1, 0), cB + kstep, voffB); PG8_STAGE(PG8_SA(1, 0), cA + kstep, voffA); PG8_STAGE(PG8_SB(1, 1), cB + hstep + kstep, voffB);
        PG8_WAIT_V(6); PG8_BAR;
    } else {
        PG8_STAGE(PG8_SB(0, 0), cB, voffB); PG8_STAGE(PG8_SA(0, 0), cA, voffA); PG8_STAGE(PG8_SB(0, 1), cB + hstep, voffB); PG8_STAGE(PG8_SA(0, 1), cA + hstep, voffA);
        if (wr == 1) PG8_BAR;
        PG8_WAIT_V(4); PG8_BAR;
        PG8_STAGE(PG8_SB(1, 0), cB + kstep, voffB); PG8_STAGE(PG8_SA(1, 0), cA + kstep, voffA); PG8_STAGE(PG8_SB(1, 1), cB + hstep + kstep, voffB);
        PG8_WAIT_V(6); PG8_BAR;
    }
    for (;;) {
        const bool has_next = S.next(ui + 1, nxt);
        const char* nA = has_next ? (const char*)g.A + (size_t)nxt.pm * tstep : cA; const char* nB = has_next ? (const char*)g.Bt + (size_t)nxt.pn * tstep : cB;
        for (int t = 0; t < nt; t += 2) {
            const bool last = (t == nt - 2);
            const char* a1 = cA + (size_t)(t + 1) * kstep;
            const char* a2 = last ? nA : cA + (size_t)(t + 2) * kstep; const char* b2 = last ? nB : cB + (size_t)(t + 2) * kstep;
            const char* a3 = a2 + kstep; const char* b3 = b2 + kstep;
            if (last && has_next) S.a_ready(nxt);
            if constexpr (SP2) {
            PG8_LDB(B0, 0, 0); PG8_LDB(B1, 0, 1); PG8_SCHED; PG8_LDA(At, 0, 0); PG8_STAGE(PG8_SA(1, 1), a1 + hstep, voffA);
            PG8_WAIT_V(8); PG8_WAIT_L(0); PG8_BAR; PG8_MMA(0, 0, At, B0); PG8_MMA(0, 1, At, B1); PG8_BAR; PG8_SCHED;
            PG8_LDA(At, 0, 1); PG8_STAGE(PG8_SB(0, 0), b2, voffB); PG8_STAGE(PG8_SB(0, 1), b2 + hstep, voffB); PG8_STAGE(PG8_SA(0, 0), a2, voffA);
            PG8_WAIT_V(8); PG8_WAIT_L(0); PG8_BAR; PG8_MMA(1, 0, At, B0); PG8_MMA(1, 1, At, B1); PG8_BAR; PG8_SCHED;
            PG8_LDB(B0, 1, 0); PG8_LDB(B1, 1, 1); PG8_SCHED; PG8_LDA(At, 1, 0); PG8_STAGE(PG8_SA(0, 1), a2 + hstep, voffA);
            PG8_WAIT_V(8); PG8_WAIT_L(0); PG8_BAR; PG8_MMA(0, 0, At, B0); PG8_MMA(0, 1, At, B1); PG8_BAR; PG8_SCHED;
            PG8_LDA(At, 1, 1); PG8_STAGE(PG8_SB(1, 0), b3, voffB); PG8_STAGE(PG8_SB(1, 1), b3 + hstep, voffB); PG8_STAGE(PG8_SA(1, 0), a3, voffA);
            PG8_WAIT_V(8); PG8_WAIT_L(0); PG8_BAR; PG8_MMA(1, 0, At, B0); PG8_MMA(1, 1, At, B1); PG8_BAR; PG8_SCHED;
            } else {
            PG8_LDB(B0, 0, 0); PG8_SCHED; PG8_LDA(At, 0, 0); PG8_STAGE(PG8_SA(1, 1), a1 + hstep, voffA);
            PG8_WAIT_L(8); PG8_BAR; PG8_WAIT_L(0); PG8_MMA(0, 0, At, B0); PG8_BAR; PG8_SCHED;
            PG8_LDB(B1, 0, 1); PG8_STAGE(PG8_SB(0, 0), b2, voffB);
            PG8_BAR; PG8_WAIT_L(0); PG8_MMA(0, 1, At, B1); PG8_BAR;
            PG8_LDA(At, 0, 1); PG8_STAGE(PG8_SA(0, 0), a2, voffA);
            PG8_BAR; PG8_WAIT_L(0); PG8_MMA(1, 0, At, B0); PG8_BAR; PG8_SCHED;
            PG8_STAGE(PG8_SB(0, 1), b2 + hstep, voffB);
            PG8_WAIT_V(6); PG8_BAR; PG8_MMA(1, 1, At, B1); PG8_BAR;
            PG8_LDB(B0, 1, 0); PG8_SCHED; PG8_LDA(At, 1, 0); PG8_STAGE(PG8_SA(0, 1), a2 + hstep, voffA);
            PG8_WAIT_L(8); PG8_BAR; PG8_WAIT_L(0); PG8_MMA(0, 0, At, B0); PG8_BAR; PG8_SCHED;
            PG8_LDB(B1, 1, 1); PG8_STAGE(PG8_SB(1, 0), b3, voffB);
            PG8_BAR; PG8_WAIT_L(0); PG8_MMA(0, 1, At, B1); PG8_BAR;
            PG8_LDA(At, 1, 1); PG8_STAGE(PG8_SA(1, 0), a3, voffA);
            PG8_BAR; PG8_WAIT_L(0); PG8_MMA(1, 0, At, B0); PG8_BAR; PG8_SCHED;
            PG8_STAGE(PG8_SB(1, 1), b3 + hstep, voffB);
            PG8_WAIT_V(6); PG8_BAR; PG8_MMA(1, 1, At, B1); PG8_BAR;
            }
        }
        if constexpr (ALIGN_EPI) { if (wr == 0) PG8_BAR; }
        if constexpr (!Epi::AFTER_DRAIN) { E(acc, cur, wr, wc, fr, fq); S.done(cur); }
        if (!has_next) break;
#pragma unroll
        for (int a = 0; a < 2; ++a)
#pragma unroll
            for (int b = 0; b < 2; ++b)
#pragma unroll
                for (int m = 0; m < 4; ++m)
#pragma unroll
                    for (int n = 0; n < 2; ++n) acc[a][b][m][n] = (f32x4){0.f, 0.f, 0.f, 0.f};
        cur = nxt; cA = nA; cB = nB; ++ui;
        if constexpr (ALIGN_EPI) { if (wr == 1) PG8_BAR; }
    }
    PG8_WAIT_V(0);
    if constexpr (!ALIGN_EPI) { if (wr == 0) PG8_BAR; }
    PG8_BAR;
    if constexpr (Epi::AFTER_DRAIN) { E.fused(acc, cur, wr, wc, fr, fq, lds, wid, lane); S.done(cur); }
#undef PG8_SA
#undef PG8_SB
#undef PG8_STAGE
#undef PG8_LDA
#undef PG8_LDB
#undef PG8_MMA
#undef PG8_WAIT_V
#undef PG8_WAIT_L
#undef PG8_BAR
#undef PG8_SCHED
}
}

#ifndef PG8_SP2
#define PG8_SP2 true
#endif
#ifndef PG8_ALIGN
#define PG8_ALIGN true
#endif
#define GAS __attribute__((address_space(1)))
#define LAS __attribute__((address_space(3)))
typedef unsigned short bf16;
typedef unsigned v4u __attribute__((ext_vector_type(4)));
typedef float f32x4 __attribute__((ext_vector_type(4)));
typedef short bf16x8 __attribute__((ext_vector_type(8)));
typedef GAS unsigned gu32;
typedef GAS unsigned long long gu64;
#define RLX_AGENT __ATOMIC_RELAXED, __HIP_MEMORY_SCOPE_AGENT
#define LDS_WAIT() asm volatile("s_waitcnt lgkmcnt(0)" ::: "memory")
#define VM_WAIT() asm volatile("s_waitcnt vmcnt(0)" ::: "memory")
__device__ __forceinline__ unsigned long long rt() { return __builtin_amdgcn_s_memrealtime(); }
__device__ __forceinline__ unsigned f2bf(float f) { unsigned u = __builtin_bit_cast(unsigned, f); return (u + 0x7fffu + ((u >> 16) & 1u)) >> 16; }
__device__ __forceinline__ unsigned pk2(float lo, float hi) { return f2bf(lo) | (f2bf(hi) << 16); }

#define XB_TMO      128
#define XB_XCNT(j)  (256  + 64 * (j))
#define XB_XSUB(j)  (1280 + 64 * (j))
#define XB_XGEN(j)  (2304 + 64 * (j))
#define XB_TOP      3328
#define XB_TOPGEN   3392
#define XCD_BAR_WORDS 3456
#define XB_SPIN_CAP (1u << 18)

__device__ __forceinline__ unsigned xb_ld(unsigned* p)              { return __hip_atomic_load(p, __ATOMIC_RELAXED, __HIP_MEMORY_SCOPE_AGENT); }
__device__ __forceinline__ unsigned xb_add(unsigned* p, unsigned v) { return __hip_atomic_fetch_add(p, v, __ATOMIC_RELAXED, __HIP_MEMORY_SCOPE_AGENT); }
__device__ __forceinline__ unsigned xb_xcc_id() { return (unsigned)__builtin_amdgcn_s_getreg((3 << 11) | 20) & 0xFu; }
#define XB_SPIN(cond, bar) do { unsigned _sp = 0; while (cond) { __builtin_amdgcn_s_sleep(1); \
    if ((++_sp & 255u) == 0u) { if (xb_ld(&(bar)[XB_TMO])) break; if (_sp > XB_SPIN_CAP) { atomicAdd(&(bar)[XB_TMO], 1u); break; } } } } while (0)

struct XcdBarrier {
    unsigned* bar; unsigned x;
    volatile LAS unsigned* st;
};

__device__ __forceinline__ XcdBarrier xcd_barrier_post(unsigned* bar, volatile LAS unsigned* st) {
    XcdBarrier b; b.bar = bar; b.x = xb_xcc_id(); b.st = st;
    if (threadIdx.x == 0) (void)xb_add(&bar[XB_XCNT(b.x)], 1u);
    return b;
}
__device__ __forceinline__ void xcd_barrier_complete(unsigned* bar, unsigned x, unsigned& nloc, unsigned& nx) {
    const unsigned G = gridDim.x * gridDim.y * gridDim.z;
    unsigned sum, cnt, mine, sp = 0u;
    for (;;) {
        sum = 0u; cnt = 0u; mine = 0u;
#pragma unroll
        for (unsigned j = 0; j < 16; ++j) { const unsigned c = xb_ld(&bar[XB_XCNT(j)]); sum += c; cnt += (c > 0u) ? 1u : 0u; mine = (j == x) ? c : mine; }
        if (sum == G) break;
        __builtin_amdgcn_s_sleep(1);
        if ((++sp & 255u) == 0u) { if (xb_ld(&bar[XB_TMO])) break; if (sp > XB_SPIN_CAP) { atomicAdd(&bar[XB_TMO], 1u); break; } }
    }
    nloc = mine > 0u ? mine : 1u; nx = cnt > 0u ? cnt : 1u;
}

__device__ __forceinline__ void xcd_barrier(const XcdBarrier& b) {
    asm volatile("s_waitcnt vmcnt(0)" ::: "memory");
    __syncthreads();
    if (threadIdx.x == 0) {
        unsigned* bar = b.bar;
        __builtin_amdgcn_s_waitcnt(0);
        unsigned nloc = b.st[0], nx = b.st[1];
        if (nloc == 0u) { xcd_barrier_complete(bar, b.x, nloc, nx); b.st[0] = nloc; b.st[1] = nx; }
        const unsigned old = xb_add(&bar[XB_XSUB(b.x)], 1u);
        const unsigned gen = old / nloc;
        if (old + 1u == (gen + 1u) * nloc) {
            __builtin_amdgcn_fence(__ATOMIC_RELEASE, "agent");
            asm volatile("s_waitcnt vmcnt(0)" ::: "memory");
            const unsigned og = xb_add(&bar[XB_TOP], 1u);
            const unsigned tg = og / nx;
            if (og + 1u == (tg + 1u) * nx) xb_add(&bar[XB_TOPGEN], 1u);
            else XB_SPIN(xb_ld(&bar[XB_TOPGEN]) == tg, bar);
            __builtin_amdgcn_fence(__ATOMIC_ACQUIRE, "agent");
            xb_add(&bar[XB_XGEN(b.x)], 1u);
            asm volatile("s_waitcnt vmcnt(0)" ::: "memory");
        } else {
            XB_SPIN(xb_ld(&bar[XB_XGEN(b.x)]) == gen, bar);
            __builtin_amdgcn_fence(__ATOMIC_ACQUIRE, "agent");
            asm volatile("s_waitcnt vmcnt(0)" ::: "memory");
        }
    }
    __syncthreads();
}

constexpr int NWAVES = 8;
#ifndef MK_ONE_LAUNCH
#define MK_ONE_LAUNCH 0
#endif

constexpr int BATCH = 2, SEQ = 4096, DM = 4096, DEPTH = 2, NHA = 16, NHD = 16, HD = 128, DQ = 64;
constexpr int M = BATCH * SEQ;
constexpr int NPROJ = 12288, DFF = 16384, DILW = 2048;
constexpr int COL_QA = 0, COL_KA = 2048, COL_VA = 4096, COL_QD = 6144, COL_KD = 8192, COL_VD = 10240;
constexpr float RMS_EPS = 1e-6f, SUBLN_EPS = 1e-5f, LOG2E = 1.4426950408889634f;
constexpr float SC_A = 0.08838834764831845f * LOG2E;
constexpr float SC_D = 0.125f * LOG2E;
constexpr int NPART = 64;
constexpr int N_PHASES = 1 + 7 * DEPTH;

constexpr size_t MiB = 1u << 20;
constexpr size_t WS_CTL = 0, CTL_ZERO_BYTES = 1 * MiB;
constexpr size_t WS_BIAS = 1 * MiB;
constexpr size_t WS_PART = 2 * MiB;
constexpr size_t WS_WIN = 4 * MiB;
constexpr size_t WS_WOUT = WS_WIN + 192 * MiB;
constexpr size_t WS_WUP = WS_WOUT + 64 * MiB;
constexpr size_t WS_WDN = WS_WUP + 256 * MiB;
constexpr size_t WS_H = WS_WDN + 256 * MiB;
constexpr size_t WS_PROJ = WS_H + 64 * MiB;
constexpr size_t WS_MIX = WS_PROJ + 192 * MiB;
constexpr size_t WS_U = WS_MIX + 64 * MiB;
constexpr size_t WS_Y = WS_U + 256 * MiB;
constexpr size_t WS_END = WS_Y + 128 * MiB;
constexpr int CW_TMO = 0, CW_CODE = 1;
constexpr int CW_LAM = 16;
constexpr int CW_BAR = 4096;

constexpr int RING_OFF = 0, RING_BYTES = 131072;
constexpr int LDSCTL_OFF = RING_BYTES, MISC_OFF = LDSCTL_OFF + 320;
constexpr int LDS_BYTES = 147456;
static_assert(MISC_OFF + 128 <= LDS_BYTES, "LDS map");

struct Frame {
    LAS unsigned char* lds;
    volatile LAS unsigned* MISC;
    gu32* ctl;
    int tid, lane, wave;
    int vcu, G;
    const float* x; float* out;
    const float *rel_bias, *g_pre_mix, *w_in, *lq1, *lk1, *lq2, *lk2, *g_subln, *w_out, *g_post_mix, *g_pre_mlp, *w_up, *w_down, *g_post_mlp;
    bf16 *Win_t, *Wout_t, *Wup_t, *Wdn_t;
    bf16 *H, *PROJ, *MIX, *U;
    float *Y, *PART, *BIAS;
};

__device__ __forceinline__ float wave_sum(float v) {
#pragma unroll
    for (int o = 1; o < 64; o <<= 1) v += __shfl_xor(v, o);
    return v;
}
__device__ __forceinline__ float bflo(unsigned u) { return __uint_as_float(u << 16); }
__device__ __forceinline__ float bfhi(unsigned u) { return __uint_as_float(u & 0xffff0000u); }

__device__ __forceinline__ void p0_transpose_item(const float* W, int K, int N, bf16* WT, LAS float* scr, int item, int lane) {
    const int nblk = N / 32, kb = item / nblk, nb = item % nblk, k0 = 64 * kb, n0 = 32 * nb;
#pragma unroll 8
    for (int i = 0; i < 32; ++i) { const int kk = 2 * i + (lane >> 5); scr[kk * 33 + (lane & 31)] = W[(size_t)(k0 + kk) * N + n0 + (lane & 31)]; }
    LDS_WAIT(); asm volatile("" ::: "memory");
    const int c = lane & 7;
#pragma unroll
    for (int j = 0; j < 4; ++j) { const int n = (lane >> 3) + 8 * j; const LAS float* s = scr + (8 * c) * 33 + n;
        v4u o; o.x = pk2(s[0 * 33], s[1 * 33]); o.y = pk2(s[2 * 33], s[3 * 33]); o.z = pk2(s[4 * 33], s[5 * 33]); o.w = pk2(s[6 * 33], s[7 * 33]);
        *(GAS v4u*)(WT + (size_t)(n0 + n) * K + k0 + 8 * c) = o; }
    LDS_WAIT(); asm volatile("" ::: "memory");
}
__device__ __forceinline__ int t5_bucket(int rel) {
    const int n = rel < 0 ? -rel : rel; int bk;
    if (n < 8) bk = n; else if (n < 15) bk = 8; else if (n < 27) bk = 9; else if (n < 50) bk = 10; else if (n < 91) bk = 11; else if (n < 166) bk = 12; else if (n < 305) bk = 13; else if (n < 559) bk = 14; else bk = 15;
    return bk + (rel > 0 ? 16 : 0);
}
__device__ __forceinline__ void rms_row_to_bf16(const float* xrow, const float* g, bf16* orow, int lane) {
    const GAS f32x4* xr = (const GAS f32x4*)xrow + lane; const GAS f32x4* gr = (const GAS f32x4*)g + lane;
    f32x4 v[16]; float s = 0.f;
#pragma unroll
    for (int j = 0; j < 16; ++j) { v[j] = xr[64 * j]; s += (v[j].x * v[j].x + v[j].y * v[j].y) + (v[j].z * v[j].z + v[j].w * v[j].w); }
    const float rstd = 1.f / sqrtf(wave_sum(s) * (1.f / DM) + RMS_EPS);
    GAS unsigned long long* o8 = (GAS unsigned long long*)orow + lane;
#pragma unroll
    for (int j = 0; j < 16; ++j) { const f32x4 gg = gr[64 * j];
        o8[64 * j] = (unsigned long long)pk2(v[j].x * rstd * gg.x, v[j].y * rstd * gg.y) | ((unsigned long long)pk2(v[j].z * rstd * gg.z, v[j].w * rstd * gg.w) << 32); }
}
__device__ __forceinline__ void p0_prologue(Frame& F) {
    LAS float* scr = (LAS float*)(F.lds + RING_OFF + F.wave * 16384);
    const int gw = F.vcu * NWAVES + F.wave, NGW = F.G * NWAVES;
    constexpr int I_IN = (DM / 64) * (NPROJ / 32), I_OUT = (DM / 64) * (DM / 32), I_UP = (DM / 64) * (DFF / 32), I_DN = (DFF / 64) * (DM / 32);
    constexpr int I_L = I_IN + I_OUT + I_UP + I_DN, NITEMS = DEPTH * I_L;
    for (int it = gw; it < NITEMS; it += NGW) {
        const int l = it / I_L; int r = it % I_L;
        if (r < I_IN) { p0_transpose_item(F.w_in + (size_t)l * DM * NPROJ, DM, NPROJ, F.Win_t + (size_t)l * NPROJ * DM, scr, r, F.lane); continue; } r -= I_IN;
        if (r < I_OUT) { p0_transpose_item(F.w_out + (size_t)l * DM * DM, DM, DM, F.Wout_t + (size_t)l * DM * DM, scr, r, F.lane); continue; } r -= I_OUT;
        if (r < I_UP) { p0_transpose_item(F.w_up + (size_t)l * DM * DFF, DM, DFF, F.Wup_t + (size_t)l * DFF * DM, scr, r, F.lane); continue; } r -= I_UP;
        p0_transpose_item(F.w_down + (size_t)l * DFF * DM, DFF, DM, F.Wdn_t + (size_t)l * DM * DFF, scr, r, F.lane);
    }
    for (int m = gw; m < M; m += NGW) rms_row_to_bf16(F.x + (size_t)m * DM, F.g_pre_mix, F.H + (size_t)m * DM, F.lane);
    for (int i = blockIdx.x * (NWAVES * 64) + F.tid; i < 32 * 8192; i += F.G * NWAVES * 64) { const int h = i >> 13, rel = (i & 8191) - 4095;
        F.BIAS[i] = (rel <= 4095) ? F.rel_bias[t5_bucket(rel) * 32 + h] * LOG2E : 0.f; }
    if (blockIdx.x == 0 && F.tid < DEPTH) { const int l = F.tid; float a = 0.f, b = 0.f;
        for (int i = 0; i < DQ; ++i) { a += F.lq1[l * DQ + i] * F.lk1[l * DQ + i]; b += F.lq2[l * DQ + i] * F.lk2[l * DQ + i]; }
        const float li = 0.8f - 0.6f * expf(-0.3f * (float)l);
        F.ctl[CW_LAM + l] = __float_as_uint(expf(a) - expf(b) + li); }
}
__device__ __forceinline__ void thin_phase(Frame& F, const float* xin, float* xout, const float* g_post, const float* g_next, bool want_h) {
    const int gw = F.vcu * NWAVES + F.wave, NGW = F.G * NWAVES;
    for (int row = gw; row < M; row += NGW) {
        const float ssq = wave_sum(F.PART[(size_t)row * NPART + F.lane]);
        const float rstd = 1.f / sqrtf(ssq * (1.f / DM) + RMS_EPS);
        const GAS f32x4* yr = (const GAS f32x4*)(F.Y + (size_t)row * DM) + F.lane; const GAS f32x4* xr = (const GAS f32x4*)(xin + (size_t)row * DM) + F.lane;
        const GAS f32x4* gp = (const GAS f32x4*)g_post + F.lane; GAS f32x4* xo = (GAS f32x4*)(xout + (size_t)row * DM) + F.lane;
        f32x4 v[16]; float s = 0.f;
#pragma unroll
        for (int j = 0; j < 16; ++j) { const f32x4 y = yr[64 * j], xx = xr[64 * j], g = gp[64 * j];
            v[j] = xx + y * rstd * g; xo[64 * j] = v[j]; s += (v[j].x * v[j].x + v[j].y * v[j].y) + (v[j].z * v[j].z + v[j].w * v[j].w); }
        if (want_h) {
            const float r2 = 1.f / sqrtf(wave_sum(s) * (1.f / DM) + RMS_EPS);
            const GAS f32x4* gn = (const GAS f32x4*)g_next + F.lane; GAS unsigned long long* o8 = (GAS unsigned long long*)(F.H + (size_t)row * DM) + F.lane;
#pragma unroll
            for (int j = 0; j < 16; ++j) { const f32x4 gg = gn[64 * j];
                o8[64 * j] = (unsigned long long)pk2(v[j].x * r2 * gg.x, v[j].y * r2 * gg.y) | ((unsigned long long)pk2(v[j].z * r2 * gg.z, v[j].w * r2 * gg.w) << 32); }
        }
    }
}

struct NaiveArgs { const bf16* PROJ; bf16* MIX; const float* BIAS; const float* g_subln; const unsigned* ctl; int layer, pad; };
__global__ void __launch_bounds__(256) naive_dilated(NaiveArgs F) {
    const int item = blockIdx.x, tid = threadIdx.x;
    const int b = item >> 9, h = (item >> 5) & 15, qc = item & 31;
    const int s = qc * 128 + (tid >> 1), half = tid & 1;
    const bf16* proj = F.PROJ;
    const GAS v4u* qp = (const GAS v4u*)(proj + (size_t)(b * SEQ + s) * NPROJ + COL_QA + h * HD);
    unsigned q[64];
#pragma unroll
    for (int i = 0; i < 16; ++i) { const v4u t = qp[i]; q[4 * i] = t.x; q[4 * i + 1] = t.y; q[4 * i + 2] = t.z; q[4 * i + 3] = t.w; }
    float m = -1e30f, l = 0.f; float o[64];
#pragma unroll
    for (int i = 0; i < 64; ++i) o[i] = 0.f;
    const float* bt = F.BIAS + h * 8192 + 4095;
#pragma unroll 1
    for (int br = 0; br < 3; ++br) { const int dil = br == 0 ? 1 : (br == 1 ? 4 : 16);
#pragma unroll 1
        for (int j = -64; j <= 64; ++j) { const int p = s + j * dil; if (p < 0 || p >= SEQ) continue;
            const GAS v4u* kp = (const GAS v4u*)(proj + (size_t)(b * SEQ + p) * NPROJ + COL_KA + h * HD);
            float dot = 0.f;
#pragma unroll
            for (int i = 0; i < 16; ++i) { const v4u kv = kp[i];
                dot += bflo(q[4 * i]) * bflo(kv.x) + bfhi(q[4 * i]) * bfhi(kv.x); dot += bflo(q[4 * i + 1]) * bflo(kv.y) + bfhi(q[4 * i + 1]) * bfhi(kv.y);
                dot += bflo(q[4 * i + 2]) * bflo(kv.z) + bfhi(q[4 * i + 2]) * bfhi(kv.z); dot += bflo(q[4 * i + 3]) * bflo(kv.w) + bfhi(q[4 * i + 3]) * bfhi(kv.w); }
            const float sc = dot + bt[j * dil];
            if (sc > m) { const float a = exp2f(m - sc); l *= a;
#pragma unroll
                for (int i = 0; i < 64; ++i) o[i] *= a;
                m = sc; }
            const float pe = exp2f(sc - m); l += pe;
            const GAS v4u* vp = (const GAS v4u*)(proj + (size_t)(b * SEQ + p) * NPROJ + COL_VA + h * HD + half * 64);
#pragma unroll
            for (int i = 0; i < 8; ++i) { const v4u vv = vp[i];
                o[8 * i + 0] += pe * bflo(vv.x); o[8 * i + 1] += pe * bfhi(vv.x); o[8 * i + 2] += pe * bflo(vv.y); o[8 * i + 3] += pe * bfhi(vv.y);
                o[8 * i + 4] += pe * bflo(vv.z); o[8 * i + 5] += pe * bfhi(vv.z); o[8 * i + 6] += pe * bflo(vv.w); o[8 * i + 7] += pe * bfhi(vv.w); }
        } }
    const float inv = 1.f / l;
    GAS v4u* op = (GAS v4u*)(F.MIX + (size_t)(b * SEQ + s) * DM + h * HD + half * 64);
#pragma unroll
    for (int i = 0; i < 8; ++i) { v4u w; w.x = pk2(o[8 * i] * inv, o[8 * i + 1] * inv); w.y = pk2(o[8 * i + 2] * inv, o[8 * i + 3] * inv); w.z = pk2(o[8 * i + 4] * inv, o[8 * i + 5] * inv); w.w = pk2(o[8 * i + 6] * inv, o[8 * i + 7] * inv); op[i] = w; }
}
__global__ void __launch_bounds__(256) naive_diff(NaiveArgs F) {
    const int item = blockIdx.x, tid = threadIdx.x, layer = F.layer;
    const int b = item >> 10, h = (item >> 6) & 15, qc = item & 63;
    const int s = qc * 64 + (tid >> 2), quarter = tid & 3;
    const bf16* proj = F.PROJ;
    const GAS v4u* qp = (const GAS v4u*)(proj + (size_t)(b * SEQ + s) * NPROJ + COL_QD + h * HD);
    unsigned q[64];
#pragma unroll
    for (int i = 0; i < 16; ++i) { const v4u t = qp[i]; q[4 * i] = t.x; q[4 * i + 1] = t.y; q[4 * i + 2] = t.z; q[4 * i + 3] = t.w; }
    float m0 = -1e30f, l0 = 0.f, m1 = -1e30f, l1 = 0.f; float o0[32], o1[32];
#pragma unroll
    for (int i = 0; i < 32; ++i) { o0[i] = 0.f; o1[i] = 0.f; }
    const float* bt = F.BIAS + (NHA + h) * 8192 + 4095 - s;
    const bf16* kbase = proj + (size_t)(b * SEQ) * NPROJ + COL_KD + h * HD; const bf16* vbase = proj + (size_t)(b * SEQ) * NPROJ + COL_VD + h * HD + quarter * 32;
#pragma unroll 1
    for (int p = 0; p < SEQ; ++p) {
        const GAS v4u* kp = (const GAS v4u*)(kbase + (size_t)p * NPROJ);
        float d0 = 0.f, d1 = 0.f;
#pragma unroll
        for (int i = 0; i < 8; ++i) { const v4u kv = kp[i];
            d0 += bflo(q[4 * i]) * bflo(kv.x) + bfhi(q[4 * i]) * bfhi(kv.x); d0 += bflo(q[4 * i + 1]) * bflo(kv.y) + bfhi(q[4 * i + 1]) * bfhi(kv.y);
            d0 += bflo(q[4 * i + 2]) * bflo(kv.z) + bfhi(q[4 * i + 2]) * bfhi(kv.z); d0 += bflo(q[4 * i + 3]) * bflo(kv.w) + bfhi(q[4 * i + 3]) * bfhi(kv.w); }
#pragma unroll
        for (int i = 8; i < 16; ++i) { const v4u kv = kp[i];
            d1 += bflo(q[4 * i]) * bflo(kv.x) + bfhi(q[4 * i]) * bfhi(kv.x); d1 += bflo(q[4 * i + 1]) * bflo(kv.y) + bfhi(q[4 * i + 1]) * bfhi(kv.y);
            d1 += bflo(q[4 * i + 2]) * bflo(kv.z) + bfhi(q[4 * i + 2]) * bfhi(kv.z); d1 += bflo(q[4 * i + 3]) * bflo(kv.w) + bfhi(q[4 * i + 3]) * bfhi(kv.w); }
        const float bias = bt[p]; const float s0 = d0 + bias, s1 = d1 + bias;
        if (s0 > m0) { const float a = exp2f(m0 - s0); l0 *= a;
#pragma unroll
            for (int i = 0; i < 32; ++i) o0[i] *= a;
            m0 = s0; }
        if (s1 > m1) { const float a = exp2f(m1 - s1); l1 *= a;
#pragma unroll
            for (int i = 0; i < 32; ++i) o1[i] *= a;
            m1 = s1; }
        const float p0 = exp2f(s0 - m0), p1 = exp2f(s1 - m1); l0 += p0; l1 += p1;
        const GAS v4u* vp = (const GAS v4u*)(vbase + (size_t)p * NPROJ);
#pragma unroll
        for (int i = 0; i < 4; ++i) { const v4u vv = vp[i]; const float v0 = bflo(vv.x), v1 = bfhi(vv.x), v2 = bflo(vv.y), v3 = bfhi(vv.y), v4 = bflo(vv.z), v5 = bfhi(vv.z), v6 = bflo(vv.w), v7 = bfhi(vv.w);
            o0[8 * i + 0] += p0 * v0; o0[8 * i + 1] += p0 * v1; o0[8 * i + 2] += p0 * v2; o0[8 * i + 3] += p0 * v3; o0[8 * i + 4] += p0 * v4; o0[8 * i + 5] += p0 * v5; o0[8 * i + 6] += p0 * v6; o0[8 * i + 7] += p0 * v7;
            o1[8 * i + 0] += p1 * v0; o1[8 * i + 1] += p1 * v1; o1[8 * i + 2] += p1 * v2; o1[8 * i + 3] += p1 * v3; o1[8 * i + 4] += p1 * v4; o1[8 * i + 5] += p1 * v5; o1[8 * i + 6] += p1 * v6; o1[8 * i + 7] += p1 * v7; }
    }
    const float lam = __uint_as_float(F.ctl[CW_LAM + layer]);
    const float li = 0.8f - 0.6f * expf(-0.3f * (float)layer);
    const float i0 = 1.f / l0, i1 = lam / l1; float ssq = 0.f;
#pragma unroll
    for (int i = 0; i < 32; ++i) { o0[i] = o0[i] * i0 - o1[i] * i1; ssq += o0[i] * o0[i]; }
    ssq += __shfl_xor(ssq, 1); ssq += __shfl_xor(ssq, 2);
    const float r = (1.f - li) / sqrtf(ssq * (1.f / HD) + SUBLN_EPS);
    const float* g = F.g_subln + layer * HD + quarter * 32;
    GAS v4u* op = (GAS v4u*)(F.MIX + (size_t)(b * SEQ + s) * DM + DILW + h * HD + quarter * 32);
#pragma unroll
    for (int i = 0; i < 4; ++i) { v4u w; w.x = pk2(o0[8 * i] * r * g[8 * i], o0[8 * i + 1] * r * g[8 * i + 1]); w.y = pk2(o0[8 * i + 2] * r * g[8 * i + 2], o0[8 * i + 3] * r * g[8 * i + 3]);
        w.z = pk2(o0[8 * i + 4] * r * g[8 * i + 4], o0[8 * i + 5] * r * g[8 * i + 5]); w.w = pk2(o0[8 * i + 6] * r * g[8 * i + 6], o0[8 * i + 7] * r * g[8 * i + 7]); op[i] = w; }
}

struct Args { const float* in[15]; float* out; unsigned char* ws; int ph_lo, ph_hi, pad0, pad1; };
__global__ void __launch_bounds__(NWAVES * 64, 2) mk_fwd(Args args) {
    extern __shared__ __attribute__((aligned(16))) unsigned char lds[];
    Frame F;
    F.lds = (LAS unsigned char*)lds;
    F.MISC = (volatile LAS unsigned*)(F.lds + MISC_OFF);
    F.tid = threadIdx.x; F.lane = F.tid & 63; F.wave = __builtin_amdgcn_readfirstlane(F.tid >> 6);
    F.G = gridDim.x; { const int bx = blockIdx.x; F.vcu = (F.G % 8 == 0) ? (bx % 8) * (F.G / 8) + bx / 8 : bx; }
    unsigned char* ws = args.ws;
    F.ctl = (gu32*)(ws + WS_CTL);
    F.x = args.in[0]; F.rel_bias = args.in[1]; F.g_pre_mix = args.in[2]; F.w_in = args.in[3]; F.lq1 = args.in[4]; F.lk1 = args.in[5]; F.lq2 = args.in[6]; F.lk2 = args.in[7];
    F.g_subln = args.in[8]; F.w_out = args.in[9]; F.g_post_mix = args.in[10]; F.g_pre_mlp = args.in[11]; F.w_up = args.in[12]; F.w_down = args.in[13]; F.g_post_mlp = args.in[14];
    F.out = args.out;
    F.Win_t = (bf16*)(ws + WS_WIN); F.Wout_t = (bf16*)(ws + WS_WOUT); F.Wup_t = (bf16*)(ws + WS_WUP); F.Wdn_t = (bf16*)(ws + WS_WDN);
    F.H = (bf16*)(ws + WS_H); F.PROJ = (bf16*)(ws + WS_PROJ); F.MIX = (bf16*)(ws + WS_MIX); F.U = (bf16*)(ws + WS_U);
    F.Y = (float*)(ws + WS_Y); F.PART = (float*)(ws + WS_PART); F.BIAS = (float*)(ws + WS_BIAS);
    for (int u = F.tid; u < (LDS_BYTES - LDSCTL_OFF) / 4; u += NWAVES * 64) ((LAS unsigned*)(F.lds + LDSCTL_OFF))[u] = 0u;
    __syncthreads();
    XcdBarrier bar; bar.bar = (unsigned*)(F.ctl + CW_BAR); bar.x = 0; bar.st = nullptr;
    const bool one = (args.ph_hi - args.ph_lo) > 1;
    if (one) bar = xcd_barrier_post((unsigned*)(F.ctl + CW_BAR), F.MISC + 8);
    const int lo = args.ph_lo, hi = args.ph_hi;
#define IN(k) (lo <= (k) && (k) < hi)
#define SEAM(k) do { if (IN(k) && IN((k) + 1)) xcd_barrier(bar); } while (0)

    if (IN(0)) { p0_prologue(F); SEAM(0); }

#pragma unroll
    for (int l = 0; l < DEPTH; ++l) {
        const int pb = 1 + 7 * l;
        if (IN(pb + 0)) {
            pg8::Gemm g{F.H, F.Win_t + (size_t)l * NPROJ * DM, M, NPROJ, DM}; pg8::StaticOrder S; S.init(M, NPROJ, F.G, (int)blockIdx.x);
            pg8::EpiBf16s<0> E{F.PROJ, NPROJ, COL_KA, COL_QD, COL_KD, SC_A, SC_D};
            pg8::gemm_phase<pg8::EpiBf16s<0>, pg8::StaticOrder, PG8_ALIGN, PG8_SP2>(F.lds + RING_OFF, g, S, E);
            SEAM(pb + 0);
        }
        if (IN(pb + 1)) {
            SEAM(pb + 1);
        }
        if (IN(pb + 2)) {
            pg8::Gemm g{F.MIX, F.Wout_t + (size_t)l * DM * DM, M, DM, DM}; pg8::StaticOrder S; S.init(M, DM, F.G, (int)blockIdx.x);
            pg8::EpiF32Ssq E{F.Y, DM, F.PART, NPART};
            pg8::gemm_phase<pg8::EpiF32Ssq, pg8::StaticOrder, PG8_ALIGN, PG8_SP2>(F.lds + RING_OFF, g, S, E);
            SEAM(pb + 2);
        }
        if (IN(pb + 3)) { thin_phase(F, l == 0 ? F.x : F.out, F.out, F.g_post_mix + l * DM, F.g_pre_mlp + l * DM, true); SEAM(pb + 3); }
        if (IN(pb + 4)) {
            pg8::Gemm g{F.H, F.Wup_t + (size_t)l * DFF * DM, M, DFF, DM}; pg8::StaticOrder S; S.init(M, DFF, F.G, (int)blockIdx.x);
            pg8::EpiBf16s<1> E{F.U, DFF, 0, 0, 0, 1.f, 1.f};
            pg8::gemm_phase<pg8::EpiBf16s<1>, pg8::StaticOrder, PG8_ALIGN, PG8_SP2>(F.lds + RING_OFF, g, S, E);
            SEAM(pb + 4);
        }
        if (IN(pb + 5)) {
            pg8::Gemm g{F.U, F.Wdn_t + (size_t)l * DM * DFF, M, DM, DFF}; pg8::StaticOrder S; S.init(M, DM, F.G, (int)blockIdx.x);
            pg8::EpiF32Ssq E{F.Y, DM, F.PART, NPART};
            pg8::gemm_phase<pg8::EpiF32Ssq, pg8::StaticOrder, PG8_ALIGN, PG8_SP2>(F.lds + RING_OFF, g, S, E);
            SEAM(pb + 5);
        }
        if (IN(pb + 6)) { thin_phase(F, F.out, F.out, F.g_post_mlp + l * DM, F.g_pre_mix + (l + 1 < DEPTH ? l + 1 : l) * DM, l + 1 < DEPTH); SEAM(pb + 6); }
    }
#undef IN
#undef SEAM
}

extern "C" void kernel_launch(void* const* d_in, const int* in_sizes, int n_in, void* d_out, int out_size, void* d_ws, size_t ws_size, hipStream_t stream) {
    static int grid = 0;
    if (grid == 0) {
        if (n_in != 15 || in_sizes[0] != M * DM || out_size != M * DM || ws_size < WS_END) { fprintf(stderr, "kernel_launch: shape mismatch (n_in %d, in0 %d, out %d, ws %zu < %zu); nothing launched\n", n_in, n_in > 0 ? in_sizes[0] : -1, out_size, ws_size, (size_t)WS_END); grid = -1; return; }
        int dev = 0, cus = 0, per_cu = 0;
        if (hipGetDevice(&dev) != hipSuccess || hipDeviceGetAttribute(&cus, hipDeviceAttributeMultiprocessorCount, dev) != hipSuccess) { grid = -1; return; }
        if (hipFuncSetAttribute((const void*)mk_fwd, hipFuncAttributeMaxDynamicSharedMemorySize, LDS_BYTES) != hipSuccess) { fprintf(stderr, "kernel_launch: hipFuncSetAttribute failed\n"); grid = -1; return; }
        if (hipOccupancyMaxActiveBlocksPerMultiprocessor(&per_cu, (const void*)mk_fwd, NWAVES * 64, LDS_BYTES) != hipSuccess || per_cu < 1)
            fprintf(stderr, "kernel_launch: note: occupancy query reports %d workgroups per CU\n", per_cu);
        (void)hipGetLastError();
        grid = cus;
    }
    if (grid < 0) return;
    if (hipMemsetAsync((char*)d_ws + WS_CTL, 0, CTL_ZERO_BYTES, stream) != hipSuccess) { fprintf(stderr, "kernel_launch: memset failed\n"); return; }
    Args a{};
    for (int i = 0; i < 15; ++i) a.in[i] = (const float*)d_in[i];
    a.out = (float*)d_out; a.ws = (unsigned char*)d_ws; a.pad0 = 0; a.pad1 = 0;
#if MK_ONE_LAUNCH
    a.ph_lo = 0; a.ph_hi = N_PHASES;
    hipLaunchKernelGGL(mk_fwd, dim3(grid), dim3(NWAVES * 64), LDS_BYTES, stream, a);
#else
    for (int p = 0; p < N_PHASES; ++p) {
        if (p >= 1 && (p - 1) % 7 == 1) {
            NaiveArgs na{}; na.PROJ = (const bf16*)((char*)d_ws + WS_PROJ); na.MIX = (bf16*)((char*)d_ws + WS_MIX); na.BIAS = (const float*)((char*)d_ws + WS_BIAS); na.g_subln = (const float*)d_in[8];
            na.ctl = (const unsigned*)((char*)d_ws + WS_CTL); na.layer = (p - 1) / 7; na.pad = 0;
            hipLaunchKernelGGL(naive_dilated, dim3(1024), dim3(256), 0, stream, na);
            hipLaunchKernelGGL(naive_diff, dim3(2048), dim3(256), 0, stream, na);
            continue; }
        a.ph_lo = p; a.ph_hi = p + 1; hipLaunchKernelGGL(mk_fwd, dim3(grid), dim3(NWAVES * 64), LDS_BYTES, stream, a); }
#endif
    const hipError_t le = hipPeekAtLastError();
    if (le != hipSuccess) fprintf(stderr, "kernel_launch: launch failed: %s\n", hipGetErrorName(le));
}
```

```cpp
#include <hip/hip_runtime.h>
#include <cstdio>
#include <cstdint>
namespace pg8 {
#define PG8_LAS __attribute__((address_space(3)))
typedef unsigned short bf16_t;
typedef short bf16x8 __attribute__((ext_vector_type(8)));
typedef float f32x4 __attribute__((ext_vector_type(4)));
typedef unsigned u32x4 __attribute__((ext_vector_type(4)));
constexpr int BM = 256, BK = 64, HALF = 128, HTB = HALF * BK * 2  , STAGE_BYTES = 8 * HTB, NXCD = 8, WGM = 8;

__host__ __device__ __forceinline__ int lds_byte(int r, int c) { const int st = (r >> 4) * 2 + (c >> 5), rr = r & 15, cc = c & 31, ob = rr * 64 + cc * 2; return st * 1024 + (ob ^ (((ob >> 9) & 1) << 5)); }
__host__ __device__ __forceinline__ void stage_rc(int b, int& R, int& C) { const int st = b / 1024, sb = b % 1024, swz = sb ^ (((sb >> 9) & 1) << 5); R = (st >> 1) * 16 + swz / 64; C = (st & 1) * 32 + (swz % 64) / 2; }
__host__ __device__ __forceinline__ int perm32(int rho) { const int n = rho >> 4, i = rho & 15; return 8 * (i >> 2) + 4 * n + (i & 3); }

__host__ __device__ __forceinline__ size_t tiled_elem(int row, int col, int nKt) { return ((((size_t)(row >> 8) * nKt + (col >> 6)) * 2 + ((row >> 7) & 1)) * 8192) + (size_t)(lds_byte(row & 127, col & 63) >> 1); }
__host__ __device__ __forceinline__ int inv_perm32(int v) { return 16 * ((v >> 2) & 1) + 4 * (v >> 3) + (v & 3); }
__host__ __device__ __forceinline__ size_t tiled_w_elem(int n, int k, int nKt) { const int nl = n & 127, R = (nl & ~31) + inv_perm32(nl & 31); return ((((size_t)(n >> 8) * nKt + (k >> 6)) * 2 + ((n >> 7) & 1)) * 8192) + (size_t)(lds_byte(R, k & 63) >> 1); }

struct Unit { int pm, pn; };
struct Gemm { const bf16_t* A; const bf16_t* Bt; int M, N, K; int lda = 0, ldb = 0; };

struct StaticOrder {
    int nM, nN, nwg, G, c;
    __host__ __device__ void init(int M, int N, int G_, int c_) { nM = M / BM; nN = N / BM; nwg = nM * nN; G = G_; c = c_; }
    __host__ __device__ bool next(int i, Unit& u) const {
        const long L = (long)i * G + c; if (L >= nwg) return false;
        int wgid = (int)L; { const int q = nwg / NXCD, r = nwg % NXCD, xcd = wgid % NXCD, off = wgid / NXCD; wgid = (xcd < r ? xcd * (q + 1) : r * (q + 1) + (xcd - r) * q) + off; }
        const int nig = WGM * nN, gid = wgid / nig, fm = gid * WGM, gsz = (nM - fm) < WGM ? (nM - fm) : WGM;
        u.pm = fm + ((wgid % nig) % gsz); u.pn = (wgid % nig) / gsz; return true;
    }
    __device__ __forceinline__ void a_ready(const Unit&) const {}
    __device__ __forceinline__ void done(const Unit&) const {}
};

__device__ __forceinline__ unsigned cvt_pk_bf16(float lo, float hi) { unsigned r; asm volatile("v_cvt_pk_bf16_f32 %0, %1, %2" : "=v"(r) : "v"(lo), "v"(hi)); return r; }
typedef float f32x2 __attribute__((ext_vector_type(2)));
template <int MODE> struct EpiBf16s {
    static constexpr bool PERM = true, AFTER_DRAIN = false;
    bf16_t* O; int ldc; int qa_end, qd_lo, qd_hi; float sc_a, sc_d; int tiled_nkt;
    __device__ __forceinline__ void operator()(const f32x4 (&acc)[2][2][4][2], const Unit& u, int wr, int wc, int fr, int fq) const {
        const int row0 = u.pm * BM + wr * 64 + fr; const int colt = u.pn * BM;
        float sc = 1.f; if (MODE == 0) { if (colt < qa_end) sc = sc_a; else if (colt >= qd_lo && colt < qd_hi) sc = sc_d; }
        const int col0 = colt + wc * 32 + 8 * fq;
        bf16_t* tb_ = O + ((size_t)(u.pm * tiled_nkt + (colt >> 6) + (wc >> 1)) * 2) * 8192 + (wr * 4 * 2 + (wc & 1)) * 512 + (((fr * 64 + fq * 16) ^ ((((fr * 64 + fq * 16) >> 9) & 1) << 5)) >> 1);
#pragma unroll
        for (int ai = 0; ai < 2; ++ai)
#pragma unroll
            for (int m = 0; m < 4; ++m) { bf16_t* rowp = O + (size_t)(row0 + ai * HALF + m * 16) * ldc + col0;
#pragma unroll
                for (int bj = 0; bj < 2; ++bj) { f32x4 v0 = acc[ai][bj][m][0], v1 = acc[ai][bj][m][1];
                    if (MODE == 1) {
#pragma unroll
                        for (int e = 0; e < 4; ++e) { const float a = fmaxf(v0[e], 0.f), b = fmaxf(v1[e], 0.f); v0[e] = a * a; v1[e] = b * b; }
                    } else { v0 = v0 * sc; v1 = v1 * sc; }
                    u32x4 w; w.x = cvt_pk_bf16(v0[0], v0[1]); w.y = cvt_pk_bf16(v0[2], v0[3]); w.z = cvt_pk_bf16(v1[0], v1[1]); w.w = cvt_pk_bf16(v1[2], v1[3]);
                    if (tiled_nkt) *(u32x4*)(tb_ + (size_t)(bj * 2 * 2 + ai) * 8192 + m * 1024) = w; else *(u32x4*)(rowp + bj * HALF) = w; } }
    }
};
struct EpiF32Ssq {
    static constexpr bool PERM = false, AFTER_DRAIN = false;
    float* C; int ldc; float* part; int npart;
    __device__ __forceinline__ void operator()(const f32x4 (&acc)[2][2][4][2], const Unit& u, int wr, int wc, int fr, int fq) const {
        const int row0 = u.pm * BM + wr * 64 + fr, col0 = u.pn * BM + wc * 32 + 4 * fq;
#pragma unroll
        for (int ai = 0; ai < 2; ++ai)
#pragma unroll
            for (int m = 0; m < 4; ++m) { const int row = row0 + ai * HALF + m * 16; float* rowp = C + (size_t)row * ldc + col0; float s = 0.f;
#pragma unroll
                for (int bj = 0; bj < 2; ++bj)
#pragma unroll
                    for (int n = 0; n < 2; ++n) { const f32x4 x = acc[ai][bj][m][n]; *(f32x4*)(rowp + bj * HALF + n * 16) = x; s += (x[0] * x[0] + x[1] * x[1]) + (x[2] * x[2] + x[3] * x[3]); }
                s += __shfl_xor(s, 16); s += __shfl_xor(s, 32);
                if (fq == 0) part[(size_t)row * npart + u.pn * 4 + wc] = s; }
    }
};

struct EpiBf16Ssq {
    static constexpr bool PERM = true, AFTER_DRAIN = false;
    bf16_t* C; int ldc; float* part; int npart;
    __device__ __forceinline__ void operator()(const f32x4 (&acc)[2][2][4][2], const Unit& u, int wr, int wc, int fr, int fq) const {
        const int row0 = u.pm * BM + wr * 64 + fr, col0 = u.pn * BM + wc * 32 + 8 * fq;
#pragma unroll
        for (int ai = 0; ai < 2; ++ai)
#pragma unroll
            for (int m = 0; m < 4; ++m) { const int row = row0 + ai * HALF + m * 16; bf16_t* rowp = C + (size_t)row * ldc + col0; float s = 0.f;
#pragma unroll
                for (int bj = 0; bj < 2; ++bj) { const f32x4 v0 = acc[ai][bj][m][0], v1 = acc[ai][bj][m][1];
                    s += (v0[0] * v0[0] + v0[1] * v0[1]) + (v0[2] * v0[2] + v0[3] * v0[3]) + (v1[0] * v1[0] + v1[1] * v1[1]) + (v1[2] * v1[2] + v1[3] * v1[3]);
                    u32x4 w; w.x = cvt_pk_bf16(v0[0], v0[1]); w.y = cvt_pk_bf16(v0[2], v0[3]); w.z = cvt_pk_bf16(v1[0], v1[1]); w.w = cvt_pk_bf16(v1[2], v1[3]);
                    *(u32x4*)(rowp + bj * HALF) = w; }
                s += __shfl_xor(s, 16); s += __shfl_xor(s, 32);
                if (fq == 0) part[(size_t)row * npart + u.pn * 4 + wc] = s; }
    }
};
struct FixedOrder : StaticOrder { int mode;
    __host__ __device__ bool next(int i, Unit& u) const { const long L = (long)i * G + c; if (L >= nwg) return false; if (mode == 2) { u.pm = 0; u.pn = 0; } else { u.pm = c % 8; u.pn = (c / 8) % 2; } return true; }
};
template <class Epi, class Sched, bool ALIGN_EPI = false, bool SP2 = false>
__device__ __forceinline__ void gemm_phase(PG8_LAS unsigned char* lds, const Gemm g, const Sched& S, const Epi& E) {
    int tid = threadIdx.x; asm volatile("" : "+v"(tid)); const int wid = __builtin_amdgcn_readfirstlane(tid >> 6), lane = tid & 63, wr = wid >> 2, wc = wid & 3, fr = lane & 15, fq = lane >> 4;
    static_assert(Epi::PERM, "the weight image has the perm32 row order baked in");
    const int K = g.K, nt = K / BK;
    unsigned voffA[2], voffB[2];
#pragma unroll
    for (int i = 0; i < 2; ++i) { voffA[i] = (unsigned)(tid * 16 + i * 8192); voffB[i] = voffA[i]; }
    const size_t kstep = 32768;
    const size_t hstepA = 16384, hstepB = 16384;
    const size_t tstepA = (size_t)nt * 32768, tstepB = tstepA;
    const unsigned ldsw = (unsigned)wid * 1024u;
    const int aoff = lds_byte(wr * 64 + fr, fq * 8), boff = lds_byte(wc * 32 + fr, fq * 8);
#define PG8_SA(b, h) (((b) * 2 + (h)) * HTB)
#define PG8_SB(b, h) ((4 + (b) * 2 + (h)) * HTB)
#define PG8_STAGE(bufoff, gbase, voff) do { _Pragma("unroll") for (int _i = 0; _i < 2; ++_i) \
        __builtin_amdgcn_global_load_lds((const unsigned*)((const char*)(gbase) + (voff)[_i]), (PG8_LAS unsigned*)(lds + (bufoff) + ldsw + _i * 8192), 16, 0, 0); } while (0)
#define PG8_LDA(dst, b, h) do { _Pragma("unroll") for (int m = 0; m < 4; ++m) _Pragma("unroll") for (int k = 0; k < 2; ++k) dst[m][k] = *(const PG8_LAS bf16x8*)(lds + PG8_SA(b, h) + aoff + m * 2048 + k * 1024); } while (0)
#define PG8_LDB(dst, b, h) do { _Pragma("unroll") for (int n = 0; n < 2; ++n) _Pragma("unroll") for (int k = 0; k < 2; ++k) dst[n][k] = *(const PG8_LAS bf16x8*)(lds + PG8_SB(b, h) + boff + n * 2048 + k * 1024); } while (0)
#define PG8_MMA(ai, bj, At, Bt) do { __builtin_amdgcn_s_setprio(1); _Pragma("unroll") for (int m = 0; m < 4; ++m) _Pragma("unroll") for (int n = 0; n < 2; ++n) _Pragma("unroll") for (int k = 0; k < 2; ++k) \
        acc[ai][bj][m][n] = __builtin_amdgcn_mfma_f32_16x16x32_bf16(Bt[n][k], At[m][k], acc[ai][bj][m][n], 0, 0, 0); __builtin_amdgcn_s_setprio(0); } while (0)
#define PG8_WAIT_V(n) asm volatile("s_waitcnt vmcnt(" #n ")" ::: "memory")
#define PG8_WAIT_L(n) asm volatile("s_waitcnt lgkmcnt(" #n ")" ::: "memory")
#define PG8_BAR __builtin_amdgcn_s_barrier()
#define PG8_SCHED __builtin_amdgcn_sched_barrier(0)
    Unit cur, nxt; int ui = 0;
    if (!S.next(0, cur)) return;
    f32x4 acc[2][2][4][2];
#pragma unroll
    for (int a = 0; a < 2; ++a)
#pragma unroll
        for (int b = 0; b < 2; ++b)
#pragma unroll
            for (int m = 0; m < 4; ++m)
#pragma unroll
                for (int n = 0; n < 2; ++n) acc[a][b][m][n] = (f32x4){0.f, 0.f, 0.f, 0.f};
    bf16x8 At[4][2], B0[2][2], B1[2][2];
    const char* cA = (const char*)g.A + (size_t)cur.pm * tstepA; const char* cB = (const char*)g.Bt + (size_t)cur.pn * tstepB;
    S.a_ready(cur);
    if constexpr (SP2) {
        PG8_STAGE(PG8_SB(0, 0), cB, voffB); PG8_STAGE(PG8_SB(0, 1), cB + hstepB, voffB); PG8_STAGE(PG8_SA(0, 0), cA, voffA); PG8_STAGE(PG8_SA(0, 1), cA + hstepA, voffA);
        if (wr == 1) PG8_BAR;
        PG8_WAIT_V(2); PG8_BAR;
        PG8_STAGE(PG8_SB(1, 0), cB + kstep, voffB); PG8_STAGE(PG8_SA(1, 0), cA + kstep, voffA); PG8_STAGE(PG8_SB(1, 1), cB + hstepB + kstep, voffB);
        PG8_WAIT_V(6); PG8_BAR;
    } else {
        PG8_STAGE(PG8_SB(0, 0), cB, voffB); PG8_STAGE(PG8_SA(0, 0), cA, voffA); PG8_STAGE(PG8_SB(0, 1), cB + hstepB, voffB); PG8_STAGE(PG8_SA(0, 1), cA + hstepA, voffA);
        if (wr == 1) PG8_BAR;
        PG8_WAIT_V(4); PG8_BAR;
        PG8_STAGE(PG8_SB(1, 0), cB + kstep, voffB); PG8_STAGE(PG8_SA(1, 0), cA + kstep, voffA); PG8_STAGE(PG8_SB(1, 1), cB + hstepB + kstep, voffB);
        PG8_WAIT_V(6); PG8_BAR;
    }
    for (;;) {
        const bool has_next = S.next(ui + 1, nxt);
        const char* nA = has_next ? (const char*)g.A + (size_t)nxt.pm * tstepA : cA; const char* nB = has_next ? (const char*)g.Bt + (size_t)nxt.pn * tstepB : cB;
        for (int t = 0; t < nt; t += 2) {
            const bool last = (t == nt - 2);
            const char* a1 = cA + (size_t)(t + 1) * kstep;
            const char* a2 = last ? nA : cA + (size_t)(t + 2) * kstep; const char* b2 = last ? nB : cB + (size_t)(t + 2) * kstep;
            const char* a3 = a2 + kstep; const char* b3 = b2 + kstep;
            if (last && has_next) S.a_ready(nxt);
            if constexpr (SP2) {
            PG8_LDB(B0, 0, 0); PG8_LDB(B1, 0, 1); PG8_SCHED; PG8_LDA(At, 0, 0); PG8_STAGE(PG8_SA(1, 1), a1 + hstepA, voffA);
            PG8_WAIT_V(8); PG8_WAIT_L(0); PG8_BAR; PG8_MMA(0, 0, At, B0); PG8_MMA(0, 1, At, B1); PG8_BAR; PG8_SCHED;
            PG8_LDA(At, 0, 1); PG8_STAGE(PG8_SB(0, 0), b2, voffB); PG8_STAGE(PG8_SB(0, 1), b2 + hstepB, voffB); PG8_STAGE(PG8_SA(0, 0), a2, voffA);
            PG8_WAIT_V(8); PG8_WAIT_L(0); PG8_BAR; PG8_MMA(1, 0, At, B0); PG8_MMA(1, 1, At, B1); PG8_BAR; PG8_SCHED;
            PG8_LDB(B0, 1, 0); PG8_LDB(B1, 1, 1); PG8_SCHED; PG8_LDA(At, 1, 0); PG8_STAGE(PG8_SA(0, 1), a2 + hstepA, voffA);
            PG8_WAIT_V(8); PG8_WAIT_L(0); PG8_BAR; PG8_MMA(0, 0, At, B0); PG8_MMA(0, 1, At, B1); PG8_BAR; PG8_SCHED;
            PG8_LDA(At, 1, 1); PG8_STAGE(PG8_SB(1, 0), b3, voffB); PG8_STAGE(PG8_SB(1, 1), b3 + hstepB, voffB); PG8_STAGE(PG8_SA(1, 0), a3, voffA);
            PG8_WAIT_V(8); PG8_WAIT_L(0); PG8_BAR; PG8_MMA(1, 0, At, B0); PG8_MMA(1, 1, At, B1); PG8_BAR; PG8_SCHED;
            } else {
            PG8_LDB(B0, 0, 0); PG8_SCHED; PG8_LDA(At, 0, 0); PG8_STAGE(PG8_SA(1, 1), a1 + hstepA, voffA);
            PG8_WAIT_L(8); PG8_BAR; PG8_WAIT_L(0); PG8_MMA(0, 0, At, B0); PG8_BAR; PG8_SCHED;
            PG8_LDB(B1, 0, 1); PG8_STAGE(PG8_SB(0, 0), b2, voffB);
            PG8_BAR; PG8_WAIT_L(0); PG8_MMA(0, 1, At, B1); PG8_BAR;
            PG8_LDA(At, 0, 1); PG8_STAGE(PG8_SA(0, 0), a2, voffA);
            PG8_BAR; PG8_WAIT_L(0); PG8_MMA(1, 0, At, B0); PG8_BAR; PG8_SCHED;
            PG8_STAGE(PG8_SB(0, 1), b2 + hstepB, voffB);
            PG8_WAIT_V(6); PG8_BAR; PG8_MMA(1, 1, At, B1); PG8_BAR;
            PG8_LDB(B0, 1, 0); PG8_SCHED; PG8_LDA(At, 1, 0); PG8_STAGE(PG8_SA(0, 1), a2 + hstepA, voffA);
            PG8_WAIT_L(8); PG8_BAR; PG8_WAIT_L(0); PG8_MMA(0, 0, At, B0); PG8_BAR; PG8_SCHED;
            PG8_LDB(B1, 1, 1); PG8_STAGE(PG8_SB(1, 0), b3, voffB);
            PG8_BAR; PG8_WAIT_L(0); PG8_MMA(0, 1, At, B1); PG8_BAR;
            PG8_LDA(At, 1, 1); PG8_STAGE(PG8_SA(1, 0), a3, voffA);
            PG8_BAR; PG8_WAIT_L(0); PG8_MMA(1, 0, At, B0); PG8_BAR; PG8_SCHED;
            PG8_STAGE(PG8_SB(1, 1), b3 + hstepB, voffB);
            PG8_WAIT_V(6); PG8_BAR; PG8_MMA(1, 1, At, B1); PG8_BAR;
            }
        }
        if constexpr (ALIGN_EPI) { if (wr == 0) PG8_BAR; }
        if constexpr (!Epi::AFTER_DRAIN) { E(acc, cur, wr, wc, fr, fq); S.done(cur); }
        if (!has_next) break;
#pragma unroll
        for (int a = 0; a < 2; ++a)
#pragma unroll
            for (int b = 0; b < 2; ++b)
#pragma unroll
                for (int m = 0; m < 4; ++m)
#pragma unroll
                    for (int n = 0; n < 2; ++n) acc[a][b][m][n] = (f32x4){0.f, 0.f, 0.f, 0.f};
        cur = nxt; cA = nA; cB = nB; ++ui;
        if constexpr (ALIGN_EPI) { if (wr == 1) PG8_BAR; }
    }
    PG8_WAIT_V(0);
    if constexpr (!ALIGN_EPI) { if (wr == 0) PG8_BAR; }
    PG8_BAR;
    if constexpr (Epi::AFTER_DRAIN) { E.fused(acc, cur, wr, wc, fr, fq, lds, wid, lane); S.done(cur); }
#undef PG8_SA
#undef PG8_SB
#undef PG8_STAGE
#undef PG8_LDA
#undef PG8_LDB
#undef PG8_MMA
#undef PG8_WAIT_V
#undef PG8_WAIT_L
#undef PG8_BAR
#undef PG8_SCHED
}
}

#ifndef PG8_SP2
#define PG8_SP2 true
#endif
#ifndef PG8_ALIGN
#define PG8_ALIGN true
#endif
#define GAS __attribute__((address_space(1)))
#define LAS __attribute__((address_space(3)))
typedef unsigned short bf16;
typedef unsigned v4u __attribute__((ext_vector_type(4)));
typedef float f32x4 __attribute__((ext_vector_type(4)));
typedef short bf16x8 __attribute__((ext_vector_type(8)));
typedef GAS unsigned gu32;
typedef GAS unsigned long long gu64;
#define RLX_AGENT __ATOMIC_RELAXED, __HIP_MEMORY_SCOPE_AGENT
#define LDS_WAIT() asm volatile("s_waitcnt lgkmcnt(0)" ::: "memory")
#define VM_WAIT() asm volatile("s_waitcnt vmcnt(0)" ::: "memory")
__device__ __forceinline__ unsigned long long rt() { return __builtin_amdgcn_s_memrealtime(); }
__device__ __forceinline__ unsigned f2bf(float f) { unsigned u = __builtin_bit_cast(unsigned, f); return (u + 0x7fffu + ((u >> 16) & 1u)) >> 16; }
__device__ __forceinline__ unsigned pk2(float lo, float hi) { return f2bf(lo) | (f2bf(hi) << 16); }

#define XB_TMO      128
#define XB_XCNT(j)  (256  + 64 * (j))
#define XB_XSUB(j)  (1280 + 64 * (j))
#define XB_XGEN(j)  (2304 + 64 * (j))
#define XB_TOP      3328
#define XB_TOPGEN   3392
#define XCD_BAR_WORDS 3456
#define XB_SPIN_CAP (1u << 18)

__device__ __forceinline__ unsigned xb_ld(unsigned* p)              { return __hip_atomic_load(p, __ATOMIC_RELAXED, __HIP_MEMORY_SCOPE_AGENT); }
__device__ __forceinline__ unsigned xb_add(unsigned* p, unsigned v) { return __hip_atomic_fetch_add(p, v, __ATOMIC_RELAXED, __HIP_MEMORY_SCOPE_AGENT); }
__device__ __forceinline__ unsigned xb_xcc_id() { return (unsigned)__builtin_amdgcn_s_getreg((3 << 11) | 20) & 0xFu; }
#define XB_SPIN(cond, bar) do { unsigned _sp = 0; while (cond) { __builtin_amdgcn_s_sleep(1); \
    if ((++_sp & 255u) == 0u) { if (xb_ld(&(bar)[XB_TMO])) break; if (_sp > XB_SPIN_CAP) { atomicAdd(&(bar)[XB_TMO], 1u); break; } } } } while (0)

struct XcdBarrier {
    unsigned* bar; unsigned x;
    volatile LAS unsigned* st;
};

__device__ __forceinline__ XcdBarrier xcd_barrier_post(unsigned* bar, volatile LAS unsigned* st) {
    XcdBarrier b; b.bar = bar; b.x = xb_xcc_id(); b.st = st;
    if (threadIdx.x == 0) (void)xb_add(&bar[XB_XCNT(b.x)], 1u);
    return b;
}
__device__ __forceinline__ void xcd_barrier_complete(unsigned* bar, unsigned x, unsigned& nloc, unsigned& nx) {
    const unsigned G = gridDim.x * gridDim.y * gridDim.z;
    unsigned sum, cnt, mine, sp = 0u;
    for (;;) {
        sum = 0u; cnt = 0u; mine = 0u;
#pragma unroll
        for (unsigned j = 0; j < 16; ++j) { const unsigned c = xb_ld(&bar[XB_XCNT(j)]); sum += c; cnt += (c > 0u) ? 1u : 0u; mine = (j == x) ? c : mine; }
        if (sum == G) break;
        __builtin_amdgcn_s_sleep(1);
        if ((++sp & 255u) == 0u) { if (xb_ld(&bar[XB_TMO])) break; if (sp > XB_SPIN_CAP) { atomicAdd(&bar[XB_TMO], 1u); break; } }
    }
    nloc = mine > 0u ? mine : 1u; nx = cnt > 0u ? cnt : 1u;
}

__device__ __forceinline__ void xcd_barrier(const XcdBarrier& b) {
    asm volatile("s_waitcnt vmcnt(0)" ::: "memory");
    __syncthreads();
    if (threadIdx.x == 0) {
        unsigned* bar = b.bar;
        __builtin_amdgcn_s_waitcnt(0);
        unsigned nloc = b.st[0], nx = b.st[1];
        if (nloc == 0u) { xcd_barrier_complete(bar, b.x, nloc, nx); b.st[0] = nloc; b.st[1] = nx; }
        const unsigned old = xb_add(&bar[XB_XSUB(b.x)], 1u);
        const unsigned gen = old / nloc;
        if (old + 1u == (gen + 1u) * nloc) {
            __builtin_amdgcn_fence(__ATOMIC_RELEASE, "agent");
            asm volatile("s_waitcnt vmcnt(0)" ::: "memory");
            const unsigned og = xb_add(&bar[XB_TOP], 1u);
            const unsigned tg = og / nx;
            if (og + 1u == (tg + 1u) * nx) xb_add(&bar[XB_TOPGEN], 1u);
            else XB_SPIN(xb_ld(&bar[XB_TOPGEN]) == tg, bar);
            __builtin_amdgcn_fence(__ATOMIC_ACQUIRE, "agent");
            xb_add(&bar[XB_XGEN(b.x)], 1u);
            asm volatile("s_waitcnt vmcnt(0)" ::: "memory");
        } else {
            XB_SPIN(xb_ld(&bar[XB_XGEN(b.x)]) == gen, bar);
            __builtin_amdgcn_fence(__ATOMIC_ACQUIRE, "agent");
            asm volatile("s_waitcnt vmcnt(0)" ::: "memory");
        }
    }
    __syncthreads();
}
namespace att {
typedef short bf16x8 __attribute__((ext_vector_type(8)));
typedef short s16x4 __attribute__((ext_vector_type(4)));
typedef float f32x16 __attribute__((ext_vector_type(16)));
typedef float f32x4 __attribute__((ext_vector_type(4)));
typedef float f32x2 __attribute__((ext_vector_type(2)));
typedef unsigned u32x4 __attribute__((ext_vector_type(4)));
#define ATT_LAS __attribute__((address_space(3)))
#define ATT_SBAR() __builtin_amdgcn_sched_barrier(0)
__device__ __forceinline__ int crow(int r, int hi) { return (r & 3) + 8 * (r >> 2) + 4 * hi; }
__device__ __forceinline__ unsigned cvtpk(float lo, float hi) { unsigned r; asm volatile("v_cvt_pk_bf16_f32 %0, %1, %2" : "=v"(r) : "v"(lo), "v"(hi)); return r; }
__device__ __forceinline__ int v_st(int k, int c) { const int kk = (k & ~0xC) | ((k & 4) << 1) | ((k & 8) >> 1); return ((kk >> 3) * 4 + (c >> 5)) * 512 + ((kk & 7) * 32 + (c & 31)) * 2; }
__device__ __forceinline__ int v_rd_base(int lane) { return ((lane & 3) << 3) | (((lane >> 2) & 3) << 6) | (((lane >> 4) & 1) << 5) | (((lane >> 5) & 1) << 8); }
constexpr int v_rd_off(int d0, int ks, int half) { return d0 * 512 + ks * 4096 + half * 2048; }
template <int OFF> __device__ __forceinline__ s16x4 tr_read(int vb) { s16x4 r; asm volatile("ds_read_b64_tr_b16 %0, %1 offset:%2" : "=&v"(r) : "v"(vb), "i"(OFF) : "memory"); return r; }
#define ATT_PK(L, H) (att::bf16x8){L[0], L[1], L[2], L[3], H[0], H[1], H[2], H[3]}
#define ATT_PK4(P, BASE, OUT) do { unsigned a0_ = att::cvtpk(P[BASE + 0], P[BASE + 1]), a1_ = att::cvtpk(P[BASE + 2], P[BASE + 3]);   \
    unsigned b0_ = att::cvtpk(P[BASE + 4], P[BASE + 5]), b1_ = att::cvtpk(P[BASE + 6], P[BASE + 7]);                              \
    auto r0_ = __builtin_amdgcn_permlane32_swap(a0_, b0_, false, false); auto r1_ = __builtin_amdgcn_permlane32_swap(a1_, b1_, false, false); \
    att::u32x4 w_ = {r0_[0], r1_[0], r0_[1], r1_[1]}; OUT = __builtin_bit_cast(att::bf16x8, w_); } while (0)
template <int D0> __device__ __forceinline__ void pv32_one(f32x16& od, int vb, bf16x8 pa0, bf16x8 pa1) {
    const s16x4 l0 = tr_read<v_rd_off(D0, 0, 0)>(vb), h0 = tr_read<v_rd_off(D0, 0, 1)>(vb), l1 = tr_read<v_rd_off(D0, 1, 0)>(vb), h1 = tr_read<v_rd_off(D0, 1, 1)>(vb);
    asm volatile("s_waitcnt lgkmcnt(0)" ::: "memory"); ATT_SBAR();
    od = __builtin_amdgcn_mfma_f32_32x32x16_bf16(pa0, ATT_PK(l0, h0), od, 0, 0, 0);
    od = __builtin_amdgcn_mfma_f32_32x32x16_bf16(pa1, ATT_PK(l1, h1), od, 0, 0, 0);
}
constexpr float THR2 = 11.5f;

__device__ __forceinline__ void glds16(const void* gsrc, unsigned lds_dst) { unsigned keep;
    asm volatile("s_mov_b32 %0, m0\n\ts_mov_b32 m0, %2\n\ts_nop 0\n\tglobal_load_lds_dwordx4 %1, off\n\ts_mov_b32 m0, %0" : "=&s"(keep) : "v"(gsrc), "s"(lds_dst) : "memory"); }
template <int D0> __device__ __forceinline__ void pv32t_one(f32x16& od, int vb, bf16x8 pa0, bf16x8 pa1) {
    const s16x4 l0 = tr_read<v_rd_off(D0, 0, 0)>(vb), h0 = tr_read<v_rd_off(D0, 0, 1)>(vb), l1 = tr_read<v_rd_off(D0, 1, 0)>(vb), h1 = tr_read<v_rd_off(D0, 1, 1)>(vb);
    asm volatile("s_waitcnt lgkmcnt(0)" ::: "memory"); ATT_SBAR();
    od = __builtin_amdgcn_mfma_f32_32x32x16_bf16(ATT_PK(l0, h0), pa0, od, 0, 0, 0);
    od = __builtin_amdgcn_mfma_f32_32x32x16_bf16(ATT_PK(l1, h1), pa1, od, 0, 0, 0);
}
template <int D0> __device__ __forceinline__ void pv64t_one(f32x16& od, int vb, bf16x8 pa0, bf16x8 pa1, bf16x8 pa2, bf16x8 pa3) {
    const s16x4 l0 = tr_read<v_rd_off(D0, 0, 0)>(vb), h0 = tr_read<v_rd_off(D0, 0, 1)>(vb), l1 = tr_read<v_rd_off(D0, 1, 0)>(vb), h1 = tr_read<v_rd_off(D0, 1, 1)>(vb);
    const s16x4 l2 = tr_read<v_rd_off(D0, 2, 0)>(vb), h2 = tr_read<v_rd_off(D0, 2, 1)>(vb), l3 = tr_read<v_rd_off(D0, 3, 0)>(vb), h3 = tr_read<v_rd_off(D0, 3, 1)>(vb);
    asm volatile("s_waitcnt lgkmcnt(0)" ::: "memory"); ATT_SBAR();
    od = __builtin_amdgcn_mfma_f32_32x32x16_bf16(ATT_PK(l0, h0), pa0, od, 0, 0, 0);
    od = __builtin_amdgcn_mfma_f32_32x32x16_bf16(ATT_PK(l1, h1), pa1, od, 0, 0, 0);
    od = __builtin_amdgcn_mfma_f32_32x32x16_bf16(ATT_PK(l2, h2), pa2, od, 0, 0, 0);
    od = __builtin_amdgcn_mfma_f32_32x32x16_bf16(ATT_PK(l3, h3), pa3, od, 0, 0, 0);
}

template <int MODE> __device__ __forceinline__ void dilated_wave_item(const unsigned short* proj, unsigned short* part_o, float* part_ml, unsigned short* MIX, ATT_LAS unsigned char* vlds, const ATT_LAS float* tsub,
                                                  int b, int h, int dil, int res, int tq0, int branch, int lane) {
    const int r32 = lane & 31, hi = lane >> 5;
    const unsigned short* pb = proj + (size_t)b * 4096 * 12288 + h * 128;
    const size_t rstr = (size_t)dil * 12288;
    const unsigned short* qrow = pb + ((size_t)(tq0 + r32) * dil + res) * 12288 + hi * 8;
    bf16x8 qr[8];
#pragma unroll
    for (int d0 = 0; d0 < 8; ++d0) qr[d0] = *(const bf16x8*)(qrow + d0 * 16);
    float m_reg = -1e30f, l_reg = 0.f; f32x16 o[4];
#pragma unroll
    for (int d = 0; d < 4; ++d)
#pragma unroll
        for (int r = 0; r < 16; ++r) o[d][r] = 0.f;
    const int L = 4096 / dil;
    int kb_lo = 2 - (tq0 >> 5); if (kb_lo < 0) kb_lo = 0;
    int kb_hi = ((L - tq0) >> 5) + 1; if (kb_hi > 4) kb_hi = 4;
    const unsigned vl0 = (unsigned)(uintptr_t)vlds;
    const int kl = (lane & 31) >> 2, cl = (lane >> 5) * 32 + (lane & 3) * 8;
    const int krl = lane >> 4, kcl = lane & 15;
#define DL_ISSUE_K(kbx) do { const unsigned short* krow0_ = pb + ((size_t)(tq0 - 64 + 32 * (kbx)) * dil + res) * 12288 + 2048; \
        _Pragma("unroll") for (int p = 0; p < 8; ++p) { const int row = 4 * p + krl, c = kcl ^ (row & 7); \
            glds16(krow0_ + (size_t)row * rstr + c * 8, (unsigned)__builtin_amdgcn_readfirstlane(vl0 + (unsigned)p * 1024u)); } } while (0)
#define DL_ISSUE_V(kbx) do { const unsigned short* vrow0_ = pb + ((size_t)(tq0 - 64 + 32 * (kbx)) * dil + res) * 12288 + 4096; \
        _Pragma("unroll") for (int p = 0; p < 8; ++p) { const int kk = 8 * (p >> 1) + kl, k = (kk & ~0xC) | ((kk & 4) << 1) | ((kk & 8) >> 1), col = (p & 1) * 64 + cl; \
            glds16(vrow0_ + (size_t)k * rstr + col, (unsigned)__builtin_amdgcn_readfirstlane(vl0 + 8192u + (unsigned)p * 1024u)); } } while (0)
    DL_ISSUE_K(kb_lo); DL_ISSUE_V(kb_lo);
    const int vb = (int)(vl0 + 8192u) + v_rd_base(lane);
    const ATT_LAS unsigned char* krd = vlds + r32 * 256;
#pragma unroll 1
    for (int kb = kb_lo; kb <= kb_hi; ++kb) {
        asm volatile("s_waitcnt vmcnt(8)" ::: "memory");
        bf16x8 kc[8];
#pragma unroll
        for (int d0 = 0; d0 < 8; ++d0) kc[d0] = *(const ATT_LAS bf16x8*)(krd + (((2 * d0 + hi) ^ (r32 & 7)) << 4));
        asm volatile("s_waitcnt lgkmcnt(0)" ::: "memory");
        asm volatile("" : "+v"(kc[0]), "+v"(kc[1]), "+v"(kc[2]), "+v"(kc[3]), "+v"(kc[4]), "+v"(kc[5]), "+v"(kc[6]), "+v"(kc[7]));
        if (kb < kb_hi) DL_ISSUE_K(kb + 1);
        const ATT_LAS float* tb = tsub + (32 - r32 + 4 * hi + 32 * kb);
        f32x16 p;
#pragma unroll
        for (int r = 0; r < 16; ++r) p[r] = tb[(r & 3) + 8 * (r >> 2)];
#pragma unroll
        for (int d0 = 0; d0 < 8; ++d0) p = __builtin_amdgcn_mfma_f32_32x32x16_bf16(kc[d0], qr[d0], p, 0, 0, 0);
        float pmax = p[0];
#pragma unroll
        for (int r = 1; r < 16; ++r) pmax = fmaxf(pmax, p[r]);
        { auto rr = __builtin_amdgcn_permlane32_swap(__float_as_uint(pmax), __float_as_uint(pmax), false, false); pmax = fmaxf(__uint_as_float(rr[0]), __uint_as_float(rr[1])); }
        float alpha = 1.f;
        if (!__all(pmax - m_reg <= THR2)) { const float mn = fmaxf(m_reg, pmax); alpha = __builtin_amdgcn_exp2f(m_reg - mn); m_reg = mn; }
        float ps = 0.f;
#pragma unroll
        for (int r = 0; r < 16; ++r) { p[r] = __builtin_amdgcn_exp2f(p[r] - m_reg); ps += p[r]; }
        { auto rr = __builtin_amdgcn_permlane32_swap(__float_as_uint(ps), __float_as_uint(ps), false, false); ps = __uint_as_float(rr[0]) + __uint_as_float(rr[1]); }
        l_reg = l_reg * alpha + ps;
        bf16x8 pa0, pa1; ATT_PK4(p, 0, pa0); ATT_PK4(p, 8, pa1);
        if (__any(alpha < 1.f)) {
#pragma unroll
            for (int d = 0; d < 4; ++d)
#pragma unroll
                for (int r = 0; r < 16; ++r) o[d][r] *= alpha;
        }
        if (kb < kb_hi) asm volatile("s_waitcnt vmcnt(8)" ::: "memory"); else asm volatile("s_waitcnt vmcnt(0)" ::: "memory");
        ATT_SBAR();
        pv32t_one<0>(o[0], vb, pa0, pa1); pv32t_one<1>(o[1], vb, pa0, pa1); pv32t_one<2>(o[2], vb, pa0, pa1); pv32t_one<3>(o[3], vb, pa0, pa1);
        if (kb < kb_hi) DL_ISSUE_V(kb + 1);
    }
#undef DL_ISSUE_K
#undef DL_ISSUE_V
    const size_t rec = (((size_t)b * 4096 + (size_t)(tq0 + r32) * dil + res) * 16 + h) * 2;
    if (MODE == 0) {
        const float inv = 1.f / l_reg;
        if (hi == 0) *(f32x2*)(part_ml + (rec + branch) * 2) = (f32x2){m_reg, l_reg};
        unsigned short* op = part_o + (rec + branch) * 128 + 4 * hi;
#pragma unroll
        for (int d0 = 0; d0 < 4; ++d0)
#pragma unroll
            for (int g = 0; g < 4; ++g) { f32x2 w; w[0] = __uint_as_float(cvtpk(o[d0][4 * g] * inv, o[d0][4 * g + 1] * inv)); w[1] = __uint_as_float(cvtpk(o[d0][4 * g + 2] * inv, o[d0][4 * g + 3] * inv));
                *(f32x2*)(op + 32 * d0 + 8 * g) = w; }
    } else {
        const f32x4 ml = *(const f32x4*)(part_ml + rec * 2);
        const float mx = fmaxf(fmaxf(m_reg, ml[0]), ml[2]);
        const float w1 = __builtin_amdgcn_exp2f(m_reg - mx), wA = __builtin_amdgcn_exp2f(ml[0] - mx) * ml[1], wB = __builtin_amdgcn_exp2f(ml[2] - mx) * ml[3];
        const float inv = 1.f / (w1 * l_reg + wA + wB), s1 = w1 * inv, sA = wA * inv, sB = wB * inv;
        const unsigned short* pa_ = part_o + rec * 128 + 4 * hi; const unsigned short* pb_ = pa_ + 128;
        const int orow = b * 4096 + (tq0 + r32) * dil + res, ocol = h * 128 + 4 * hi;
#pragma unroll
        for (int d0 = 0; d0 < 4; ++d0)
#pragma unroll
            for (int g = 0; g < 4; ++g) { const f32x2 ua = *(const f32x2*)(pa_ + 32 * d0 + 8 * g), ub = *(const f32x2*)(pb_ + 32 * d0 + 8 * g);
                const unsigned a0 = __float_as_uint(ua[0]), a1 = __float_as_uint(ua[1]), b0 = __float_as_uint(ub[0]), b1 = __float_as_uint(ub[1]);
                const float y0 = o[d0][4 * g] * s1 + __uint_as_float(a0 << 16) * sA + __uint_as_float(b0 << 16) * sB, y1 = o[d0][4 * g + 1] * s1 + __uint_as_float(a0 & 0xffff0000u) * sA + __uint_as_float(b0 & 0xffff0000u) * sB;
                const float y2 = o[d0][4 * g + 2] * s1 + __uint_as_float(a1 << 16) * sA + __uint_as_float(b1 << 16) * sB, y3 = o[d0][4 * g + 3] * s1 + __uint_as_float(a1 & 0xffff0000u) * sA + __uint_as_float(b1 & 0xffff0000u) * sB;
                f32x2 w; w[0] = __uint_as_float(cvtpk(y0, y1)); w[1] = __uint_as_float(cvtpk(y2, y3)); *(f32x2*)(MIX + pg8::tiled_elem(orow, ocol + 32 * d0 + 8 * g, 64)) = w; }
    }
}

#define ATT_VRD8(D0, L, H) do { L[0] = tr_read<v_rd_off(D0, 0, 0)>(vb); H[0] = tr_read<v_rd_off(D0, 0, 1)>(vb); L[1] = tr_read<v_rd_off(D0, 1, 0)>(vb); H[1] = tr_read<v_rd_off(D0, 1, 1)>(vb); \
        L[2] = tr_read<v_rd_off(D0, 2, 0)>(vb); H[2] = tr_read<v_rd_off(D0, 2, 1)>(vb); L[3] = tr_read<v_rd_off(D0, 3, 0)>(vb); H[3] = tr_read<v_rd_off(D0, 3, 1)>(vb); } while (0)
#define ATT_PV4(OD, L, H) do { OD = __builtin_amdgcn_mfma_f32_32x32x16_bf16(ATT_PK(L[0], H[0]), pa0, OD, 0, 0, 0); OD = __builtin_amdgcn_mfma_f32_32x32x16_bf16(ATT_PK(L[1], H[1]), pa1, OD, 0, 0, 0); \
        OD = __builtin_amdgcn_mfma_f32_32x32x16_bf16(ATT_PK(L[2], H[2]), pa2, OD, 0, 0, 0); OD = __builtin_amdgcn_mfma_f32_32x32x16_bf16(ATT_PK(L[3], H[3]), pa3, OD, 0, 0, 0); } while (0)
template <int GV> __device__ __forceinline__ void pv64t_all(f32x16 (&o)[4], int vb, bf16x8 pa0, bf16x8 pa1, bf16x8 pa2, bf16x8 pa3) {
    s16x4 la[4], ha[4], lb[4], hb[4];
    if (GV == 7) {
#pragma unroll
        for (int i = 0; i < 4; ++i) { la[i] = (s16x4){1, 2, 3, 4}; ha[i] = (s16x4){5, 6, 7, 8}; lb[i] = la[i]; hb[i] = ha[i]; asm volatile("" : "+v"(la[i]), "+v"(ha[i]), "+v"(lb[i]), "+v"(hb[i])); }
        ATT_PV4(o[0], la, ha); ATT_PV4(o[1], lb, hb); ATT_PV4(o[2], la, ha); ATT_PV4(o[3], lb, hb); return; }
    if (GV == 8) {
        ATT_VRD8(0, la, ha); ATT_VRD8(1, lb, hb); asm volatile("s_waitcnt lgkmcnt(8)" ::: "memory");
#pragma unroll
        for (int i = 0; i < 4; ++i) asm volatile("" :: "v"(la[i]), "v"(ha[i]));
        ATT_VRD8(2, la, ha); asm volatile("s_waitcnt lgkmcnt(8)" ::: "memory");
#pragma unroll
        for (int i = 0; i < 4; ++i) asm volatile("" :: "v"(lb[i]), "v"(hb[i]));
        ATT_VRD8(3, lb, hb); asm volatile("s_waitcnt lgkmcnt(0)" ::: "memory");
#pragma unroll
        for (int i = 0; i < 4; ++i) asm volatile("" :: "v"(la[i]), "v"(ha[i]), "v"(lb[i]), "v"(hb[i]));
        o[0][0] += __builtin_bit_cast(f32x4, pa0)[0] + __builtin_bit_cast(f32x4, pa1)[1] + __builtin_bit_cast(f32x4, pa2)[2] + __builtin_bit_cast(f32x4, pa3)[3]; return; }
#define ATT_VRDK(KS, L, H) do { L[0] = tr_read<v_rd_off(0, KS, 0)>(vb); H[0] = tr_read<v_rd_off(0, KS, 1)>(vb); L[1] = tr_read<v_rd_off(1, KS, 0)>(vb); H[1] = tr_read<v_rd_off(1, KS, 1)>(vb); \
        L[2] = tr_read<v_rd_off(2, KS, 0)>(vb); H[2] = tr_read<v_rd_off(2, KS, 1)>(vb); L[3] = tr_read<v_rd_off(3, KS, 0)>(vb); H[3] = tr_read<v_rd_off(3, KS, 1)>(vb); } while (0)
#define ATT_PVK(PA, L, H) do { o[0] = __builtin_amdgcn_mfma_f32_32x32x16_bf16(ATT_PK(L[0], H[0]), PA, o[0], 0, 0, 0); o[1] = __builtin_amdgcn_mfma_f32_32x32x16_bf16(ATT_PK(L[1], H[1]), PA, o[1], 0, 0, 0); \
        o[2] = __builtin_amdgcn_mfma_f32_32x32x16_bf16(ATT_PK(L[2], H[2]), PA, o[2], 0, 0, 0); o[3] = __builtin_amdgcn_mfma_f32_32x32x16_bf16(ATT_PK(L[3], H[3]), PA, o[3], 0, 0, 0); } while (0)
    ATT_VRDK(0, la, ha); ATT_VRDK(1, lb, hb);
    asm volatile("s_waitcnt lgkmcnt(8)" ::: "memory"); ATT_SBAR(); ATT_PVK(pa0, la, ha); ATT_SBAR();
    ATT_VRDK(2, la, ha);
    asm volatile("s_waitcnt lgkmcnt(8)" ::: "memory"); ATT_SBAR(); ATT_PVK(pa1, lb, hb); ATT_SBAR();
    ATT_VRDK(3, lb, hb);
    asm volatile("s_waitcnt lgkmcnt(8)" ::: "memory"); ATT_SBAR(); ATT_PVK(pa2, la, ha); ATT_SBAR();
    asm volatile("s_waitcnt lgkmcnt(0)" ::: "memory"); ATT_SBAR(); ATT_PVK(pa3, lb, hb);
#undef ATT_VRDK
#undef ATT_PVK
}

constexpr int DF_TB = 131072, DF_TBN = 1312, DF_TB0 = 656, DF_XROW = 528;
#define ATT_WAIT_BAR() asm volatile("s_waitcnt vmcnt(0) lgkmcnt(0)\n\ts_barrier" ::: "memory")
#define ATT_WAIT4_BAR() asm volatile("s_waitcnt vmcnt(4) lgkmcnt(0)\n\ts_barrier" ::: "memory")
template <int GV> __device__ __forceinline__ void df_qkt(f32x16& p0, f32x16& p1, const ATT_LAS unsigned char* ks, const bf16x8 (&qr)[4], const ATT_LAS float* tb, bool lookup, const f32x16& cinit, float m_reg, int map, int r32, int hi) {
    const int sw = r32 & 7; const ATT_LAS unsigned char* kr = ks + r32 * 256 + map * 128;
    bf16x8 kf0[4], kf1[4];
#pragma unroll
    for (int d0 = 0; d0 < 4; ++d0) { const int off = ((2 * d0 + hi) ^ sw) << 4;
        if (GV == 7) { kf0[d0] = qr[d0]; kf1[d0] = qr[3 - d0]; asm volatile("" : "+v"(kf0[d0]), "+v"(kf1[d0])); } else { kf0[d0] = *(const ATT_LAS bf16x8*)(kr + off); kf1[d0] = *(const ATT_LAS bf16x8*)(kr + 8192 + off); } }
    if (GV == 8) {
#pragma unroll
        for (int d0 = 0; d0 < 4; ++d0) asm volatile("" :: "v"(kf0[d0]), "v"(kf1[d0]));
        p0 = cinit; p1 = cinit; return; }
    if (lookup) {
#pragma unroll
        for (int r = 0; r < 16; ++r) { p0[r] = tb[(r & 3) + 8 * (r >> 2)] - m_reg; p1[r] = tb[32 + (r & 3) + 8 * (r >> 2)] - m_reg; }
        p0 = __builtin_amdgcn_mfma_f32_32x32x16_bf16(kf0[0], qr[0], p0, 0, 0, 0); p1 = __builtin_amdgcn_mfma_f32_32x32x16_bf16(kf1[0], qr[0], p1, 0, 0, 0);
    } else {
        p0 = __builtin_amdgcn_mfma_f32_32x32x16_bf16(kf0[0], qr[0], cinit, 0, 0, 0); p1 = __builtin_amdgcn_mfma_f32_32x32x16_bf16(kf1[0], qr[0], cinit, 0, 0, 0);
    }
#pragma unroll
    for (int d0 = 1; d0 < 4; ++d0) { p0 = __builtin_amdgcn_mfma_f32_32x32x16_bf16(kf0[d0], qr[d0], p0, 0, 0, 0); p1 = __builtin_amdgcn_mfma_f32_32x32x16_bf16(kf1[d0], qr[d0], p1, 0, 0, 0); }
}
template <bool FIRST> __device__ __forceinline__ void df_partial(f32x16& p0, f32x16& p1, float& m_reg, float& alpha, f32x16& cinit) {
    float pmax = p0[0];
#pragma unroll
    for (int r = 1; r < 16; ++r) pmax = fmaxf(pmax, p0[r]);
#pragma unroll
    for (int r = 0; r < 16; ++r) pmax = fmaxf(pmax, p1[r]);
    { auto rr = __builtin_amdgcn_permlane32_swap(__float_as_uint(pmax), __float_as_uint(pmax), false, false); pmax = fmaxf(__uint_as_float(rr[0]), __uint_as_float(rr[1])); }
    alpha = 1.f;
    if (FIRST || !__builtin_expect(__all(pmax <= THR2), 1)) { const float dl = FIRST ? pmax : fmaxf(pmax, 0.f); m_reg += dl; alpha = FIRST ? 1.f : __builtin_amdgcn_exp2f(-dl);
#pragma unroll
        for (int r = 0; r < 16; ++r) { p0[r] -= dl; p1[r] -= dl; cinit[r] -= dl; } }
#pragma unroll
    for (int r = 0; r < 16; ++r) p0[r] = __builtin_amdgcn_exp2f(p0[r]);
}
__device__ __forceinline__ void df_finish(f32x16& p0, f32x16& p1, float alpha, float& l_reg, bf16x8& pa0, bf16x8& pa1, bf16x8& pa2, bf16x8& pa3) {
#pragma unroll
    for (int r = 0; r < 16; ++r) p1[r] = __builtin_amdgcn_exp2f(p1[r]);
    float ps = 0.f;
#pragma unroll
    for (int r = 0; r < 16; ++r) ps += p0[r];
#pragma unroll
    for (int r = 0; r < 16; ++r) ps += p1[r];
    { auto rr = __builtin_amdgcn_permlane32_swap(__float_as_uint(ps), __float_as_uint(ps), false, false); ps = __uint_as_float(rr[0]) + __uint_as_float(rr[1]); }
    l_reg = l_reg * alpha + ps;
    ATT_PK4(p0, 0, pa0); ATT_PK4(p0, 8, pa1); ATT_PK4(p1, 0, pa2); ATT_PK4(p1, 8, pa3);
}
template <int GV> __device__ __forceinline__ void diff_unit(const unsigned short* proj, unsigned short* MIX, const float* BIAS, const float* gsub, float lam, float post, ATT_LAS unsigned char* lds, int b, int h, int qb, int tid) {
    const int lane = tid & 63, wid = __builtin_amdgcn_readfirstlane(tid >> 6), r32 = lane & 31, hi = lane >> 5, rg = wid & 3, map = wid >> 2;
    const unsigned lds0 = (unsigned)(uintptr_t)lds;
    ATT_LAS float* tbl = (ATT_LAS float*)(lds + DF_TB);
    const int qw = qb * 128 + rg * 32;
    const unsigned short* pb = proj + (size_t)b * 4096 * 12288 + h * 128;
    const float* bh = BIAS + (16 + h) * 8192 + 4095;
    ATT_WAIT_BAR();
    for (int i = tid; i < DF_TBN; i += 512) tbl[i] = bh[i - DF_TB0];
    const float cpos = bh[600], cneg = bh[-600];
    bf16x8 qr[4];
    { const unsigned short* qrow = pb + (size_t)(qw + r32) * 12288 + 6144 + map * 64 + hi * 8;
#pragma unroll
      for (int d0 = 0; d0 < 4; ++d0) qr[d0] = *(const bf16x8*)(qrow + d0 * 16); }
    unsigned koff[2], voff[2];
#pragma unroll
    for (int e = 0; e < 2; ++e) { const int p = 2 * wid + e; { const int row = 4 * p + (lane >> 4), c = (lane & 15) ^ (row & 7); koff[e] = (unsigned)(row * 24576 + c * 16); }
        { const int j = 64 * p + lane, st = j >> 5, kk = (st >> 2) * 8 + ((j & 31) >> 2), col = (st & 3) * 32 + (j & 3) * 8, k = (kk & ~0xC) | ((kk & 4) << 1) | ((kk & 8) >> 1); voff[e] = (unsigned)(k * 24576 + col * 2); } }
    const char* kbase = (const char*)(pb + 8192); const char* vbase = (const char*)(pb + 10240);
#define DF_DMA(t, slot) do { const size_t tb_ = (size_t)(t) * (64 * 24576); const unsigned sl_ = lds0 + (unsigned)(slot) * 32768u + (unsigned)(2 * wid) * 1024u; \
        glds16(kbase + tb_ + koff[0], (unsigned)__builtin_amdgcn_readfirstlane(sl_)); glds16(kbase + tb_ + koff[1], (unsigned)__builtin_amdgcn_readfirstlane(sl_ + 1024u)); \
        glds16(vbase + tb_ + voff[0], (unsigned)__builtin_amdgcn_readfirstlane(sl_ + 16384u)); glds16(vbase + tb_ + voff[1], (unsigned)__builtin_amdgcn_readfirstlane(sl_ + 16384u + 1024u)); } while (0)
    if (GV < 5) { DF_DMA(0, 0); DF_DMA(1, 1); }
    float m_reg = 0.f, l_reg = 0.f, cbk = 0.f; f32x16 o[4], cinit;
#pragma unroll
    for (int d = 0; d < 4; ++d)
#pragma unroll
        for (int r = 0; r < 16; ++r) o[d][r] = 0.f;
#pragma unroll
    for (int r = 0; r < 16; ++r) cinit[r] = 0.f;
    f32x16 pA0, pA1, pB0, pB1; float alA = 1.f, alB = 1.f; bf16x8 pa0, pa1, pa2, pa3;
    const int vrb = (int)(lds0 + 16384u) + v_rd_base(lane);
#define DF_MODE(j, LK, CB, TB) const int k0_ = (j) * 64, rmin_ = k0_ - (qw + 31), rmax_ = k0_ + 63 - qw; const bool LK = !(rmin_ >= 559 || rmax_ <= -559); \
        const float CB = LK ? 0.f : (rmin_ >= 559 ? cpos : cneg); const ATT_LAS float* TB = tbl + (LK ? (k0_ - qw - r32 + 4 * hi + DF_TB0) : 0); \
        if (!LK && CB != cbk) { cbk = CB; _Pragma("unroll") for (int r_ = 0; r_ < 16; ++r_) cinit[r_] = CB - m_reg; }
#define DF_RESC(al) do { if (__any((al) < 1.f)) { _Pragma("unroll") for (int d_ = 0; d_ < 4; ++d_) _Pragma("unroll") for (int r_ = 0; r_ < 16; ++r_) o[d_][r_] *= (al); } } while (0)
#define DF_STEP(PC0, PC1, ALC, PP0, PP1, ALP, j) do { \
        if (GV < 5 && (j) + 2 < 64) DF_DMA((j) + 2, ((j) + 2) & 3); \
        { DF_MODE(j, lk_, cb_, tb_); ATT_SBAR(); \
          if (GV != 4) df_qkt<GV>(PC0, PC1, lds + ((j) & 3) * 32768, qr, tb_, lk_, cinit, m_reg, map, r32, hi); else { PC0 = cinit; PC1 = cinit; } \
          if (GV != 2) df_finish(PP0, PP1, ALP, l_reg, pa0, pa1, pa2, pa3); else { pa0 = __builtin_bit_cast(bf16x8, (f32x4){PP0[0], PP0[1], PP0[2], PP0[3]}); pa1 = __builtin_bit_cast(bf16x8, (f32x4){PP0[4], PP0[5], PP0[6], PP0[7]}); pa2 = __builtin_bit_cast(bf16x8, (f32x4){PP1[0], PP1[1], PP1[2], PP1[3]}); pa3 = __builtin_bit_cast(bf16x8, (f32x4){PP1[4], PP1[5], PP1[6], PP1[7]}); l_reg += PP0[8] + PP1[8]; } ATT_SBAR(); \
          if (GV != 3) { const int vb_ = vrb + (((j) - 1) & 3) * 32768; \
            pv64t_all<GV>(o, vb_, pa0, pa1, pa2, pa3); } \
          else { o[0][0] += __builtin_bit_cast(f32x4, pa0)[0] + __builtin_bit_cast(f32x4, pa1)[1] + __builtin_bit_cast(f32x4, pa2)[2] + __builtin_bit_cast(f32x4, pa3)[3]; } \
          if (GV != 2) df_partial<false>(PC0, PC1, m_reg, ALC, cinit); else ALC = 1.f; } \
        DF_RESC(ALC); \
        if (GV >= 6) { asm volatile("s_waitcnt lgkmcnt(0)" ::: "memory"); } else if (GV == 5) { asm volatile("s_waitcnt lgkmcnt(0)\n\ts_barrier" ::: "memory"); } else if ((j) + 2 < 64) ATT_WAIT4_BAR(); else ATT_WAIT_BAR(); } while (0)
    ATT_WAIT4_BAR();
    { if (GV < 5) DF_DMA(2, 2); DF_MODE(0, lk_, cb_, tb_); df_qkt<GV>(pA0, pA1, lds, qr, tb_, lk_, cinit, m_reg, map, r32, hi); df_partial<true>(pA0, pA1, m_reg, alA, cinit); ATT_WAIT4_BAR(); }
#pragma unroll 1
    for (int j = 1; j < 63; j += 2) { DF_STEP(pB0, pB1, alB, pA0, pA1, alA, j); DF_STEP(pA0, pA1, alA, pB0, pB1, alB, j + 1); }
    DF_STEP(pB0, pB1, alB, pA0, pA1, alA, 63);
    df_finish(pB0, pB1, alB, l_reg, pa0, pa1, pa2, pa3); ATT_SBAR();
    { const int vb_ = vrb + (63 & 3) * 32768;
      pv64t_all<GV>(o, vb_, pa0, pa1, pa2, pa3); }
#undef DF_STEP
#undef DF_RESC
#undef DF_MODE
#undef DF_DMA
    ATT_WAIT_BAR();
    ATT_LAS unsigned char* xr = lds + rg * (32 * DF_XROW) + r32 * DF_XROW + hi * 16;
    if (map == 1) { const float s1 = lam / l_reg;
#pragma unroll
        for (int d0 = 0; d0 < 4; ++d0)
#pragma unroll
            for (int g = 0; g < 4; ++g) *(ATT_LAS f32x4*)(xr + (32 * d0 + 8 * g) * 4) = (f32x4){o[d0][4 * g] * s1, o[d0][4 * g + 1] * s1, o[d0][4 * g + 2] * s1, o[d0][4 * g + 3] * s1}; }
    ATT_WAIT_BAR();
    if (map == 0 && (GV == 0 || l_reg == -123.456f)) { const float s0 = 1.f / l_reg; float ss = 0.f;
#pragma unroll
        for (int d0 = 0; d0 < 4; ++d0)
#pragma unroll
            for (int g = 0; g < 4; ++g) { const f32x4 y = *(const ATT_LAS f32x4*)(xr + (32 * d0 + 8 * g) * 4);
#pragma unroll
                for (int i = 0; i < 4; ++i) { const float x = o[d0][4 * g + i] * s0 - y[i]; o[d0][4 * g + i] = x; ss += x * x; } }
        { auto rr = __builtin_amdgcn_permlane32_swap(__float_as_uint(ss), __float_as_uint(ss), false, false); ss = __uint_as_float(rr[0]) + __uint_as_float(rr[1]); }
        const float rs = post / sqrtf(ss * (1.f / 128.f) + 1e-5f);
        const int orow = b * 4096 + qw + r32, ocol = 2048 + h * 128 + 4 * hi; const float* gp = gsub + 4 * hi;
#pragma unroll
        for (int d0 = 0; d0 < 4; ++d0)
#pragma unroll
            for (int g = 0; g < 4; ++g) { const f32x4 gg = *(const f32x4*)(gp + 32 * d0 + 8 * g);
                f32x2 w; { const unsigned lo = cvtpk(o[d0][4 * g] * rs * gg[0], o[d0][4 * g + 1] * rs * gg[1]), hi2 = cvtpk(o[d0][4 * g + 2] * rs * gg[2], o[d0][4 * g + 3] * rs * gg[3]); w[0] = __uint_as_float(lo); w[1] = __uint_as_float(hi2); }
                *(f32x2*)(MIX + pg8::tiled_elem(orow, ocol + 32 * d0 + 8 * g, 64)) = w; } }
}
}

constexpr int NWAVES = 8;
#ifndef MK_ONE_LAUNCH
#define MK_ONE_LAUNCH 1
#endif

#ifndef PROBE_DUP
#define PROBE_DUP 0
#endif
#define DUPN(k) ((PROBE_DUP == (k)) ? 2 : 1)
#ifndef PROBE_CLK
#define PROBE_CLK 0
#endif
#ifndef PROBE_GG
#define PROBE_GG 0
#endif
#ifndef PROBE_BAR
#define PROBE_BAR 0
#endif
#ifndef PROBE_THIN
#define PROBE_THIN 0
#endif
#ifndef PROBE_GV
#define PROBE_GV 0
#endif

constexpr int BATCH = 2, SEQ = 4096, DM = 4096, DEPTH = 2, NHA = 16, NHD = 16, HD = 128, DQ = 64;
constexpr int M = BATCH * SEQ;
constexpr int NPROJ = 12288, DFF = 16384, DILW = 2048;
constexpr int COL_QA = 0, COL_KA = 2048, COL_VA = 4096, COL_QD = 6144, COL_KD = 8192, COL_VD = 10240;
constexpr float RMS_EPS = 1e-6f, SUBLN_EPS = 1e-5f, LOG2E = 1.4426950408889634f;
constexpr float SC_A = 0.08838834764831845f * LOG2E;
constexpr float SC_D = 0.125f * LOG2E;
constexpr int NPART = 64;
constexpr int N_PHASES = 1 + 7 * DEPTH;

constexpr size_t MiB = 1u << 20;
constexpr size_t WS_CTL = 0, CTL_ZERO_BYTES = 1 * MiB;
constexpr size_t WS_BIAS = 1 * MiB;
constexpr size_t WS_PART = 2 * MiB;
constexpr size_t WS_WIN = 4 * MiB;
constexpr size_t WS_WOUT = WS_WIN + 192 * MiB;
constexpr size_t WS_WUP = WS_WOUT + 64 * MiB;
constexpr size_t WS_WDN = WS_WUP + 256 * MiB;
constexpr size_t WS_H = WS_WDN + 256 * MiB;
constexpr size_t WS_PROJ = WS_H + 64 * MiB;
constexpr size_t WS_MIX = WS_PROJ + 192 * MiB;
constexpr size_t WS_U = WS_MIX + 64 * MiB;
constexpr size_t WS_Y = WS_U + 256 * MiB;
constexpr size_t WS_END = WS_Y + 128 * MiB;
constexpr int CW_TMO = 0, CW_CODE = 1;
constexpr int CW_LAM = 16;
constexpr int CW_BAR = 4096;

constexpr int RING_OFF = 0, RING_BYTES = 131072;
constexpr int LDSCTL_OFF = 143360, MISC_OFF = LDSCTL_OFF + 320;
constexpr int LDS_BYTES = 147456;
static_assert(MISC_OFF + 128 <= LDS_BYTES, "LDS map");

struct Frame {
    LAS unsigned char* lds;
    volatile LAS unsigned* MISC;
    gu32* ctl;
    int tid, lane, wave;
    int vcu, G;
    const float* x; float* out;
    const float *rel_bias, *g_pre_mix, *w_in, *lq1, *lk1, *lq2, *lk2, *g_subln, *w_out, *g_post_mix, *g_pre_mlp, *w_up, *w_down, *g_post_mlp;
    bf16 *Win_t, *Wout_t, *Wup_t, *Wdn_t;
    bf16 *H, *PROJ, *MIX, *U;
    bf16* Y; float *PART, *BIAS;
};

__device__ __forceinline__ float wave_sum(float v) {
#pragma unroll
    for (int o = 1; o < 64; o <<= 1) v += __shfl_xor(v, o);
    return v;
}
__device__ __forceinline__ int opaque_tid() { int t = threadIdx.x; asm volatile("" : "+v"(t)); return t; }
__device__ __forceinline__ float bflo(unsigned u) { return __uint_as_float(u << 16); }
__device__ __forceinline__ float bfhi(unsigned u) { return __uint_as_float(u & 0xffff0000u); }

__device__ __forceinline__ void p0_transpose_item(const float* W, int K, int N, bf16* WT, LAS float* scr, int item, int lane) {
    const int nblk = N / 32, kb = item / nblk, nb = item % nblk, k0 = 64 * kb, n0 = 32 * nb;
    const GAS float* src = (const GAS float*)W + (size_t)(k0 + (lane >> 5)) * N + n0 + (lane & 31);
    float v[32];
#pragma unroll
    for (int i = 0; i < 32; ++i) v[i] = src[(size_t)(2 * i) * N];
#pragma unroll
    for (int i = 0; i < 32; ++i) scr[(2 * i + (lane >> 5)) * 33 + (lane & 31)] = v[i];
    LDS_WAIT(); asm volatile("" ::: "memory");
    const int c = lane & 7;
#pragma unroll
    for (int j = 0; j < 4; ++j) { const int n = (lane >> 3) + 8 * j; const LAS float* s = scr + (8 * c) * 33 + n;
        v4u o; o.x = pk2(s[0 * 33], s[1 * 33]); o.y = pk2(s[2 * 33], s[3 * 33]); o.z = pk2(s[4 * 33], s[5 * 33]); o.w = pk2(s[6 * 33], s[7 * 33]);
        *(GAS v4u*)(WT + pg8::tiled_w_elem(n0 + n, k0 + 8 * c, K / 64)) = o; }
    LDS_WAIT(); asm volatile("" ::: "memory");
}
__device__ __forceinline__ int t5_bucket(int rel) {
    const int n = rel < 0 ? -rel : rel; int bk;
    if (n < 8) bk = n; else if (n < 15) bk = 8; else if (n < 27) bk = 9; else if (n < 50) bk = 10; else if (n < 91) bk = 11; else if (n < 166) bk = 12; else if (n < 305) bk = 13; else if (n < 559) bk = 14; else bk = 15;
    return bk + (rel > 0 ? 16 : 0);
}
__device__ __forceinline__ void rms_row_to_bf16(const float* xrow, const float* g, bf16* H, int row, int lane) {
    const GAS f32x4* xr = (const GAS f32x4*)xrow + lane; const GAS f32x4* gr = (const GAS f32x4*)g + lane;
    f32x4 v[16]; float s = 0.f;
#pragma unroll
    for (int j = 0; j < 16; ++j) { v[j] = xr[64 * j]; s += (v[j].x * v[j].x + v[j].y * v[j].y) + (v[j].z * v[j].z + v[j].w * v[j].w); }
    const float rstd = 1.f / sqrtf(wave_sum(s) * (1.f / DM) + RMS_EPS);
#pragma unroll
    for (int j = 0; j < 16; ++j) { const f32x4 gg = gr[64 * j];
        *(GAS unsigned long long*)(H + pg8::tiled_elem(row, 4 * (64 * j + lane), DM / 64)) = (unsigned long long)pk2(v[j].x * rstd * gg.x, v[j].y * rstd * gg.y) | ((unsigned long long)pk2(v[j].z * rstd * gg.z, v[j].w * rstd * gg.w) << 32); }
}
__device__ __forceinline__ void p0_prologue(Frame& F) {
    const int tid_ = opaque_tid(), lane_ = tid_ & 63;
    LAS float* scr = (LAS float*)(F.lds + RING_OFF + F.wave * 16384);
    const int gw = F.vcu * NWAVES + F.wave, NGW = F.G * NWAVES;
    constexpr int I_IN = (DM / 64) * (NPROJ / 32), I_OUT = (DM / 64) * (DM / 32), I_UP = (DM / 64) * (DFF / 32), I_DN = (DFF / 64) * (DM / 32);
    constexpr int I_L = I_IN + I_OUT + I_UP + I_DN, NITEMS = DEPTH * I_L;
    for (int it = gw; it < NITEMS; it += NGW) {
        const int l = it / I_L; int r = it % I_L;
        if (r < I_IN) { p0_transpose_item(F.w_in + (size_t)l * DM * NPROJ, DM, NPROJ, F.Win_t + (size_t)l * NPROJ * DM, scr, r, lane_); continue; } r -= I_IN;
        if (r < I_OUT) { p0_transpose_item(F.w_out + (size_t)l * DM * DM, DM, DM, F.Wout_t + (size_t)l * DM * DM, scr, r, lane_); continue; } r -= I_OUT;
        if (r < I_UP) { p0_transpose_item(F.w_up + (size_t)l * DM * DFF, DM, DFF, F.Wup_t + (size_t)l * DFF * DM, scr, r, lane_); continue; } r -= I_UP;
        p0_transpose_item(F.w_down + (size_t)l * DFF * DM, DFF, DM, F.Wdn_t + (size_t)l * DM * DFF, scr, r, lane_);
    }
    for (int m = gw; m < M; m += NGW) rms_row_to_bf16(F.x + (size_t)m * DM, F.g_pre_mix, F.H, m, lane_);
    for (int i = blockIdx.x * (NWAVES * 64) + tid_; i < 32 * 8192; i += F.G * NWAVES * 64) { const int h = i >> 13, rel = (i & 8191) - 4095;
        F.BIAS[i] = (rel <= 4095) ? F.rel_bias[t5_bucket(rel) * 32 + h] * LOG2E : 0.f; }
    if (blockIdx.x == 0 && tid_ < DEPTH) { const int l = tid_; float a = 0.f, b = 0.f;
        for (int i = 0; i < DQ; ++i) { a += F.lq1[l * DQ + i] * F.lk1[l * DQ + i]; b += F.lq2[l * DQ + i] * F.lk2[l * DQ + i]; }
        const float li = 0.8f - 0.6f * expf(-0.3f * (float)l);
        F.ctl[CW_LAM + l] = __float_as_uint(expf(a) - expf(b) + li); }
}
template <bool XIN_BF, bool XOUT_BF> __device__ __forceinline__ void thin_phase(Frame& F, const void* xin, void* xout, const float* g_post, const float* g_next, bool want_h) {
    const int lane_ = opaque_tid() & 63;
    const int gw = F.vcu * NWAVES + F.wave, NGW = F.G * NWAVES;
    for (int row = gw; row < M; row += NGW) {
        const float ssq = wave_sum(F.PART[(size_t)row * NPART + lane_]);
        const float rstd = 1.f / sqrtf(ssq * (1.f / DM) + RMS_EPS);
        const GAS unsigned long long* yr = (const GAS unsigned long long*)(F.Y + (size_t)row * DM) + lane_;
        const GAS f32x4* xr = (const GAS f32x4*)((const float*)xin + (size_t)row * DM) + lane_; const GAS unsigned long long* xrb = (const GAS unsigned long long*)((const bf16*)xin + (size_t)row * DM) + lane_;
        const GAS f32x4* gp = (const GAS f32x4*)g_post + lane_;
        GAS f32x4* xo = (GAS f32x4*)((float*)xout + (size_t)row * DM) + lane_; GAS unsigned long long* xob = (GAS unsigned long long*)((bf16*)xout + (size_t)row * DM) + lane_;
        f32x4 v[16]; float s = 0.f;
#pragma unroll
        for (int j = 0; j < 16; ++j) { const unsigned long long yb = yr[64 * j]; const f32x4 y = {bflo((unsigned)yb), bfhi((unsigned)yb), bflo((unsigned)(yb >> 32)), bfhi((unsigned)(yb >> 32))}; const f32x4 g = gp[64 * j];
            f32x4 xx; if (XIN_BF) { const unsigned long long xb = xrb[64 * j]; xx = (f32x4){bflo((unsigned)xb), bfhi((unsigned)xb), bflo((unsigned)(xb >> 32)), bfhi((unsigned)(xb >> 32))}; } else xx = xr[64 * j];
            v[j] = xx + y * rstd * g;
            if (XOUT_BF) xob[64 * j] = (unsigned long long)pk2(v[j].x, v[j].y) | ((unsigned long long)pk2(v[j].z, v[j].w) << 32); else xo[64 * j] = v[j];
            s += (v[j].x * v[j].x + v[j].y * v[j].y) + (v[j].z * v[j].z + v[j].w * v[j].w); }
        if (want_h) {
            const float r2 = 1.f / sqrtf(wave_sum(s) * (1.f / DM) + RMS_EPS);
            const GAS f32x4* gn = (const GAS f32x4*)g_next + lane_;
#pragma unroll
            for (int j = 0; j < 16; ++j) { const f32x4 gg = gn[64 * j];
                *(GAS unsigned long long*)(F.H + pg8::tiled_elem(row, 4 * (64 * j + lane_), DM / 64)) = (unsigned long long)pk2(v[j].x * r2 * gg.x, v[j].y * r2 * gg.y) | ((unsigned long long)pk2(v[j].z * r2 * gg.z, v[j].w * r2 * gg.w) << 32); }
        }
    }
}
__device__ __forceinline__ void naive_dilated_item(const bf16* proj, bf16* MIX, const float* BIAS, int item, int tid) {
    const int b = item >> 9, h = (item >> 5) & 15, qc = item & 31;
    const int s = qc * 128 + (tid >> 2), quarter = tid & 3;
    const GAS v4u* qp = (const GAS v4u*)(proj + (size_t)(b * SEQ + s) * NPROJ + COL_QA + h * HD);
    unsigned q[64];
#pragma unroll
    for (int i = 0; i < 16; ++i) { const v4u t = qp[i]; q[4 * i] = t.x; q[4 * i + 1] = t.y; q[4 * i + 2] = t.z; q[4 * i + 3] = t.w; }
    float m = -1e30f, l = 0.f; float o[32];
#pragma unroll
    for (int i = 0; i < 32; ++i) o[i] = 0.f;
    const float* bt = BIAS + h * 8192 + 4095;
#pragma unroll 1
    for (int br = 0; br < 3; ++br) { const int dil = br == 0 ? 1 : (br == 1 ? 4 : 16);
#pragma unroll 1
        for (int j = -64; j <= 64; ++j) { const int p = s + j * dil; if (p < 0 || p >= SEQ) continue;
            const GAS v4u* kp = (const GAS v4u*)(proj + (size_t)(b * SEQ + p) * NPROJ + COL_KA + h * HD);
            float dot = 0.f;
#pragma unroll
            for (int i = 0; i < 16; ++i) { const v4u kv = kp[i];
                dot += bflo(q[4 * i]) * bflo(kv.x) + bfhi(q[4 * i]) * bfhi(kv.x); dot += bflo(q[4 * i + 1]) * bflo(kv.y) + bfhi(q[4 * i + 1]) * bfhi(kv.y);
                dot += bflo(q[4 * i + 2]) * bflo(kv.z) + bfhi(q[4 * i + 2]) * bfhi(kv.z); dot += bflo(q[4 * i + 3]) * bflo(kv.w) + bfhi(q[4 * i + 3]) * bfhi(kv.w); }
            const float sc = dot + bt[j * dil];
            if (sc > m) { const float a = exp2f(m - sc); l *= a;
#pragma unroll
                for (int i = 0; i < 32; ++i) o[i] *= a;
                m = sc; }
            const float pe = exp2f(sc - m); l += pe;
            const GAS v4u* vp = (const GAS v4u*)(proj + (size_t)(b * SEQ + p) * NPROJ + COL_VA + h * HD + quarter * 32);
#pragma unroll
            for (int i = 0; i < 4; ++i) { const v4u vv = vp[i];
                o[8 * i + 0] += pe * bflo(vv.x); o[8 * i + 1] += pe * bfhi(vv.x); o[8 * i + 2] += pe * bflo(vv.y); o[8 * i + 3] += pe * bfhi(vv.y);
                o[8 * i + 4] += pe * bflo(vv.z); o[8 * i + 5] += pe * bfhi(vv.z); o[8 * i + 6] += pe * bflo(vv.w); o[8 * i + 7] += pe * bfhi(vv.w); }
        } }
    const float inv = 1.f / l;
    GAS v4u* op = (GAS v4u*)(MIX + (size_t)(b * SEQ + s) * DM + h * HD + quarter * 32);
#pragma unroll
    for (int i = 0; i < 4; ++i) { v4u w; w.x = pk2(o[8 * i] * inv, o[8 * i + 1] * inv); w.y = pk2(o[8 * i + 2] * inv, o[8 * i + 3] * inv); w.z = pk2(o[8 * i + 4] * inv, o[8 * i + 5] * inv); w.w = pk2(o[8 * i + 6] * inv, o[8 * i + 7] * inv); op[i] = w; }
}
__device__ __forceinline__ void naive_diff_item(const bf16* proj, bf16* MIX, const float* BIAS, const float* g_subln, float lam, int item, int layer, int tid) {
    const int b = item >> 10, h = (item >> 6) & 15, qc = item & 63;
    const int s = qc * 64 + (tid >> 3), oct = tid & 7;
    const GAS v4u* qp = (const GAS v4u*)(proj + (size_t)(b * SEQ + s) * NPROJ + COL_QD + h * HD);
    unsigned q[64];
#pragma unroll
    for (int i = 0; i < 16; ++i) { const v4u t = qp[i]; q[4 * i] = t.x; q[4 * i + 1] = t.y; q[4 * i + 2] = t.z; q[4 * i + 3] = t.w; }
    float m0 = -1e30f, l0 = 0.f, m1 = -1e30f, l1 = 0.f; float o0[16], o1[16];
#pragma unroll
    for (int i = 0; i < 16; ++i) { o0[i] = 0.f; o1[i] = 0.f; }
    const float* bt = BIAS + (NHA + h) * 8192 + 4095 - s;
    const bf16* kbase = proj + (size_t)(b * SEQ) * NPROJ + COL_KD + h * HD; const bf16* vbase = proj + (size_t)(b * SEQ) * NPROJ + COL_VD + h * HD + oct * 16;
#pragma unroll 1
    for (int p = 0; p < SEQ; ++p) {
        const GAS v4u* kp = (const GAS v4u*)(kbase + (size_t)p * NPROJ);
        float d0 = 0.f, d1 = 0.f;
#pragma unroll
        for (int i = 0; i < 8; ++i) { const v4u kv = kp[i];
            d0 += bflo(q[4 * i]) * bflo(kv.x) + bfhi(q[4 * i]) * bfhi(kv.x); d0 += bflo(q[4 * i + 1]) * bflo(kv.y) + bfhi(q[4 * i + 1]) * bfhi(kv.y);
            d0 += bflo(q[4 * i + 2]) * bflo(kv.z) + bfhi(q[4 * i + 2]) * bfhi(kv.z); d0 += bflo(q[4 * i + 3]) * bflo(kv.w) + bfhi(q[4 * i + 3]) * bfhi(kv.w); }
#pragma unroll
        for (int i = 8; i < 16; ++i) { const v4u kv = kp[i];
            d1 += bflo(q[4 * i]) * bflo(kv.x) + bfhi(q[4 * i]) * bfhi(kv.x); d1 += bflo(q[4 * i + 1]) * bflo(kv.y) + bfhi(q[4 * i + 1]) * bfhi(kv.y);
            d1 += bflo(q[4 * i + 2]) * bflo(kv.z) + bfhi(q[4 * i + 2]) * bfhi(kv.z); d1 += bflo(q[4 * i + 3]) * bflo(kv.w) + bfhi(q[4 * i + 3]) * bfhi(kv.w); }
        const float bias = bt[p]; const float s0 = d0 + bias, s1 = d1 + bias;
        if (s0 > m0) { const float a = exp2f(m0 - s0); l0 *= a;
#pragma unroll
            for (int i = 0; i < 16; ++i) o0[i] *= a;
            m0 = s0; }
        if (s1 > m1) { const float a = exp2f(m1 - s1); l1 *= a;
#pragma unroll
            for (int i = 0; i < 16; ++i) o1[i] *= a;
            m1 = s1; }
        const float p0 = exp2f(s0 - m0), p1 = exp2f(s1 - m1); l0 += p0; l1 += p1;
        const GAS v4u* vp = (const GAS v4u*)(vbase + (size_t)p * NPROJ);
#pragma unroll
        for (int i = 0; i < 2; ++i) { const v4u vv = vp[i]; const float v0 = bflo(vv.x), v1 = bfhi(vv.x), v2 = bflo(vv.y), v3 = bfhi(vv.y), v4 = bflo(vv.z), v5 = bfhi(vv.z), v6 = bflo(vv.w), v7 = bfhi(vv.w);
            o0[8 * i + 0] += p0 * v0; o0[8 * i + 1] += p0 * v1; o0[8 * i + 2] += p0 * v2; o0[8 * i + 3] += p0 * v3; o0[8 * i + 4] += p0 * v4; o0[8 * i + 5] += p0 * v5; o0[8 * i + 6] += p0 * v6; o0[8 * i + 7] += p0 * v7;
            o1[8 * i + 0] += p1 * v0; o1[8 * i + 1] += p1 * v1; o1[8 * i + 2] += p1 * v2; o1[8 * i + 3] += p1 * v3; o1[8 * i + 4] += p1 * v4; o1[8 * i + 5] += p1 * v5; o1[8 * i + 6] += p1 * v6; o1[8 * i + 7] += p1 * v7; }
    }
    const float li = 0.8f - 0.6f * expf(-0.3f * (float)layer);
    const float i0 = 1.f / l0, i1 = lam / l1; float ssq = 0.f;
#pragma unroll
    for (int i = 0; i < 16; ++i) { o0[i] = o0[i] * i0 - o1[i] * i1; ssq += o0[i] * o0[i]; }
    ssq += __shfl_xor(ssq, 1); ssq += __shfl_xor(ssq, 2); ssq += __shfl_xor(ssq, 4);
    const float r = (1.f - li) / sqrtf(ssq * (1.f / HD) + SUBLN_EPS);
    const float* g = g_subln + layer * HD + oct * 16;
    GAS v4u* op = (GAS v4u*)(MIX + (size_t)(b * SEQ + s) * DM + DILW + h * HD + oct * 16);
#pragma unroll
    for (int i = 0; i < 2; ++i) { v4u w; w.x = pk2(o0[8 * i] * r * g[8 * i], o0[8 * i + 1] * r * g[8 * i + 1]); w.y = pk2(o0[8 * i + 2] * r * g[8 * i + 2], o0[8 * i + 3] * r * g[8 * i + 3]);
        w.z = pk2(o0[8 * i + 4] * r * g[8 * i + 4], o0[8 * i + 5] * r * g[8 * i + 5]); w.w = pk2(o0[8 * i + 6] * r * g[8 * i + 6], o0[8 * i + 7] * r * g[8 * i + 7]); op[i] = w; }
}

constexpr int DIL_V_OFF = 0, DIL_T_OFF = 131072;
__device__ __forceinline__ void dilated_phase(Frame& F, unsigned char* ws) {
    const int tid_ = opaque_tid(), lane_ = tid_ & 63;
    bf16* part_o = (bf16*)(ws + WS_U); float* part_ml = (float*)(ws + WS_U + (size_t)M * 16 * 2 * 128 * 2);
    LAS unsigned char* vl = F.lds + DIL_V_OFF + F.wave * 16384; LAS float* tsub = (LAS float*)(F.lds + DIL_T_OFF);
    for (int item = blockIdx.x; item < 256; item += F.G) {
        const int xg = item & 7, jj = item >> 3, bh = 4 * xg + (jj >> 3), b = bh >> 4, h = bh & 15, c = jj & 7, P0 = c * 512;
        __syncthreads();
        for (int i = tid_; i < 576; i += NWAVES * 64) { const int br = i / 192, rel = (i % 192) - 96, d = br == 0 ? 1 : (br == 1 ? 4 : 16);
            tsub[i] = (rel >= -64 && rel <= 64) ? F.BIAS[h * 8192 + 4095 + rel * d] : -1e30f; }
        __syncthreads();
#pragma unroll 1
        for (int k = 0; k < 4; ++k) { const int wi = F.wave + 8 * k, is4 = wi >> 4, sub = wi & 15;
            const int dil = is4 ? 4 : 16, res = is4 ? (sub & 3) : sub, tq0 = is4 ? P0 / 4 + 32 * (sub >> 2) : P0 / 16;
            att::dilated_wave_item<0>(F.PROJ, part_o, part_ml, F.MIX, vl, tsub + (is4 ? 192 : 384), b, h, dil, res, tq0, is4, lane_); }
        asm volatile("s_waitcnt vmcnt(0)" ::: "memory");
        __syncthreads();
#pragma unroll 1
        for (int k = 0; k < 2; ++k) { const int sub = F.wave + 8 * k;
            att::dilated_wave_item<1>(F.PROJ, part_o, part_ml, F.MIX, vl, tsub, b, h, 1, 0, P0 + 32 * sub, 0, lane_); }
        asm volatile("s_waitcnt vmcnt(0)" ::: "memory");
    }
}

#define IN(k) (lo <= (k) && (k) < hi)
#define SEAM(k) do { if (IN(k) && IN((k) + 1)) xcd_barrier(bar); } while (0)
template <int l> __device__ __forceinline__ void layer_phases(Frame& F, const XcdBarrier& bar, const int lo, const int hi) {
        const int pb = 1 + 7 * l;
        if (IN(pb + 0)) {
            pg8::Gemm g{F.H, F.Win_t + (size_t)l * NPROJ * DM, M, NPROJ, DM}; pg8::StaticOrder S; S.init(M, NPROJ, F.G, (int)blockIdx.x);
            pg8::EpiBf16s<0> E{F.PROJ, NPROJ, COL_KA, COL_QD, COL_KD, SC_A, SC_D, 0};
            for (int dup_ = 0; dup_ < DUPN(2); ++dup_) pg8::gemm_phase<pg8::EpiBf16s<0>, pg8::StaticOrder, PG8_ALIGN, PG8_SP2>(F.lds + RING_OFF, g, S, E);
            SEAM(pb + 0);
        }
        if (IN(pb + 1)) {
            for (int dup_ = 0; dup_ < DUPN(3); ++dup_) dilated_phase(F, (unsigned char*)F.Y - WS_Y);
            { const float lam = __uint_as_float(__hip_atomic_load(F.ctl + CW_LAM + l, RLX_AGENT)); const float post = 1.f - (0.8f - 0.6f * expf(-0.3f * (float)l));
              for (int dup_ = 0; dup_ < DUPN(4); ++dup_) for (int u = blockIdx.x; u < 1024; u += F.G) { const int j = u >> 3, bh = (u & 7) * 4 + (j >> 5), qb = j & 31;
                  att::diff_unit<0>(F.PROJ, F.MIX, F.BIAS, F.g_subln + l * HD, lam, post, F.lds, bh >> 4, bh & 15, qb, opaque_tid()); }
              if (PROBE_GV > 0) for (int u = blockIdx.x; u < 1024; u += F.G) { const int j = u >> 3, bh = (u & 7) * 4 + (j >> 5), qb = j & 31;
                  att::diff_unit<PROBE_GV>(F.PROJ, F.MIX, F.BIAS, F.g_subln + l * HD, lam, post, F.lds, bh >> 4, bh & 15, qb, opaque_tid()); }
              __syncthreads(); }
            SEAM(pb + 1);
        }
        if (IN(pb + 2)) {
            pg8::Gemm g{F.MIX, F.Wout_t + (size_t)l * DM * DM, M, DM, DM}; pg8::StaticOrder S; S.init(M, DM, F.G, (int)blockIdx.x);
            pg8::EpiBf16Ssq E{F.Y, DM, F.PART, NPART};
            for (int dup_ = 0; dup_ < DUPN(5); ++dup_) pg8::gemm_phase<pg8::EpiBf16Ssq, pg8::StaticOrder, PG8_ALIGN, PG8_SP2>(F.lds + RING_OFF, g, S, E);
            SEAM(pb + 2);
        }
        if (IN(pb + 3)) { bf16* XB = (bf16*)((unsigned char*)F.Y + 64 * MiB);
            if (l == 0) thin_phase<false, true>(F, F.x, XB, F.g_post_mix + l * DM, F.g_pre_mlp + l * DM, true); else thin_phase<true, true>(F, XB, XB, F.g_post_mix + l * DM, F.g_pre_mlp + l * DM, true);
            SEAM(pb + 3); }
        if (IN(pb + 4)) {
            pg8::Gemm g{F.H, F.Wup_t + (size_t)l * DFF * DM, M, DFF, DM}; pg8::StaticOrder S; S.init(M, DFF, F.G, (int)blockIdx.x);
            pg8::EpiBf16s<1> E{F.U, DFF, 0, 0, 0, 1.f, 1.f, DFF / 64};
            for (int dup_ = 0; dup_ < DUPN(6); ++dup_) pg8::gemm_phase<pg8::EpiBf16s<1>, pg8::StaticOrder, PG8_ALIGN, PG8_SP2>(F.lds + RING_OFF, g, S, E);
            if (PROBE_GG > 0) { pg8::EpiBf16s<1> Eg{(bf16*)((unsigned char*)F.Y - WS_Y + WS_END), DFF, 0, 0, 0, 1.f, 1.f};
                if (PROBE_GG == 5) { pg8::Gemm gp = g; gp.lda = DM + 64; gp.ldb = DM + 64; pg8::gemm_phase<pg8::EpiBf16s<1>, pg8::StaticOrder, PG8_ALIGN, PG8_SP2>(F.lds + RING_OFF, gp, S, Eg); }
                else if (PROBE_GG == 1) pg8::gemm_phase<pg8::EpiBf16s<1>, pg8::StaticOrder, PG8_ALIGN, PG8_SP2>(F.lds + RING_OFF, g, S, Eg);
                else { pg8::FixedOrder Sf; Sf.init(M, DFF, F.G, (int)blockIdx.x); Sf.mode = PROBE_GG; pg8::gemm_phase<pg8::EpiBf16s<1>, pg8::FixedOrder, PG8_ALIGN, PG8_SP2>(F.lds + RING_OFF, g, Sf, Eg); } }
            SEAM(pb + 4);
        }
        if (IN(pb + 5)) {
            pg8::Gemm g{F.U, F.Wdn_t + (size_t)l * DM * DFF, M, DM, DFF}; pg8::StaticOrder S; S.init(M, DM, F.G, (int)blockIdx.x);
            pg8::EpiBf16Ssq E{F.Y, DM, F.PART, NPART};
            for (int dup_ = 0; dup_ < DUPN(7); ++dup_) pg8::gemm_phase<pg8::EpiBf16Ssq, pg8::StaticOrder, PG8_ALIGN, PG8_SP2>(F.lds + RING_OFF, g, S, E);
            SEAM(pb + 5);
        }
        if (IN(pb + 6)) { bf16* XB = (bf16*)((unsigned char*)F.Y + 64 * MiB);
            if (l + 1 < DEPTH) thin_phase<true, true>(F, XB, XB, F.g_post_mlp + l * DM, F.g_pre_mix + (l + 1) * DM, true); else thin_phase<true, false>(F, XB, F.out, F.g_post_mlp + l * DM, F.g_post_mlp + l * DM, false);
            SEAM(pb + 6); }
    }
#undef IN
#undef SEAM

struct Args { const float* in[15]; float* out; unsigned char* ws; int ph_lo, ph_hi, pad0, pad1; };
__global__ void __launch_bounds__(NWAVES * 64, 2) mk_fwd(Args args) {
    extern __shared__ __attribute__((aligned(16))) unsigned char lds[];
    Frame F;
    F.lds = (LAS unsigned char*)lds;
    F.MISC = (volatile LAS unsigned*)(F.lds + MISC_OFF);
    F.tid = threadIdx.x; F.lane = F.tid & 63; F.wave = __builtin_amdgcn_readfirstlane(F.tid >> 6);
    F.G = gridDim.x; { const int bx = blockIdx.x; F.vcu = (F.G % 8 == 0) ? (bx % 8) * (F.G / 8) + bx / 8 : bx; }
    unsigned char* ws = args.ws;
    F.ctl = (gu32*)(ws + WS_CTL);
    F.x = args.in[0]; F.rel_bias = args.in[1]; F.g_pre_mix = args.in[2]; F.w_in = args.in[3]; F.lq1 = args.in[4]; F.lk1 = args.in[5]; F.lq2 = args.in[6]; F.lk2 = args.in[7];
    F.g_subln = args.in[8]; F.w_out = args.in[9]; F.g_post_mix = args.in[10]; F.g_pre_mlp = args.in[11]; F.w_up = args.in[12]; F.w_down = args.in[13]; F.g_post_mlp = args.in[14];
    F.out = args.out;
    F.Win_t = (bf16*)(ws + WS_WIN); F.Wout_t = (bf16*)(ws + WS_WOUT); F.Wup_t = (bf16*)(ws + WS_WUP); F.Wdn_t = (bf16*)(ws + WS_WDN);
    F.H = (bf16*)(ws + WS_H); F.PROJ = (bf16*)(ws + WS_PROJ); F.MIX = (bf16*)(ws + WS_MIX); F.U = (bf16*)(ws + WS_U);
    F.Y = (bf16*)(ws + WS_Y); F.PART = (float*)(ws + WS_PART); F.BIAS = (float*)(ws + WS_BIAS);
    for (int u = F.tid; u < (LDS_BYTES - LDSCTL_OFF) / 4; u += NWAVES * 64) ((LAS unsigned*)(F.lds + LDSCTL_OFF))[u] = 0u;
    __syncthreads();
    XcdBarrier bar; bar.bar = (unsigned*)(F.ctl + CW_BAR); bar.x = 0; bar.st = nullptr;
    const bool one = (args.ph_hi - args.ph_lo) > 1;
    if (one) bar = xcd_barrier_post((unsigned*)(F.ctl + CW_BAR), F.MISC + 8);
    const int lo = args.ph_lo, hi = args.ph_hi;
#define IN(k) (lo <= (k) && (k) < hi)
#define SEAM(k) do { if (IN(k) && IN((k) + 1)) xcd_barrier(bar); } while (0)

    if (PROBE_CLK > 0 && IN(0)) {
        const int w_ = F.wave;
        if (PROBE_CLK != 9 || w_ < 4) {
            if (PROBE_CLK == 8 && w_ >= 4) __builtin_amdgcn_s_setprio(1);
            att::f32x16 a0 = {}, a1 = {}, a2 = {}, a3 = {}; att::bf16x8 x = {0x3f80, 0x4000, 0x3fc0, 0x4040, 0x3f80, 0x4000, 0x3fc0, 0x4040}, y = {0x3f80, 0x3f00, 0x3e80, 0x3f80, 0x3f80, 0x3f00, 0x3e80, 0x3f80}; asm volatile("" : "+v"(x), "+v"(y));
            float v0 = (float)threadIdx.x, v1 = v0 + 1.f, v2 = v0 + 2.f, v3 = v0 + 3.f, v4 = v0 + 4.f, v5 = v0 + 5.f; const float c = 0.999f;
#define PC_V6() do { v0 = fmaf(v0, c, 0.5f); v1 = fmaf(v1, c, 0.5f); v2 = fmaf(v2, c, 0.5f); if (PROBE_CLK != 7) { v3 = fmaf(v3, c, 0.5f); v4 = fmaf(v4, c, 0.5f); v5 = fmaf(v5, c, 0.5f); } } while (0)
#pragma unroll 1
            for (int i = 0; i < 6250; ++i) {
                a0 = __builtin_amdgcn_mfma_f32_32x32x16_bf16(x, y, a0, 0, 0, 0); PC_V6(); __builtin_amdgcn_sched_barrier(0);
                a1 = __builtin_amdgcn_mfma_f32_32x32x16_bf16(x, y, a1, 0, 0, 0); PC_V6(); __builtin_amdgcn_sched_barrier(0);
                a2 = __builtin_amdgcn_mfma_f32_32x32x16_bf16(x, y, a2, 0, 0, 0); PC_V6(); __builtin_amdgcn_sched_barrier(0);
                a3 = __builtin_amdgcn_mfma_f32_32x32x16_bf16(x, y, a3, 0, 0, 0); PC_V6(); __builtin_amdgcn_sched_barrier(0); }
#undef PC_V6
            if (a0[0] + a1[1] + a2[2] + a3[3] + v0 + v1 + v2 + v3 + v4 + v5 == -1.2345f) F.out[threadIdx.x] = 0.f;
            if (PROBE_CLK == 8 && w_ >= 4) __builtin_amdgcn_s_setprio(0); }
        __syncthreads(); }
    if (IN(0)) { for (int dup_ = 0; dup_ < DUPN(1); ++dup_) p0_prologue(F); SEAM(0); for (int eb_ = 0; eb_ < PROBE_BAR; ++eb_) xcd_barrier(bar); }

    layer_phases<0>(F, bar, lo, hi);
    layer_phases<1>(F, bar, lo, hi);
#undef IN
#undef SEAM
}

extern "C" void kernel_launch(void* const* d_in, const int* in_sizes, int n_in, void* d_out, int out_size, void* d_ws, size_t ws_size, hipStream_t stream) {
    static int grid = 0;
    if (grid == 0) {
        if (n_in != 15 || in_sizes[0] != M * DM || out_size != M * DM || ws_size < WS_END) { fprintf(stderr, "kernel_launch: shape mismatch (n_in %d, in0 %d, out %d, ws %zu < %zu); nothing launched\n", n_in, n_in > 0 ? in_sizes[0] : -1, out_size, ws_size, (size_t)WS_END); grid = -1; return; }
        int dev = 0, cus = 0, per_cu = 0;
        if (hipGetDevice(&dev) != hipSuccess || hipDeviceGetAttribute(&cus, hipDeviceAttributeMultiprocessorCount, dev) != hipSuccess) { grid = -1; return; }
        if (hipFuncSetAttribute((const void*)mk_fwd, hipFuncAttributeMaxDynamicSharedMemorySize, LDS_BYTES) != hipSuccess) { fprintf(stderr, "kernel_launch: hipFuncSetAttribute failed\n"); grid = -1; return; }
        if (hipOccupancyMaxActiveBlocksPerMultiprocessor(&per_cu, (const void*)mk_fwd, NWAVES * 64, LDS_BYTES) != hipSuccess || per_cu < 1)
            fprintf(stderr, "kernel_launch: note: occupancy query reports %d workgroups per CU\n", per_cu);
        (void)hipGetLastError();
        grid = cus;
    }
    if (grid < 0) return;
    if (hipMemsetAsync((char*)d_ws + WS_CTL, 0, CTL_ZERO_BYTES, stream) != hipSuccess) { fprintf(stderr, "kernel_launch: memset failed\n"); return; }
    Args a{};
    for (int i = 0; i < 15; ++i) a.in[i] = (const float*)d_in[i];
    a.out = (float*)d_out; a.ws = (unsigned char*)d_ws; a.pad0 = 0; a.pad1 = 0;
#if MK_ONE_LAUNCH
    a.ph_lo = 0; a.ph_hi = N_PHASES;
    hipLaunchKernelGGL(mk_fwd, dim3(grid), dim3(NWAVES * 64), LDS_BYTES, stream, a);
#else
    for (int p = 0; p < N_PHASES; ++p) {
        a.ph_lo = p; a.ph_hi = p + 1; hipLaunchKernelGGL(mk_fwd, dim3(grid), dim3(NWAVES * 64), LDS_BYTES, stream, a); }
#endif
    const hipError_t le = hipPeekAtLastError();
    if (le != hipSuccess) fprintf(stderr, "kernel_launch: launch failed: %s\n", hipGetErrorName(le));
}
```

```cpp
#include <hip/hip_runtime.h>
#include <cstdio>
#include <cstdint>
namespace pg8 {
#define PG8_LAS __attribute__((address_space(3)))
typedef unsigned short bf16_t;
typedef short bf16x8 __attribute__((ext_vector_type(8)));
typedef float f32x4 __attribute__((ext_vector_type(4)));
typedef unsigned u32x4 __attribute__((ext_vector_type(4)));
constexpr int BM = 256, BK = 64, HALF = 128, HTB = HALF * BK * 2  , STAGE_BYTES = 8 * HTB, NXCD = 8, WGM = 8;

__host__ __device__ __forceinline__ int lds_byte(int r, int c) { const int st = (r >> 4) * 2 + (c >> 5), rr = r & 15, cc = c & 31, ob = rr * 64 + cc * 2; return st * 1024 + (ob ^ (((ob >> 9) & 1) << 5)); }
__host__ __device__ __forceinline__ void stage_rc(int b, int& R, int& C) { const int st = b / 1024, sb = b % 1024, swz = sb ^ (((sb >> 9) & 1) << 5); R = (st >> 1) * 16 + swz / 64; C = (st & 1) * 32 + (swz % 64) / 2; }
__host__ __device__ __forceinline__ int perm32(int rho) { const int n = rho >> 4, i = rho & 15; return 8 * (i >> 2) + 4 * n + (i & 3); }

__host__ __device__ __forceinline__ size_t tiled_elem(int row, int col, int nKt) { return ((((size_t)(row >> 8) * nKt + (col >> 6)) * 2 + ((row >> 7) & 1)) * 8192) + (size_t)(lds_byte(row & 127, col & 63) >> 1); }
__host__ __device__ __forceinline__ int inv_perm32(int v) { return 16 * ((v >> 2) & 1) + 4 * (v >> 3) + (v & 3); }
__host__ __device__ __forceinline__ size_t tiled_w_elem(int n, int k, int nKt) { const int nl = n & 127, R = (nl & ~31) + inv_perm32(nl & 31); return ((((size_t)(n >> 8) * nKt + (k >> 6)) * 2 + ((n >> 7) & 1)) * 8192) + (size_t)(lds_byte(R, k & 63) >> 1); }

struct Unit { int pm, pn; };
struct Gemm { const bf16_t* A; const bf16_t* Bt; int M, N, K; int lda = 0, ldb = 0; };

struct StaticOrder {
    int nM, nN, nwg, G, c;
    __host__ __device__ void init(int M, int N, int G_, int c_) { nM = M / BM; nN = N / BM; nwg = nM * nN; G = G_; c = c_; }
    __host__ __device__ bool next(int i, Unit& u) const {
        const long L = (long)i * G + c; if (L >= nwg) return false;
        int wgid = (int)L; { const int q = nwg / NXCD, r = nwg % NXCD, xcd = wgid % NXCD, off = wgid / NXCD; wgid = (xcd < r ? xcd * (q + 1) : r * (q + 1) + (xcd - r) * q) + off; }
        const int nig = WGM * nN, gid = wgid / nig, fm = gid * WGM, gsz = (nM - fm) < WGM ? (nM - fm) : WGM;
        u.pm = fm + ((wgid % nig) % gsz); u.pn = (wgid % nig) / gsz; return true;
    }
    __device__ __forceinline__ void a_ready(const Unit&) const {}
    __device__ __forceinline__ void done(const Unit&) const {}
};

__device__ __forceinline__ unsigned cvt_pk_bf16(float lo, float hi) { unsigned r; asm volatile("v_cvt_pk_bf16_f32 %0, %1, %2" : "=v"(r) : "v"(lo), "v"(hi)); return r; }
typedef float f32x2 __attribute__((ext_vector_type(2)));
template <int MODE> struct EpiBf16s {
    static constexpr bool PERM = true, AFTER_DRAIN = false;
    bf16_t* O; int ldc; int qa_end, qd_lo, qd_hi; float sc_a, sc_d; int tiled_nkt;
    __device__ __forceinline__ void operator()(const f32x4 (&acc)[2][2][4][2], const Unit& u, int wr, int wc, int fr, int fq) const {
        const int row0 = u.pm * BM + wr * 64 + fr; const int colt = u.pn * BM;
        float sc = 1.f; if (MODE == 0) { if (colt < qa_end) sc = sc_a; else if (colt >= qd_lo && colt < qd_hi) sc = sc_d; }
        const int col0 = colt + wc * 32 + 8 * fq;
        bf16_t* tb_ = O + ((size_t)(u.pm * tiled_nkt + (colt >> 6) + (wc >> 1)) * 2) * 8192 + (wr * 4 * 2 + (wc & 1)) * 512 + (((fr * 64 + fq * 16) ^ ((((fr * 64 + fq * 16) >> 9) & 1) << 5)) >> 1);
#pragma unroll
        for (int ai = 0; ai < 2; ++ai)
#pragma unroll
            for (int m = 0; m < 4; ++m) { bf16_t* rowp = O + (size_t)(row0 + ai * HALF + m * 16) * ldc + col0;
#pragma unroll
                for (int bj = 0; bj < 2; ++bj) { f32x4 v0 = acc[ai][bj][m][0], v1 = acc[ai][bj][m][1];
                    if (MODE == 1) {
#pragma unroll
                        for (int e = 0; e < 4; ++e) { const float a = fmaxf(v0[e], 0.f), b = fmaxf(v1[e], 0.f); v0[e] = a * a; v1[e] = b * b; }
                    } else { v0 = v0 * sc; v1 = v1 * sc; }
                    u32x4 w; w.x = cvt_pk_bf16(v0[0], v0[1]); w.y = cvt_pk_bf16(v0[2], v0[3]); w.z = cvt_pk_bf16(v1[0], v1[1]); w.w = cvt_pk_bf16(v1[2], v1[3]);
                    if (tiled_nkt) *(u32x4*)(tb_ + (size_t)(bj * 2 * 2 + ai) * 8192 + m * 1024) = w; else *(u32x4*)(rowp + bj * HALF) = w; } }
    }
};
struct EpiF32Ssq {
    static constexpr bool PERM = false, AFTER_DRAIN = false;
    float* C; int ldc; float* part; int npart;
    __device__ __forceinline__ void operator()(const f32x4 (&acc)[2][2][4][2], const Unit& u, int wr, int wc, int fr, int fq) const {
        const int row0 = u.pm * BM + wr * 64 + fr, col0 = u.pn * BM + wc * 32 + 4 * fq;
#pragma unroll
        for (int ai = 0; ai < 2; ++ai)
#pragma unroll
            for (int m = 0; m < 4; ++m) { const int row = row0 + ai * HALF + m * 16; float* rowp = C + (size_t)row * ldc + col0; float s = 0.f;
#pragma unroll
                for (int bj = 0; bj < 2; ++bj)
#pragma unroll
                    for (int n = 0; n < 2; ++n) { const f32x4 x = acc[ai][bj][m][n]; *(f32x4*)(rowp + bj * HALF + n * 16) = x; s += (x[0] * x[0] + x[1] * x[1]) + (x[2] * x[2] + x[3] * x[3]); }
                s += __shfl_xor(s, 16); s += __shfl_xor(s, 32);
                if (fq == 0) part[(size_t)row * npart + u.pn * 4 + wc] = s; }
    }
};

struct EpiBf16Ssq {
    static constexpr bool PERM = true, AFTER_DRAIN = false;
    bf16_t* C; int ldc; float* part; int npart;
    __device__ __forceinline__ void operator()(const f32x4 (&acc)[2][2][4][2], const Unit& u, int wr, int wc, int fr, int fq) const {
        const int row0 = u.pm * BM + wr * 64 + fr, col0 = u.pn * BM + wc * 32 + 8 * fq;
#pragma unroll
        for (int ai = 0; ai < 2; ++ai)
#pragma unroll
            for (int m = 0; m < 4; ++m) { const int row = row0 + ai * HALF + m * 16; bf16_t* rowp = C + (size_t)row * ldc + col0; float s = 0.f;
#pragma unroll
                for (int bj = 0; bj < 2; ++bj) { const f32x4 v0 = acc[ai][bj][m][0], v1 = acc[ai][bj][m][1];
                    s += (v0[0] * v0[0] + v0[1] * v0[1]) + (v0[2] * v0[2] + v0[3] * v0[3]) + (v1[0] * v1[0] + v1[1] * v1[1]) + (v1[2] * v1[2] + v1[3] * v1[3]);
                    u32x4 w; w.x = cvt_pk_bf16(v0[0], v0[1]); w.y = cvt_pk_bf16(v0[2], v0[3]); w.z = cvt_pk_bf16(v1[0], v1[1]); w.w = cvt_pk_bf16(v1[2], v1[3]);
                    *(u32x4*)(rowp + bj * HALF) = w; }
                s += __shfl_xor(s, 16); s += __shfl_xor(s, 32);
                if (fq == 0) part[(size_t)row * npart + u.pn * 4 + wc] = s; }
    }
};
struct FixedOrder : StaticOrder { int mode;
    __host__ __device__ bool next(int i, Unit& u) const { const long L = (long)i * G + c; if (L >= nwg) return false; if (mode == 2) { u.pm = 0; u.pn = 0; } else { u.pm = c % 8; u.pn = (c / 8) % 2; } return true; }
};
template <class Epi, class Sched, bool ALIGN_EPI = false, bool SP2 = false>
__device__ __forceinline__ void gemm_phase(PG8_LAS unsigned char* lds, const Gemm g, const Sched& S, const Epi& E) {
    int tid = threadIdx.x; asm volatile("" : "+v"(tid)); const int wid = __builtin_amdgcn_readfirstlane(tid >> 6), lane = tid & 63, wr = wid >> 2, wc = wid & 3, fr = lane & 15, fq = lane >> 4;
    static_assert(Epi::PERM, "the weight image has the perm32 row order baked in");
    const int K = g.K, nt = K / BK;
    unsigned voffA[2], voffB[2];
#pragma unroll
    for (int i = 0; i < 2; ++i) { voffA[i] = (unsigned)(tid * 16 + i * 8192); voffB[i] = voffA[i]; }
    const size_t kstep = 32768;
    const size_t hstepA = 16384, hstepB = 16384;
    const size_t tstepA = (size_t)nt * 32768, tstepB = tstepA;
    const unsigned ldsw = (unsigned)wid * 1024u;
    const int aoff = lds_byte(wr * 64 + fr, fq * 8), boff = lds_byte(wc * 32 + fr, fq * 8);
#define PG8_SA(b, h) (((b) * 2 + (h)) * HTB)
#define PG8_SB(b, h) ((4 + (b) * 2 + (h)) * HTB)
#define PG8_STAGE(bufoff, gbase, voff) do { _Pragma("unroll") for (int _i = 0; _i < 2; ++_i) \
        __builtin_amdgcn_global_load_lds((const unsigned*)((const char*)(gbase) + (voff)[_i]), (PG8_LAS unsigned*)(lds + (bufoff) + ldsw + _i * 8192), 16, 0, 0); } while (0)
#define PG8_LDA(dst, b, h) do { _Pragma("unroll") for (int m = 0; m < 4; ++m) _Pragma("unroll") for (int k = 0; k < 2; ++k) dst[m][k] = *(const PG8_LAS bf16x8*)(lds + PG8_SA(b, h) + aoff + m * 2048 + k * 1024); } while (0)
#define PG8_LDB(dst, b, h) do { _Pragma("unroll") for (int n = 0; n < 2; ++n) _Pragma("unroll") for (int k = 0; k < 2; ++k) dst[n][k] = *(const PG8_LAS bf16x8*)(lds + PG8_SB(b, h) + boff + n * 2048 + k * 1024); } while (0)
#define PG8_MMA(ai, bj, At, Bt) do { __builtin_amdgcn_s_setprio(1); _Pragma("unroll") for (int m = 0; m < 4; ++m) _Pragma("unroll") for (int n = 0; n < 2; ++n) _Pragma("unroll") for (int k = 0; k < 2; ++k) \
        acc[ai][bj][m][n] = __builtin_amdgcn_mfma_f32_16x16x32_bf16(Bt[n][k], At[m][k], acc[ai][bj][m][n], 0, 0, 0); __builtin_amdgcn_s_setprio(0); } while (0)
#define PG8_WAIT_V(n) asm volatile("s_waitcnt vmcnt(" #n ")" ::: "memory")
#define PG8_WAIT_L(n) asm volatile("s_waitcnt lgkmcnt(" #n ")" ::: "memory")
#define PG8_BAR __builtin_amdgcn_s_barrier()
#define PG8_SCHED __builtin_amdgcn_sched_barrier(0)
    Unit cur, nxt; int ui = 0;
    if (!S.next(0, cur)) return;
    f32x4 acc[2][2][4][2];
#pragma unroll
    for (int a = 0; a < 2; ++a)
#pragma unroll
        for (int b = 0; b < 2; ++b)
#pragma unroll
            for (int m = 0; m < 4; ++m)
#pragma unroll
                for (int n = 0; n < 2; ++n) acc[a][b][m][n] = (f32x4){0.f, 0.f, 0.f, 0.f};
    bf16x8 At[4][2], B0[2][2], B1[2][2];
    const char* cA = (const char*)g.A + (size_t)cur.pm * tstepA; const char* cB = (const char*)g.Bt + (size_t)cur.pn * tstepB;
    S.a_ready(cur);
    if constexpr (SP2) {
        PG8_STAGE(PG8_SB(0, 0), cB, voffB); PG8_STAGE(PG8_SB(0, 1), cB + hstepB, voffB); PG8_STAGE(PG8_SA(0, 0), cA, voffA); PG8_STAGE(PG8_SA(0, 1), cA + hstepA, voffA);
        if (wr == 1) PG8_BAR;
        PG8_WAIT_V(2); PG8_BAR;
        PG8_STAGE(PG8_SB(1, 0), cB + kstep, voffB); PG8_STAGE(PG8_SA(1, 0), cA + kstep, voffA); PG8_STAGE(PG8_SB(1, 1), cB + hstepB + kstep, voffB);
        PG8_WAIT_V(6); PG8_BAR;
    } else {
        PG8_STAGE(PG8_SB(0, 0), cB, voffB); PG8_STAGE(PG8_SA(0, 0), cA, voffA); PG8_STAGE(PG8_SB(0, 1), cB + hstepB, voffB); PG8_STAGE(PG8_SA(0, 1), cA + hstepA, voffA);
        if (wr == 1) PG8_BAR;
        PG8_WAIT_V(4); PG8_BAR;
        PG8_STAGE(PG8_SB(1, 0), cB + kstep, voffB); PG8_STAGE(PG8_SA(1, 0), cA + kstep, voffA); PG8_STAGE(PG8_SB(1, 1), cB + hstepB + kstep, voffB);
        PG8_WAIT_V(6); PG8_BAR;
    }
    for (;;) {
        const bool has_next = S.next(ui + 1, nxt);
        const char* nA = has_next ? (const char*)g.A + (size_t)nxt.pm * tstepA : cA; const char* nB = has_next ? (const char*)g.Bt + (size_t)nxt.pn * tstepB : cB;
        for (int t = 0; t < nt; t += 2) {
            const bool last = (t == nt - 2);
            const char* a1 = cA + (size_t)(t + 1) * kstep;
            const char* a2 = last ? nA : cA + (size_t)(t + 2) * kstep; const char* b2 = last ? nB : cB + (size_t)(t + 2) * kstep;
            const char* a3 = a2 + kstep; const char* b3 = b2 + kstep;
            if (last && has_next) S.a_ready(nxt);
            if constexpr (SP2) {
            PG8_LDB(B0, 0, 0); PG8_LDB(B1, 0, 1); PG8_SCHED; PG8_LDA(At, 0, 0); PG8_STAGE(PG8_SA(1, 1), a1 + hstepA, voffA);
            PG8_WAIT_V(8); PG8_WAIT_L(0); PG8_BAR; PG8_MMA(0, 0, At, B0); PG8_MMA(0, 1, At, B1); PG8_BAR; PG8_SCHED;
            PG8_LDA(At, 0, 1); PG8_STAGE(PG8_SB(0, 0), b2, voffB); PG8_STAGE(PG8_SB(0, 1), b2 + hstepB, voffB); PG8_STAGE(PG8_SA(0, 0), a2, voffA);
            PG8_WAIT_V(8); PG8_WAIT_L(0); PG8_BAR; PG8_MMA(1, 0, At, B0); PG8_MMA(1, 1, At, B1); PG8_BAR; PG8_SCHED;
            PG8_LDB(B0, 1, 0); PG8_LDB(B1, 1, 1); PG8_SCHED; PG8_LDA(At, 1, 0); PG8_STAGE(PG8_SA(0, 1), a2 + hstepA, voffA);
            PG8_WAIT_V(8); PG8_WAIT_L(0); PG8_BAR; PG8_MMA(0, 0, At, B0); PG8_MMA(0, 1, At, B1); PG8_BAR; PG8_SCHED;
            PG8_LDA(At, 1, 1); PG8_STAGE(PG8_SB(1, 0), b3, voffB); PG8_STAGE(PG8_SB(1, 1), b3 + hstepB, voffB); PG8_STAGE(PG8_SA(1, 0), a3, voffA);
            PG8_WAIT_V(8); PG8_WAIT_L(0); PG8_BAR; PG8_MMA(1, 0, At, B0); PG8_MMA(1, 1, At, B1); PG8_BAR; PG8_SCHED;
            } else {
            PG8_LDB(B0, 0, 0); PG8_SCHED; PG8_LDA(At, 0, 0); PG8_STAGE(PG8_SA(1, 1), a1 + hstepA, voffA);
            PG8_WAIT_L(8); PG8_BAR; PG8_WAIT_L(0); PG8_MMA(0, 0, At, B0); PG8_BAR; PG8_SCHED;
            PG8_LDB(B1, 0, 1); PG8_STAGE(PG8_SB(0, 0), b2, voffB);
            PG8_BAR; PG8_WAIT_L(0); PG8_MMA(0, 1, At, B1); PG8_BAR;
            PG8_LDA(At, 0, 1); PG8_STAGE(PG8_SA(0, 0), a2, voffA);
            PG8_BAR; PG8_WAIT_L(0); PG8_MMA(1, 0, At, B0); PG8_BAR; PG8_SCHED;
            PG8_STAGE(PG8_SB(0, 1), b2 + hstepB, voffB);
            PG8_WAIT_V(6); PG8_BAR; PG8_MMA(1, 1, At, B1); PG8_BAR;
            PG8_LDB(B0, 1, 0); PG8_SCHED; PG8_LDA(At, 1, 0); PG8_STAGE(PG8_SA(0, 1), a2 + hstepA, voffA);
            PG8_WAIT_L(8); PG8_BAR; PG8_WAIT_L(0); PG8_MMA(0, 0, At, B0); PG8_BAR; PG8_SCHED;
            PG8_LDB(B1, 1, 1); PG8_STAGE(PG8_SB(1, 0), b3, voffB);
            PG8_BAR; PG8_WAIT_L(0); PG8_MMA(0, 1, At, B1); PG8_BAR;
            PG8_LDA(At, 1, 1); PG8_STAGE(PG8_SA(1, 0), a3, voffA);
            PG8_BAR; PG8_WAIT_L(0); PG8_MMA(1, 0, At, B0); PG8_BAR; PG8_SCHED;
            PG8_STAGE(PG8_SB(1, 1), b3 + hstepB, voffB);
            PG8_WAIT_V(6); PG8_BAR; PG8_MMA(1, 1, At, B1); PG8_BAR;
            }
        }
        if constexpr (ALIGN_EPI) { if (wr == 0) PG8_BAR; }
        if constexpr (!Epi::AFTER_DRAIN) { E(acc, cur, wr, wc, fr, fq); S.done(cur); }
        if (!has_next) break;
#pragma unroll
        for (int a = 0; a < 2; ++a)
#pragma unroll
            for (int b = 0; b < 2; ++b)
#pragma unroll
                for (int m = 0; m < 4; ++m)
#pragma unroll
                    for (int n = 0; n < 2; ++n) acc[a][b][m][n] = (f32x4){0.f, 0.f, 0.f, 0.f};
        cur = nxt; cA = nA; cB = nB; ++ui;
        if constexpr (ALIGN_EPI) { if (wr == 1) PG8_BAR; }
    }
    PG8_WAIT_V(0);
    if constexpr (!ALIGN_EPI) { if (wr == 0) PG8_BAR; }
    PG8_BAR;
    if constexpr (Epi::AFTER_DRAIN) { E.fused(acc, cur, wr, wc, fr, fq, lds, wid, lane); S.done(cur); }
#undef PG8_SA
#undef PG8_SB
#undef PG8_STAGE
#undef PG8_LDA
#undef PG8_LDB
#undef PG8_MMA
#undef PG8_WAIT_V
#undef PG8_WAIT_L
#undef PG8_BAR
#undef PG8_SCHED
}
}

#ifndef PG8_SP2
#define PG8_SP2 true
#endif
#ifndef PG8_ALIGN
#define PG8_ALIGN true
#endif
#define GAS __attribute__((address_space(1)))
#define LAS __attribute__((address_space(3)))
typedef unsigned short bf16;
typedef unsigned v4u __attribute__((ext_vector_type(4)));
typedef float f32x4 __attribute__((ext_vector_type(4)));
typedef short bf16x8 __attribute__((ext_vector_type(8)));
typedef GAS unsigned gu32;
typedef GAS unsigned long long gu64;
#define RLX_AGENT __ATOMIC_RELAXED, __HIP_MEMORY_SCOPE_AGENT
#define LDS_WAIT() asm volatile("s_waitcnt lgkmcnt(0)" ::: "memory")
#define VM_WAIT() asm volatile("s_waitcnt vmcnt(0)" ::: "memory")
__device__ __forceinline__ unsigned long long rt() { return __builtin_amdgcn_s_memrealtime(); }
__device__ __forceinline__ unsigned f2bf(float f) { unsigned u = __builtin_bit_cast(unsigned, f); return (u + 0x7fffu + ((u >> 16) & 1u)) >> 16; }
__device__ __forceinline__ unsigned pk2(float lo, float hi) { return f2bf(lo) | (f2bf(hi) << 16); }

#define XB_TMO      128
#define XB_XCNT(j)  (256  + 64 * (j))
#define XB_XSUB(j)  (1280 + 64 * (j))
#define XB_XGEN(j)  (2304 + 64 * (j))
#define XB_TOP      3328
#define XB_TOPGEN   3392
#define XCD_BAR_WORDS 3456
#define XB_SPIN_CAP (1u << 18)

__device__ __forceinline__ unsigned xb_ld(unsigned* p)              { return __hip_atomic_load(p, __ATOMIC_RELAXED, __HIP_MEMORY_SCOPE_AGENT); }
__device__ __forceinline__ unsigned xb_add(unsigned* p, unsigned v) { return __hip_atomic_fetch_add(p, v, __ATOMIC_RELAXED, __HIP_MEMORY_SCOPE_AGENT); }
__device__ __forceinline__ unsigned xb_xcc_id() { return (unsigned)__builtin_amdgcn_s_getreg((3 << 11) | 20) & 0xFu; }
#define XB_SPIN(cond, bar) do { unsigned _sp = 0; while (cond) { __builtin_amdgcn_s_sleep(1); \
    if ((++_sp & 255u) == 0u) { if (xb_ld(&(bar)[XB_TMO])) break; if (_sp > XB_SPIN_CAP) { atomicAdd(&(bar)[XB_TMO], 1u); break; } } } } while (0)

struct XcdBarrier {
    unsigned* bar; unsigned x;
    volatile LAS unsigned* st;
};

__device__ __forceinline__ XcdBarrier xcd_barrier_post(unsigned* bar, volatile LAS unsigned* st) {
    XcdBarrier b; b.bar = bar; b.x = xb_xcc_id(); b.st = st;
    if (threadIdx.x == 0) (void)xb_add(&bar[XB_XCNT(b.x)], 1u);
    return b;
}
__device__ __forceinline__ void xcd_barrier_complete(unsigned* bar, unsigned x, unsigned& nloc, unsigned& nx) {
    const unsigned G = gridDim.x * gridDim.y * gridDim.z;
    unsigned sum, cnt, mine, sp = 0u;
    for (;;) {
        sum = 0u; cnt = 0u; mine = 0u;
#pragma unroll
        for (unsigned j = 0; j < 16; ++j) { const unsigned c = xb_ld(&bar[XB_XCNT(j)]); sum += c; cnt += (c > 0u) ? 1u : 0u; mine = (j == x) ? c : mine; }
        if (sum == G) break;
        __builtin_amdgcn_s_sleep(1);
        if ((++sp & 255u) == 0u) { if (xb_ld(&bar[XB_TMO])) break; if (sp > XB_SPIN_CAP) { atomicAdd(&bar[XB_TMO], 1u); break; } }
    }
    nloc = mine > 0u ? mine : 1u; nx = cnt > 0u ? cnt : 1u;
}

__device__ __forceinline__ void xcd_barrier(const XcdBarrier& b) {
    asm volatile("s_waitcnt vmcnt(0)" ::: "memory");
    __syncthreads();
    if (threadIdx.x == 0) {
        unsigned* bar = b.bar;
        __builtin_amdgcn_s_waitcnt(0);
        unsigned nloc = b.st[0], nx = b.st[1];
        if (nloc == 0u) { xcd_barrier_complete(bar, b.x, nloc, nx); b.st[0] = nloc; b.st[1] = nx; }
        const unsigned old = xb_add(&bar[XB_XSUB(b.x)], 1u);
        const unsigned gen = old / nloc;
        if (old + 1u == (gen + 1u) * nloc) {
            __builtin_amdgcn_fence(__ATOMIC_RELEASE, "agent");
            asm volatile("s_waitcnt vmcnt(0)" ::: "memory");
            const unsigned og = xb_add(&bar[XB_TOP], 1u);
            const unsigned tg = og / nx;
            if (og + 1u == (tg + 1u) * nx) xb_add(&bar[XB_TOPGEN], 1u);
            else XB_SPIN(xb_ld(&bar[XB_TOPGEN]) == tg, bar);
            __builtin_amdgcn_fence(__ATOMIC_ACQUIRE, "agent");
            xb_add(&bar[XB_XGEN(b.x)], 1u);
            asm volatile("s_waitcnt vmcnt(0)" ::: "memory");
        } else {
            XB_SPIN(xb_ld(&bar[XB_XGEN(b.x)]) == gen, bar);
            __builtin_amdgcn_fence(__ATOMIC_ACQUIRE, "agent");
            asm volatile("s_waitcnt vmcnt(0)" ::: "memory");
        }
    }
    __syncthreads();
}
namespace att {
typedef short bf16x8 __attribute__((ext_vector_type(8)));
typedef short s16x4 __attribute__((ext_vector_type(4)));
typedef float f32x16 __attribute__((ext_vector_type(16)));
typedef float f32x4 __attribute__((ext_vector_type(4)));
typedef float f32x2 __attribute__((ext_vector_type(2)));
typedef unsigned u32x4 __attribute__((ext_vector_type(4)));
#define ATT_LAS __attribute__((address_space(3)))
#define ATT_SBAR() __builtin_amdgcn_sched_barrier(0)
__device__ __forceinline__ int crow(int r, int hi) { return (r & 3) + 8 * (r >> 2) + 4 * hi; }
__device__ __forceinline__ unsigned cvtpk(float lo, float hi) { unsigned r; asm volatile("v_cvt_pk_bf16_f32 %0, %1, %2" : "=v"(r) : "v"(lo), "v"(hi)); return r; }
__device__ __forceinline__ int v_st(int k, int c) { const int kk = (k & ~0xC) | ((k & 4) << 1) | ((k & 8) >> 1); return ((kk >> 3) * 4 + (c >> 5)) * 512 + ((kk & 7) * 32 + (c & 31)) * 2; }
__device__ __forceinline__ int v_rd_base(int lane) { return ((lane & 3) << 3) | (((lane >> 2) & 3) << 6) | (((lane >> 4) & 1) << 5) | (((lane >> 5) & 1) << 8); }
constexpr int v_rd_off(int d0, int ks, int half) { return d0 * 512 + ks * 4096 + half * 2048; }
template <int OFF> __device__ __forceinline__ s16x4 tr_read(int vb) { s16x4 r; asm volatile("ds_read_b64_tr_b16 %0, %1 offset:%2" : "=&v"(r) : "v"(vb), "i"(OFF) : "memory"); return r; }
#define ATT_PK(L, H) (att::bf16x8){L[0], L[1], L[2], L[3], H[0], H[1], H[2], H[3]}
#define ATT_PK4(P, BASE, OUT) do { unsigned a0_ = att::cvtpk(P[BASE + 0], P[BASE + 1]), a1_ = att::cvtpk(P[BASE + 2], P[BASE + 3]);   \
    unsigned b0_ = att::cvtpk(P[BASE + 4], P[BASE + 5]), b1_ = att::cvtpk(P[BASE + 6], P[BASE + 7]);                              \
    auto r0_ = __builtin_amdgcn_permlane32_swap(a0_, b0_, false, false); auto r1_ = __builtin_amdgcn_permlane32_swap(a1_, b1_, false, false); \
    att::u32x4 w_ = {r0_[0], r1_[0], r0_[1], r1_[1]}; OUT = __builtin_bit_cast(att::bf16x8, w_); } while (0)
template <int D0> __device__ __forceinline__ void pv32_one(f32x16& od, int vb, bf16x8 pa0, bf16x8 pa1) {
    const s16x4 l0 = tr_read<v_rd_off(D0, 0, 0)>(vb), h0 = tr_read<v_rd_off(D0, 0, 1)>(vb), l1 = tr_read<v_rd_off(D0, 1, 0)>(vb), h1 = tr_read<v_rd_off(D0, 1, 1)>(vb);
    asm volatile("s_waitcnt lgkmcnt(0)" ::: "memory"); ATT_SBAR();
    od = __builtin_amdgcn_mfma_f32_32x32x16_bf16(pa0, ATT_PK(l0, h0), od, 0, 0, 0);
    od = __builtin_amdgcn_mfma_f32_32x32x16_bf16(pa1, ATT_PK(l1, h1), od, 0, 0, 0);
}
constexpr float THR2 = 11.5f;

__device__ __forceinline__ void glds16(const void* gsrc, unsigned lds_dst) { unsigned keep;
    asm volatile("s_mov_b32 %0, m0\n\ts_mov_b32 m0, %2\n\ts_nop 0\n\tglobal_load_lds_dwordx4 %1, off\n\ts_mov_b32 m0, %0" : "=&s"(keep) : "v"(gsrc), "s"(lds_dst) : "memory"); }
template <int D0> __device__ __forceinline__ void pv32t_one(f32x16& od, int vb, bf16x8 pa0, bf16x8 pa1) {
    const s16x4 l0 = tr_read<v_rd_off(D0, 0, 0)>(vb), h0 = tr_read<v_rd_off(D0, 0, 1)>(vb), l1 = tr_read<v_rd_off(D0, 1, 0)>(vb), h1 = tr_read<v_rd_off(D0, 1, 1)>(vb);
    asm volatile("s_waitcnt lgkmcnt(0)" ::: "memory"); ATT_SBAR();
    od = __builtin_amdgcn_mfma_f32_32x32x16_bf16(ATT_PK(l0, h0), pa0, od, 0, 0, 0);
    od = __builtin_amdgcn_mfma_f32_32x32x16_bf16(ATT_PK(l1, h1), pa1, od, 0, 0, 0);
}
template <int D0> __device__ __forceinline__ void pv64t_one(f32x16& od, int vb, bf16x8 pa0, bf16x8 pa1, bf16x8 pa2, bf16x8 pa3) {
    const s16x4 l0 = tr_read<v_rd_off(D0, 0, 0)>(vb), h0 = tr_read<v_rd_off(D0, 0, 1)>(vb), l1 = tr_read<v_rd_off(D0, 1, 0)>(vb), h1 = tr_read<v_rd_off(D0, 1, 1)>(vb);
    const s16x4 l2 = tr_read<v_rd_off(D0, 2, 0)>(vb), h2 = tr_read<v_rd_off(D0, 2, 1)>(vb), l3 = tr_read<v_rd_off(D0, 3, 0)>(vb), h3 = tr_read<v_rd_off(D0, 3, 1)>(vb);
    asm volatile("s_waitcnt lgkmcnt(0)" ::: "memory"); ATT_SBAR();
    od = __builtin_amdgcn_mfma_f32_32x32x16_bf16(ATT_PK(l0, h0), pa0, od, 0, 0, 0);
    od = __builtin_amdgcn_mfma_f32_32x32x16_bf16(ATT_PK(l1, h1), pa1, od, 0, 0, 0);
    od = __builtin_amdgcn_mfma_f32_32x32x16_bf16(ATT_PK(l2, h2), pa2, od, 0, 0, 0);
    od = __builtin_amdgcn_mfma_f32_32x32x16_bf16(ATT_PK(l3, h3), pa3, od, 0, 0, 0);
}

template <int MODE> __device__ __forceinline__ void dilated_unit(const unsigned short* proj, unsigned short* part_o, float* part_ml, unsigned short* MIX, ATT_LAS unsigned char* lds, const ATT_LAS float* tsub,
                                                            int b, int h, int dil, int res, int S0, int branch, int tid) {
    const int lane = tid & 63, wid = __builtin_amdgcn_readfirstlane(tid >> 6), r32 = lane & 31, hi = lane >> 5;
    const unsigned short* pb = proj + (size_t)b * 4096 * 12288 + h * 128;
    const size_t rstr = (size_t)dil * 12288;
    const int L = 4096 / dil, tq0 = S0 + 32 * wid;
    const unsigned short* qrow = pb + ((size_t)(tq0 + r32) * dil + res) * 12288 + hi * 8;
    bf16x8 qr[8];
#pragma unroll
    for (int d0 = 0; d0 < 8; ++d0) qr[d0] = *(const bf16x8*)(qrow + d0 * 16);
    float m_reg = -1e30f, l_reg = 0.f; f32x16 o[4];
#pragma unroll
    for (int d = 0; d < 4; ++d)
#pragma unroll
        for (int r = 0; r < 16; ++r) o[d][r] = 0.f;
    const unsigned lds0 = (unsigned)(uintptr_t)lds;
    unsigned valid = 0u;
#pragma unroll
    for (int t = 0; t < 12; ++t) { const int t0 = S0 - 64 + 32 * t; if (t0 >= 0 && t0 < L) valid |= 1u << t; }
    const int kl = (lane & 31) >> 2, cl = (lane >> 5) * 32 + (lane & 3) * 8;
    const int krl = lane >> 4, kcl = lane & 15;
#define DU_DMA(t) do { if ((valid >> (t)) & 1u) { const unsigned short* blk_ = pb + ((size_t)(S0 - 64 + 32 * (t)) * dil + res) * 12288; const unsigned sl_ = lds0 + (unsigned)((t) & 7) * 16384u; \
        _Pragma("unroll") for (int e = 0; e < 2; ++e) { \
            if (wid < 4) { const int p = 2 * wid + e, row = 4 * p + krl, c = kcl ^ (row & 7); glds16(blk_ + 2048 + (size_t)row * rstr + c * 8, (unsigned)__builtin_amdgcn_readfirstlane(sl_ + (unsigned)p * 1024u)); } \
            else { const int p = 2 * (wid - 4) + e, kk = 8 * (p >> 1) + kl, k = (kk & ~0xC) | ((kk & 4) << 1) | ((kk & 8) >> 1), col = (p & 1) * 64 + cl; \
                   glds16(blk_ + 4096 + (size_t)k * rstr + col, (unsigned)__builtin_amdgcn_readfirstlane(sl_ + 8192u + (unsigned)p * 1024u)); } } } } while (0)
    DU_DMA(0); DU_DMA(1); DU_DMA(2); DU_DMA(3);
#pragma unroll 1
    for (int t = 0; t < 12; ++t) {
        if (t + 4 < 12) DU_DMA(t + 4);
        if (!((valid >> t) & 1u)) continue;
        { const int na = __builtin_popcount(valid & (0x1eu << t) & 0xfffu);
          if (na >= 4) asm volatile("s_waitcnt vmcnt(8) lgkmcnt(0)\n\ts_barrier" ::: "memory"); else if (na == 3) asm volatile("s_waitcnt vmcnt(6) lgkmcnt(0)\n\ts_barrier" ::: "memory");
          else if (na == 2) asm volatile("s_waitcnt vmcnt(4) lgkmcnt(0)\n\ts_barrier" ::: "memory"); else if (na == 1) asm volatile("s_waitcnt vmcnt(2) lgkmcnt(0)\n\ts_barrier" ::: "memory");
          else asm volatile("s_waitcnt vmcnt(0) lgkmcnt(0)\n\ts_barrier" ::: "memory"); }
        const int kb = t - wid; if (kb < 0 || kb > 4) continue;
        const ATT_LAS unsigned char* krd = lds + (t & 7) * 16384 + r32 * 256;
        bf16x8 kc[8];
#pragma unroll
        for (int d0 = 0; d0 < 8; ++d0) kc[d0] = *(const ATT_LAS bf16x8*)(krd + (((2 * d0 + hi) ^ (r32 & 7)) << 4));
        const ATT_LAS float* tb = tsub + (32 - r32 + 4 * hi + 32 * kb);
        f32x16 p;
#pragma unroll
        for (int r = 0; r < 16; ++r) p[r] = tb[(r & 3) + 8 * (r >> 2)];
#pragma unroll
        for (int d0 = 0; d0 < 8; ++d0) p = __builtin_amdgcn_mfma_f32_32x32x16_bf16(kc[d0], qr[d0], p, 0, 0, 0);
        float pmax = p[0];
#pragma unroll
        for (int r = 1; r < 16; ++r) pmax = fmaxf(pmax, p[r]);
        { auto rr = __builtin_amdgcn_permlane32_swap(__float_as_uint(pmax), __float_as_uint(pmax), false, false); pmax = fmaxf(__uint_as_float(rr[0]), __uint_as_float(rr[1])); }
        float alpha = 1.f;
        if (!__all(pmax - m_reg <= THR2)) { const float mn = fmaxf(m_reg, pmax); alpha = __builtin_amdgcn_exp2f(m_reg - mn); m_reg = mn; }
        float ps = 0.f;
#pragma unroll
        for (int r = 0; r < 16; ++r) { p[r] = __builtin_amdgcn_exp2f(p[r] - m_reg); ps += p[r]; }
        { auto rr = __builtin_amdgcn_permlane32_swap(__float_as_uint(ps), __float_as_uint(ps), false, false); ps = __uint_as_float(rr[0]) + __uint_as_float(rr[1]); }
        l_reg = l_reg * alpha + ps;
        bf16x8 pa0, pa1; ATT_PK4(p, 0, pa0); ATT_PK4(p, 8, pa1);
        if (__any(alpha < 1.f)) {
#pragma unroll
            for (int d = 0; d < 4; ++d)
#pragma unroll
                for (int r = 0; r < 16; ++r) o[d][r] *= alpha;
        }
        ATT_SBAR();
        const int vb = (int)(lds0 + (unsigned)(t & 7) * 16384u + 8192u) + v_rd_base(lane);
        pv32t_one<0>(o[0], vb, pa0, pa1); pv32t_one<1>(o[1], vb, pa0, pa1); pv32t_one<2>(o[2], vb, pa0, pa1); pv32t_one<3>(o[3], vb, pa0, pa1);
    }
#undef DU_DMA
    const size_t rec = (((size_t)b * 4096 + (size_t)(tq0 + r32) * dil + res) * 16 + h) * 2;
    if (MODE == 0) {
        const float inv = 1.f / l_reg;
        if (hi == 0) *(f32x2*)(part_ml + (rec + branch) * 2) = (f32x2){m_reg, l_reg};
        unsigned short* op = part_o + (rec + branch) * 128 + 4 * hi;
#pragma unroll
        for (int d0 = 0; d0 < 4; ++d0)
#pragma unroll
            for (int g = 0; g < 4; ++g) { f32x2 w; w[0] = __uint_as_float(cvtpk(o[d0][4 * g] * inv, o[d0][4 * g + 1] * inv)); w[1] = __uint_as_float(cvtpk(o[d0][4 * g + 2] * inv, o[d0][4 * g + 3] * inv));
                *(f32x2*)(op + 32 * d0 + 8 * g) = w; }
    } else {
        const f32x4 ml = *(const f32x4*)(part_ml + rec * 2);
        const float mx = fmaxf(fmaxf(m_reg, ml[0]), ml[2]);
        const float w1 = __builtin_amdgcn_exp2f(m_reg - mx), wA = __builtin_amdgcn_exp2f(ml[0] - mx) * ml[1], wB = __builtin_amdgcn_exp2f(ml[2] - mx) * ml[3];
        const float inv = 1.f / (w1 * l_reg + wA + wB), s1 = w1 * inv, sA = wA * inv, sB = wB * inv;
        const unsigned short* pa_ = part_o + rec * 128 + 4 * hi; const unsigned short* pb_ = pa_ + 128;
        const int orow = b * 4096 + (tq0 + r32) * dil + res, ocol = h * 128 + 4 * hi;
#pragma unroll
        for (int d0 = 0; d0 < 4; ++d0)
#pragma unroll
            for (int g = 0; g < 4; ++g) { const f32x2 ua = *(const f32x2*)(pa_ + 32 * d0 + 8 * g), ub = *(const f32x2*)(pb_ + 32 * d0 + 8 * g);
                const unsigned a0 = __float_as_uint(ua[0]), a1 = __float_as_uint(ua[1]), b0 = __float_as_uint(ub[0]), b1 = __float_as_uint(ub[1]);
                const float y0 = o[d0][4 * g] * s1 + __uint_as_float(a0 << 16) * sA + __uint_as_float(b0 << 16) * sB, y1 = o[d0][4 * g + 1] * s1 + __uint_as_float(a0 & 0xffff0000u) * sA + __uint_as_float(b0 & 0xffff0000u) * sB;
                const float y2 = o[d0][4 * g + 2] * s1 + __uint_as_float(a1 << 16) * sA + __uint_as_float(b1 << 16) * sB, y3 = o[d0][4 * g + 3] * s1 + __uint_as_float(a1 & 0xffff0000u) * sA + __uint_as_float(b1 & 0xffff0000u) * sB;
                f32x2 w; w[0] = __uint_as_float(cvtpk(y0, y1)); w[1] = __uint_as_float(cvtpk(y2, y3)); *(f32x2*)(MIX + pg8::tiled_elem(orow, ocol + 32 * d0 + 8 * g, 64)) = w; }
    }
}

#define ATT_VRD8(D0, L, H) do { L[0] = tr_read<v_rd_off(D0, 0, 0)>(vb); H[0] = tr_read<v_rd_off(D0, 0, 1)>(vb); L[1] = tr_read<v_rd_off(D0, 1, 0)>(vb); H[1] = tr_read<v_rd_off(D0, 1, 1)>(vb); \
        L[2] = tr_read<v_rd_off(D0, 2, 0)>(vb); H[2] = tr_read<v_rd_off(D0, 2, 1)>(vb); L[3] = tr_read<v_rd_off(D0, 3, 0)>(vb); H[3] = tr_read<v_rd_off(D0, 3, 1)>(vb); } while (0)
#define ATT_PV4(OD, L, H) do { OD = __builtin_amdgcn_mfma_f32_32x32x16_bf16(ATT_PK(L[0], H[0]), pa0, OD, 0, 0, 0); OD = __builtin_amdgcn_mfma_f32_32x32x16_bf16(ATT_PK(L[1], H[1]), pa1, OD, 0, 0, 0); \
        OD = __builtin_amdgcn_mfma_f32_32x32x16_bf16(ATT_PK(L[2], H[2]), pa2, OD, 0, 0, 0); OD = __builtin_amdgcn_mfma_f32_32x32x16_bf16(ATT_PK(L[3], H[3]), pa3, OD, 0, 0, 0); } while (0)
template <int GV> __device__ __forceinline__ void pv64t_all(f32x16 (&o)[4], int vb, bf16x8 pa0, bf16x8 pa1, bf16x8 pa2, bf16x8 pa3) {
    s16x4 la[4], ha[4], lb[4], hb[4];
    if (GV == 7) {
#pragma unroll
        for (int i = 0; i < 4; ++i) { la[i] = (s16x4){1, 2, 3, 4}; ha[i] = (s16x4){5, 6, 7, 8}; lb[i] = la[i]; hb[i] = ha[i]; asm volatile("" : "+v"(la[i]), "+v"(ha[i]), "+v"(lb[i]), "+v"(hb[i])); }
        ATT_PV4(o[0], la, ha); ATT_PV4(o[1], lb, hb); ATT_PV4(o[2], la, ha); ATT_PV4(o[3], lb, hb); return; }
    if (GV == 8) {
        ATT_VRD8(0, la, ha); ATT_VRD8(1, lb, hb); asm volatile("s_waitcnt lgkmcnt(8)" ::: "memory");
#pragma unroll
        for (int i = 0; i < 4; ++i) asm volatile("" :: "v"(la[i]), "v"(ha[i]));
        ATT_VRD8(2, la, ha); asm volatile("s_waitcnt lgkmcnt(8)" ::: "memory");
#pragma unroll
        for (int i = 0; i < 4; ++i) asm volatile("" :: "v"(lb[i]), "v"(hb[i]));
        ATT_VRD8(3, lb, hb); asm volatile("s_waitcnt lgkmcnt(0)" ::: "memory");
#pragma unroll
        for (int i = 0; i < 4; ++i) asm volatile("" :: "v"(la[i]), "v"(ha[i]), "v"(lb[i]), "v"(hb[i]));
        o[0][0] += __builtin_bit_cast(f32x4, pa0)[0] + __builtin_bit_cast(f32x4, pa1)[1] + __builtin_bit_cast(f32x4, pa2)[2] + __builtin_bit_cast(f32x4, pa3)[3]; return; }
    ATT_VRD8(0, la, ha); ATT_VRD8(1, lb, hb);
    asm volatile("s_waitcnt lgkmcnt(8)" ::: "memory"); ATT_SBAR(); ATT_PV4(o[0], la, ha); ATT_SBAR();
    ATT_VRD8(2, la, ha);
    asm volatile("s_waitcnt lgkmcnt(8)" ::: "memory"); ATT_SBAR(); ATT_PV4(o[1], lb, hb); ATT_SBAR();
    ATT_VRD8(3, lb, hb);
    asm volatile("s_waitcnt lgkmcnt(8)" ::: "memory"); ATT_SBAR(); ATT_PV4(o[2], la, ha); ATT_SBAR();
    asm volatile("s_waitcnt lgkmcnt(0)" ::: "memory"); ATT_SBAR(); ATT_PV4(o[3], lb, hb);
}

constexpr int DF_TB = 131072, DF_TBN = 1312, DF_TB0 = 656, DF_XROW = 528;
#define ATT_WAIT_BAR() asm volatile("s_waitcnt vmcnt(0) lgkmcnt(0)\n\ts_barrier" ::: "memory")
#define ATT_WAIT4_BAR() asm volatile("s_waitcnt vmcnt(4) lgkmcnt(0)\n\ts_barrier" ::: "memory")
template <int GV> __device__ __forceinline__ void df_qkt(f32x16& p0, f32x16& p1, const ATT_LAS unsigned char* ks, const bf16x8 (&qr)[4], const ATT_LAS float* tb, bool lookup, const f32x16& cinit, float m_reg, int map, int r32, int hi) {
    const int sw = r32 & 7; const ATT_LAS unsigned char* kr = ks + r32 * 256 + map * 128;
    bf16x8 kf0[4], kf1[4];
#pragma unroll
    for (int d0 = 0; d0 < 4; ++d0) { const int off = ((2 * d0 + hi) ^ sw) << 4;
        if (GV == 7) { kf0[d0] = qr[d0]; kf1[d0] = qr[3 - d0]; asm volatile("" : "+v"(kf0[d0]), "+v"(kf1[d0])); } else { kf0[d0] = *(const ATT_LAS bf16x8*)(kr + off); kf1[d0] = *(const ATT_LAS bf16x8*)(kr + 8192 + off); } }
    if (GV == 8) {
#pragma unroll
        for (int d0 = 0; d0 < 4; ++d0) asm volatile("" :: "v"(kf0[d0]), "v"(kf1[d0]));
        p0 = cinit; p1 = cinit; return; }
    if (lookup) {
#pragma unroll
        for (int r = 0; r < 16; ++r) { p0[r] = tb[(r & 3) + 8 * (r >> 2)] - m_reg; p1[r] = tb[32 + (r & 3) + 8 * (r >> 2)] - m_reg; }
        p0 = __builtin_amdgcn_mfma_f32_32x32x16_bf16(kf0[0], qr[0], p0, 0, 0, 0); p1 = __builtin_amdgcn_mfma_f32_32x32x16_bf16(kf1[0], qr[0], p1, 0, 0, 0);
    } else {
        p0 = __builtin_amdgcn_mfma_f32_32x32x16_bf16(kf0[0], qr[0], cinit, 0, 0, 0); p1 = __builtin_amdgcn_mfma_f32_32x32x16_bf16(kf1[0], qr[0], cinit, 0, 0, 0);
    }
#pragma unroll
    for (int d0 = 1; d0 < 4; ++d0) { p0 = __builtin_amdgcn_mfma_f32_32x32x16_bf16(kf0[d0], qr[d0], p0, 0, 0, 0); p1 = __builtin_amdgcn_mfma_f32_32x32x16_bf16(kf1[d0], qr[d0], p1, 0, 0, 0); }
}
template <bool FIRST> __device__ __forceinline__ void df_partial(f32x16& p0, f32x16& p1, float& m_reg, float& alpha, f32x16& cinit) {
    float pmax = p0[0];
#pragma unroll
    for (int r = 1; r < 16; ++r) pmax = fmaxf(pmax, p0[r]);
#pragma unroll
    for (int r = 0; r < 16; ++r) pmax = fmaxf(pmax, p1[r]);
    { auto rr = __builtin_amdgcn_permlane32_swap(__float_as_uint(pmax), __float_as_uint(pmax), false, false); pmax = fmaxf(__uint_as_float(rr[0]), __uint_as_float(rr[1])); }
    alpha = 1.f;
    if (FIRST || !__builtin_expect(__all(pmax <= THR2), 1)) { const float dl = FIRST ? pmax : fmaxf(pmax, 0.f); m_reg += dl; alpha = FIRST ? 1.f : __builtin_amdgcn_exp2f(-dl);
#pragma unroll
        for (int r = 0; r < 16; ++r) { p0[r] -= dl; p1[r] -= dl; cinit[r] -= dl; } }
#pragma unroll
    for (int r = 0; r < 16; ++r) p0[r] = __builtin_amdgcn_exp2f(p0[r]);
}
__device__ __forceinline__ void df_finish(f32x16& p0, f32x16& p1, float alpha, float& l_reg, bf16x8& pa0, bf16x8& pa1, bf16x8& pa2, bf16x8& pa3) {
#pragma unroll
    for (int r = 0; r < 16; ++r) p1[r] = __builtin_amdgcn_exp2f(p1[r]);
    float ps = 0.f;
#pragma unroll
    for (int r = 0; r < 16; ++r) ps += p0[r];
#pragma unroll
    for (int r = 0; r < 16; ++r) ps += p1[r];
    { auto rr = __builtin_amdgcn_permlane32_swap(__float_as_uint(ps), __float_as_uint(ps), false, false); ps = __uint_as_float(rr[0]) + __uint_as_float(rr[1]); }
    l_reg = l_reg * alpha + ps;
    ATT_PK4(p0, 0, pa0); ATT_PK4(p0, 8, pa1); ATT_PK4(p1, 0, pa2); ATT_PK4(p1, 8, pa3);
}
template <int GV> __device__ __forceinline__ void diff_unit(const unsigned short* proj, unsigned short* MIX, const float* BIAS, const float* gsub, float lam, float post, ATT_LAS unsigned char* lds, int b, int h, int qb, int tid) {
    const int lane = tid & 63, wid = __builtin_amdgcn_readfirstlane(tid >> 6), r32 = lane & 31, hi = lane >> 5, rg = wid & 3, map = wid >> 2;
    const unsigned lds0 = (unsigned)(uintptr_t)lds;
    ATT_LAS float* tbl = (ATT_LAS float*)(lds + DF_TB);
    const int qw = qb * 128 + rg * 32;
    const unsigned short* pb = proj + (size_t)b * 4096 * 12288 + h * 128;
    const float* bh = BIAS + (16 + h) * 8192 + 4095;
    ATT_WAIT_BAR();
    for (int i = tid; i < DF_TBN; i += 512) tbl[i] = bh[i - DF_TB0];
    const float cpos = bh[600], cneg = bh[-600];
    bf16x8 qr[4];
    { const unsigned short* qrow = pb + (size_t)(qw + r32) * 12288 + 6144 + map * 64 + hi * 8;
#pragma unroll
      for (int d0 = 0; d0 < 4; ++d0) qr[d0] = *(const bf16x8*)(qrow + d0 * 16); }
    unsigned koff[2], voff[2];
#pragma unroll
    for (int e = 0; e < 2; ++e) { const int p = 2 * wid + e; { const int row = 4 * p + (lane >> 4), c = (lane & 15) ^ (row & 7); koff[e] = (unsigned)(row * 24576 + c * 16); }
        { const int j = 64 * p + lane, st = j >> 5, kk = (st >> 2) * 8 + ((j & 31) >> 2), col = (st & 3) * 32 + (j & 3) * 8, k = (kk & ~0xC) | ((kk & 4) << 1) | ((kk & 8) >> 1); voff[e] = (unsigned)(k * 24576 + col * 2); } }
    const char* kbase = (const char*)(pb + 8192); const char* vbase = (const char*)(pb + 10240);
#define DF_DMA(t, slot) do { const size_t tb_ = (size_t)(t) * (64 * 24576); const unsigned sl_ = lds0 + (unsigned)(slot) * 32768u + (unsigned)(2 * wid) * 1024u; \
        glds16(kbase + tb_ + koff[0], (unsigned)__builtin_amdgcn_readfirstlane(sl_)); glds16(kbase + tb_ + koff[1], (unsigned)__builtin_amdgcn_readfirstlane(sl_ + 1024u)); \
        glds16(vbase + tb_ + voff[0], (unsigned)__builtin_amdgcn_readfirstlane(sl_ + 16384u)); glds16(vbase + tb_ + voff[1], (unsigned)__builtin_amdgcn_readfirstlane(sl_ + 16384u + 1024u)); } while (0)
    if (GV < 5) { DF_DMA(0, 0); DF_DMA(1, 1); }
    float m_reg = 0.f, l_reg = 0.f, cbk = 0.f; f32x16 o[4], cinit;
#pragma unroll
    for (int d = 0; d < 4; ++d)
#pragma unroll
        for (int r = 0; r < 16; ++r) o[d][r] = 0.f;
#pragma unroll
    for (int r = 0; r < 16; ++r) cinit[r] = 0.f;
    f32x16 pA0, pA1, pB0, pB1; float alA = 1.f, alB = 1.f; bf16x8 pa0, pa1, pa2, pa3;
    const int vrb = (int)(lds0 + 16384u) + v_rd_base(lane);
#define DF_MODE(j, LK, CB, TB) const int k0_ = (j) * 64, rmin_ = k0_ - (qw + 31), rmax_ = k0_ + 63 - qw; const bool LK = !(rmin_ >= 559 || rmax_ <= -559); \
        const float CB = LK ? 0.f : (rmin_ >= 559 ? cpos : cneg); const ATT_LAS float* TB = tbl + (LK ? (k0_ - qw - r32 + 4 * hi + DF_TB0) : 0); \
        if (!LK && CB != cbk) { cbk = CB; _Pragma("unroll") for (int r_ = 0; r_ < 16; ++r_) cinit[r_] = CB - m_reg; }
#define DF_RESC(al) do { if (__any((al) < 1.f)) { _Pragma("unroll") for (int d_ = 0; d_ < 4; ++d_) _Pragma("unroll") for (int r_ = 0; r_ < 16; ++r_) o[d_][r_] *= (al); } } while (0)
#define DF_STEP(PC0, PC1, ALC, PP0, PP1, ALP, j) do { \
        if (GV < 5 && (j) + 2 < 64) DF_DMA((j) + 2, ((j) + 2) & 3); \
        { DF_MODE(j, lk_, cb_, tb_); ATT_SBAR(); \
          if (GV != 4) df_qkt<GV>(PC0, PC1, lds + ((j) & 3) * 32768, qr, tb_, lk_, cinit, m_reg, map, r32, hi); else { PC0 = cinit; PC1 = cinit; } \
          if (GV != 2) df_finish(PP0, PP1, ALP, l_reg, pa0, pa1, pa2, pa3); else { pa0 = __builtin_bit_cast(bf16x8, (f32x4){PP0[0], PP0[1], PP0[2], PP0[3]}); pa1 = __builtin_bit_cast(bf16x8, (f32x4){PP0[4], PP0[5], PP0[6], PP0[7]}); pa2 = __builtin_bit_cast(bf16x8, (f32x4){PP1[0], PP1[1], PP1[2], PP1[3]}); pa3 = __builtin_bit_cast(bf16x8, (f32x4){PP1[4], PP1[5], PP1[6], PP1[7]}); l_reg += PP0[8] + PP1[8]; } ATT_SBAR(); \
          if (GV != 3) { const int vb_ = vrb + (((j) - 1) & 3) * 32768; \
            pv64t_all<GV>(o, vb_, pa0, pa1, pa2, pa3); } \
          else { o[0][0] += __builtin_bit_cast(f32x4, pa0)[0] + __builtin_bit_cast(f32x4, pa1)[1] + __builtin_bit_cast(f32x4, pa2)[2] + __builtin_bit_cast(f32x4, pa3)[3]; } \
          if (GV != 2) df_partial<false>(PC0, PC1, m_reg, ALC, cinit); else ALC = 1.f; } \
        DF_RESC(ALC); \
        if (GV >= 6) { asm volatile("s_waitcnt lgkmcnt(0)" ::: "memory"); } else if (GV == 5) { asm volatile("s_waitcnt lgkmcnt(0)\n\ts_barrier" ::: "memory"); } else if ((j) + 2 < 64) ATT_WAIT4_BAR(); else ATT_WAIT_BAR(); } while (0)
    ATT_WAIT4_BAR();
    { if (GV < 5) DF_DMA(2, 2); DF_MODE(0, lk_, cb_, tb_); df_qkt<GV>(pA0, pA1, lds, qr, tb_, lk_, cinit, m_reg, map, r32, hi); df_partial<true>(pA0, pA1, m_reg, alA, cinit); ATT_WAIT4_BAR(); }
#pragma unroll 1
    for (int j = 1; j < 63; j += 2) { DF_STEP(pB0, pB1, alB, pA0, pA1, alA, j); DF_STEP(pA0, pA1, alA, pB0, pB1, alB, j + 1); }
    DF_STEP(pB0, pB1, alB, pA0, pA1, alA, 63);
    df_finish(pB0, pB1, alB, l_reg, pa0, pa1, pa2, pa3); ATT_SBAR();
    { const int vb_ = vrb + (63 & 3) * 32768;
      pv64t_all<GV>(o, vb_, pa0, pa1, pa2, pa3); }
#undef DF_STEP
#undef DF_RESC
#undef DF_MODE
#undef DF_DMA
    ATT_WAIT_BAR();
    ATT_LAS unsigned char* xr = lds + rg * (32 * DF_XROW) + r32 * DF_XROW + hi * 16;
    if (map == 1) { const float s1 = lam / l_reg;
#pragma unroll
        for (int d0 = 0; d0 < 4; ++d0)
#pragma unroll
            for (int g = 0; g < 4; ++g) *(ATT_LAS f32x4*)(xr + (32 * d0 + 8 * g) * 4) = (f32x4){o[d0][4 * g] * s1, o[d0][4 * g + 1] * s1, o[d0][4 * g + 2] * s1, o[d0][4 * g + 3] * s1}; }
    ATT_WAIT_BAR();
    if (map == 0 && (GV == 0 || l_reg == -123.456f)) { const float s0 = 1.f / l_reg; float ss = 0.f;
#pragma unroll
        for (int d0 = 0; d0 < 4; ++d0)
#pragma unroll
            for (int g = 0; g < 4; ++g) { const f32x4 y = *(const ATT_LAS f32x4*)(xr + (32 * d0 + 8 * g) * 4);
#pragma unroll
                for (int i = 0; i < 4; ++i) { const float x = o[d0][4 * g + i] * s0 - y[i]; o[d0][4 * g + i] = x; ss += x * x; } }
        { auto rr = __builtin_amdgcn_permlane32_swap(__float_as_uint(ss), __float_as_uint(ss), false, false); ss = __uint_as_float(rr[0]) + __uint_as_float(rr[1]); }
        const float rs = post / sqrtf(ss * (1.f / 128.f) + 1e-5f);
        const int orow = b * 4096 + qw + r32, ocol = 2048 + h * 128 + 4 * hi; const float* gp = gsub + 4 * hi;
#pragma unroll
        for (int d0 = 0; d0 < 4; ++d0)
#pragma unroll
            for (int g = 0; g < 4; ++g) { const f32x4 gg = *(const f32x4*)(gp + 32 * d0 + 8 * g);
                f32x2 w; { const unsigned lo = cvtpk(o[d0][4 * g] * rs * gg[0], o[d0][4 * g + 1] * rs * gg[1]), hi2 = cvtpk(o[d0][4 * g + 2] * rs * gg[2], o[d0][4 * g + 3] * rs * gg[3]); w[0] = __uint_as_float(lo); w[1] = __uint_as_float(hi2); }
                *(f32x2*)(MIX + pg8::tiled_elem(orow, ocol + 32 * d0 + 8 * g, 64)) = w; } }
}
}

constexpr int NWAVES = 8;
#ifndef MK_ONE_LAUNCH
#define MK_ONE_LAUNCH 1
#endif

#ifndef PROBE_DUP
#define PROBE_DUP 0
#endif
#define DUPN(k) ((PROBE_DUP == (k)) ? 2 : 1)
#ifndef PROBE_CLK
#define PROBE_CLK 0
#endif
#ifndef PROBE_GG
#define PROBE_GG 0
#endif
#ifndef PROBE_BAR
#define PROBE_BAR 0
#endif
#ifndef PROBE_THIN
#define PROBE_THIN 0
#endif
#ifndef PROBE_GV
#define PROBE_GV 0
#endif

constexpr int BATCH = 2, SEQ = 4096, DM = 4096, DEPTH = 2, NHA = 16, NHD = 16, HD = 128, DQ = 64;
constexpr int M = BATCH * SEQ;
constexpr int NPROJ = 12288, DFF = 16384, DILW = 2048;
constexpr int COL_QA = 0, COL_KA = 2048, COL_VA = 4096, COL_QD = 6144, COL_KD = 8192, COL_VD = 10240;
constexpr float RMS_EPS = 1e-6f, SUBLN_EPS = 1e-5f, LOG2E = 1.4426950408889634f;
constexpr float SC_A = 0.08838834764831845f * LOG2E;
constexpr float SC_D = 0.125f * LOG2E;
constexpr int NPART = 64;
constexpr int N_PHASES = 1 + 7 * DEPTH;

constexpr size_t MiB = 1u << 20;
constexpr size_t WS_CTL = 0, CTL_ZERO_BYTES = 1 * MiB;
constexpr size_t WS_BIAS = 1 * MiB;
constexpr size_t WS_PART = 2 * MiB;
constexpr size_t WS_WIN = 4 * MiB;
constexpr size_t WS_WOUT = WS_WIN + 192 * MiB;
constexpr size_t WS_WUP = WS_WOUT + 64 * MiB;
constexpr size_t WS_WDN = WS_WUP + 256 * MiB;
constexpr size_t WS_H = WS_WDN + 256 * MiB;
constexpr size_t WS_PROJ = WS_H + 64 * MiB;
constexpr size_t WS_MIX = WS_PROJ + 192 * MiB;
constexpr size_t WS_U = WS_MIX + 64 * MiB;
constexpr size_t WS_Y = WS_U + 256 * MiB;
constexpr size_t WS_END = WS_Y + 128 * MiB;
constexpr int CW_TMO = 0, CW_CODE = 1;
constexpr int CW_LAM = 16;
constexpr int CW_BAR = 4096;

constexpr int RING_OFF = 0, RING_BYTES = 131072;
constexpr int LDSCTL_OFF = 143360, MISC_OFF = LDSCTL_OFF + 320;
constexpr int LDS_BYTES = 147456;
static_assert(MISC_OFF + 128 <= LDS_BYTES, "LDS map");

struct Frame {
    LAS unsigned char* lds;
    volatile LAS unsigned* MISC;
    gu32* ctl;
    int tid, lane, wave;
    int vcu, G;
    const float* x; float* out;
    const float *rel_bias, *g_pre_mix, *w_in, *lq1, *lk1, *lq2, *lk2, *g_subln, *w_out, *g_post_mix, *g_pre_mlp, *w_up, *w_down, *g_post_mlp;
    bf16 *Win_t, *Wout_t, *Wup_t, *Wdn_t;
    bf16 *H, *PROJ, *MIX, *U;
    bf16* Y; float *PART, *BIAS;
};

__device__ __forceinline__ float wave_sum(float v) {
#pragma unroll
    for (int o = 1; o < 64; o <<= 1) v += __shfl_xor(v, o);
    return v;
}
__device__ __forceinline__ int opaque_tid() { int t = threadIdx.x; asm volatile("" : "+v"(t)); return t; }
__device__ __forceinline__ float bflo(unsigned u) { return __uint_as_float(u << 16); }
__device__ __forceinline__ float bfhi(unsigned u) { return __uint_as_float(u & 0xffff0000u); }

__device__ __forceinline__ void p0_transpose_item(const float* W, int K, int N, bf16* WT, LAS float* scr, int item, int lane) {
    const int nblk = N / 32, kb = item / nblk, nb = item % nblk, k0 = 64 * kb, n0 = 32 * nb;
    const GAS float* src = (const GAS float*)W + (size_t)(k0 + (lane >> 5)) * N + n0 + (lane & 31);
    float v[32];
#pragma unroll
    for (int i = 0; i < 32; ++i) v[i] = src[(size_t)(2 * i) * N];
#pragma unroll
    for (int i = 0; i < 32; ++i) scr[(2 * i + (lane >> 5)) * 33 + (lane & 31)] = v[i];
    LDS_WAIT(); asm volatile("" ::: "memory");
    const int c = lane & 7;
#pragma unroll
    for (int j = 0; j < 4; ++j) { const int n = (lane >> 3) + 8 * j; const LAS float* s = scr + (8 * c) * 33 + n;
        v4u o; o.x = pk2(s[0 * 33], s[1 * 33]); o.y = pk2(s[2 * 33], s[3 * 33]); o.z = pk2(s[4 * 33], s[5 * 33]); o.w = pk2(s[6 * 33], s[7 * 33]);
        *(GAS v4u*)(WT + pg8::tiled_w_elem(n0 + n, k0 + 8 * c, K / 64)) = o; }
    LDS_WAIT(); asm volatile("" ::: "memory");
}
__device__ __forceinline__ int t5_bucket(int rel) {
    const int n = rel < 0 ? -rel : rel; int bk;
    if (n < 8) bk = n; else if (n < 15) bk = 8; else if (n < 27) bk = 9; else if (n < 50) bk = 10; else if (n < 91) bk = 11; else if (n < 166) bk = 12; else if (n < 305) bk = 13; else if (n < 559) bk = 14; else bk = 15;
    return bk + (rel > 0 ? 16 : 0);
}
__device__ __forceinline__ void rms_row_to_bf16(const float* xrow, const float* g, bf16* H, int row, int lane) {
    const GAS f32x4* xr = (const GAS f32x4*)xrow + lane; const GAS f32x4* gr = (const GAS f32x4*)g + lane;
    f32x4 v[16]; float s = 0.f;
#pragma unroll
    for (int j = 0; j < 16; ++j) { v[j] = xr[64 * j]; s += (v[j].x * v[j].x + v[j].y * v[j].y) + (v[j].z * v[j].z + v[j].w * v[j].w); }
    const float rstd = 1.f / sqrtf(wave_sum(s) * (1.f / DM) + RMS_EPS);
#pragma unroll
    for (int j = 0; j < 16; ++j) { const f32x4 gg = gr[64 * j];
        *(GAS unsigned long long*)(H + pg8::tiled_elem(row, 4 * (64 * j + lane), DM / 64)) = (unsigned long long)pk2(v[j].x * rstd * gg.x, v[j].y * rstd * gg.y) | ((unsigned long long)pk2(v[j].z * rstd * gg.z, v[j].w * rstd * gg.w) << 32); }
}
__device__ __forceinline__ void p0_prologue(Frame& F) {
    const int tid_ = opaque_tid(), lane_ = tid_ & 63;
    LAS float* scr = (LAS float*)(F.lds + RING_OFF + F.wave * 16384);
    const int gw = F.vcu * NWAVES + F.wave, NGW = F.G * NWAVES;
    constexpr int I_IN = (DM / 64) * (NPROJ / 32), I_OUT = (DM / 64) * (DM / 32), I_UP = (DM / 64) * (DFF / 32), I_DN = (DFF / 64) * (DM / 32);
    constexpr int I_L = I_IN + I_OUT + I_UP + I_DN, NITEMS = DEPTH * I_L;
    for (int it = gw; it < NITEMS; it += NGW) {
        const int l = it / I_L; int r = it % I_L;
        if (r < I_IN) { p0_transpose_item(F.w_in + (size_t)l * DM * NPROJ, DM, NPROJ, F.Win_t + (size_t)l * NPROJ * DM, scr, r, lane_); continue; } r -= I_IN;
        if (r < I_OUT) { p0_transpose_item(F.w_out + (size_t)l * DM * DM, DM, DM, F.Wout_t + (size_t)l * DM * DM, scr, r, lane_); continue; } r -= I_OUT;
        if (r < I_UP) { p0_transpose_item(F.w_up + (size_t)l * DM * DFF, DM, DFF, F.Wup_t + (size_t)l * DFF * DM, scr, r, lane_); continue; } r -= I_UP;
        p0_transpose_item(F.w_down + (size_t)l * DFF * DM, DFF, DM, F.Wdn_t + (size_t)l * DM * DFF, scr, r, lane_);
    }
    for (int m = gw; m < M; m += NGW) rms_row_to_bf16(F.x + (size_t)m * DM, F.g_pre_mix, F.H, m, lane_);
    for (int i = blockIdx.x * (NWAVES * 64) + tid_; i < 32 * 8192; i += F.G * NWAVES * 64) { const int h = i >> 13, rel = (i & 8191) - 4095;
        F.BIAS[i] = (rel <= 4095) ? F.rel_bias[t5_bucket(rel) * 32 + h] * LOG2E : 0.f; }
    if (blockIdx.x == 0 && tid_ < DEPTH) { const int l = tid_; float a = 0.f, b = 0.f;
        for (int i = 0; i < DQ; ++i) { a += F.lq1[l * DQ + i] * F.lk1[l * DQ + i]; b += F.lq2[l * DQ + i] * F.lk2[l * DQ + i]; }
        const float li = 0.8f - 0.6f * expf(-0.3f * (float)l);
        F.ctl[CW_LAM + l] = __float_as_uint(expf(a) - expf(b) + li); }
}
template <bool XIN_BF, bool XOUT_BF> __device__ __forceinline__ void thin_phase(Frame& F, const void* xin, void* xout, const float* g_post, const float* g_next, bool want_h) {
    const int lane_ = opaque_tid() & 63;
    const int gw = F.vcu * NWAVES + F.wave, NGW = F.G * NWAVES;
    for (int row = gw; row < M; row += NGW) {
        const float ssq = wave_sum(F.PART[(size_t)row * NPART + lane_]);
        const float rstd = 1.f / sqrtf(ssq * (1.f / DM) + RMS_EPS);
        const GAS unsigned long long* yr = (const GAS unsigned long long*)(F.Y + (size_t)row * DM) + lane_;
        const GAS f32x4* xr = (const GAS f32x4*)((const float*)xin + (size_t)row * DM) + lane_; const GAS unsigned long long* xrb = (const GAS unsigned long long*)((const bf16*)xin + (size_t)row * DM) + lane_;
        const GAS f32x4* gp = (const GAS f32x4*)g_post + lane_;
        GAS f32x4* xo = (GAS f32x4*)((float*)xout + (size_t)row * DM) + lane_; GAS unsigned long long* xob = (GAS unsigned long long*)((bf16*)xout + (size_t)row * DM) + lane_;
        f32x4 v[16]; float s = 0.f;
#pragma unroll
        for (int j = 0; j < 16; ++j) { const unsigned long long yb = yr[64 * j]; const f32x4 y = {bflo((unsigned)yb), bfhi((unsigned)yb), bflo((unsigned)(yb >> 32)), bfhi((unsigned)(yb >> 32))}; const f32x4 g = gp[64 * j];
            f32x4 xx; if (XIN_BF) { const unsigned long long xb = xrb[64 * j]; xx = (f32x4){bflo((unsigned)xb), bfhi((unsigned)xb), bflo((unsigned)(xb >> 32)), bfhi((unsigned)(xb >> 32))}; } else xx = xr[64 * j];
            v[j] = xx + y * rstd * g;
            if (XOUT_BF) xob[64 * j] = (unsigned long long)pk2(v[j].x, v[j].y) | ((unsigned long long)pk2(v[j].z, v[j].w) << 32); else xo[64 * j] = v[j];
            s += (v[j].x * v[j].x + v[j].y * v[j].y) + (v[j].z * v[j].z + v[j].w * v[j].w); }
        if (want_h) {
            const float r2 = 1.f / sqrtf(wave_sum(s) * (1.f / DM) + RMS_EPS);
            const GAS f32x4* gn = (const GAS f32x4*)g_next + lane_;
#pragma unroll
            for (int j = 0; j < 16; ++j) { const f32x4 gg = gn[64 * j];
                *(GAS unsigned long long*)(F.H + pg8::tiled_elem(row, 4 * (64 * j + lane_), DM / 64)) = (unsigned long long)pk2(v[j].x * r2 * gg.x, v[j].y * r2 * gg.y) | ((unsigned long long)pk2(v[j].z * r2 * gg.z, v[j].w * r2 * gg.w) << 32); }
        }
    }
}
__device__ __forceinline__ void naive_dilated_item(const bf16* proj, bf16* MIX, const float* BIAS, int item, int tid) {
    const int b = item >> 9, h = (item >> 5) & 15, qc = item & 31;
    const int s = qc * 128 + (tid >> 2), quarter = tid & 3;
    const GAS v4u* qp = (const GAS v4u*)(proj + (size_t)(b * SEQ + s) * NPROJ + COL_QA + h * HD);
    unsigned q[64];
#pragma unroll
    for (int i = 0; i < 16; ++i) { const v4u t = qp[i]; q[4 * i] = t.x; q[4 * i + 1] = t.y; q[4 * i + 2] = t.z; q[4 * i + 3] = t.w; }
    float m = -1e30f, l = 0.f; float o[32];
#pragma unroll
    for (int i = 0; i < 32; ++i) o[i] = 0.f;
    const float* bt = BIAS + h * 8192 + 4095;
#pragma unroll 1
    for (int br = 0; br < 3; ++br) { const int dil = br == 0 ? 1 : (br == 1 ? 4 : 16);
#pragma unroll 1
        for (int j = -64; j <= 64; ++j) { const int p = s + j * dil; if (p < 0 || p >= SEQ) continue;
            const GAS v4u* kp = (const GAS v4u*)(proj + (size_t)(b * SEQ + p) * NPROJ + COL_KA + h * HD);
            float dot = 0.f;
#pragma unroll
            for (int i = 0; i < 16; ++i) { const v4u kv = kp[i];
                dot += bflo(q[4 * i]) * bflo(kv.x) + bfhi(q[4 * i]) * bfhi(kv.x); dot += bflo(q[4 * i + 1]) * bflo(kv.y) + bfhi(q[4 * i + 1]) * bfhi(kv.y);
                dot += bflo(q[4 * i + 2]) * bflo(kv.z) + bfhi(q[4 * i + 2]) * bfhi(kv.z); dot += bflo(q[4 * i + 3]) * bflo(kv.w) + bfhi(q[4 * i + 3]) * bfhi(kv.w); }
            const float sc = dot + bt[j * dil];
            if (sc > m) { const float a = exp2f(m - sc); l *= a;
#pragma unroll
                for (int i = 0; i < 32; ++i) o[i] *= a;
                m = sc; }
            const float pe = exp2f(sc - m); l += pe;
            const GAS v4u* vp = (const GAS v4u*)(proj + (size_t)(b * SEQ + p) * NPROJ + COL_VA + h * HD + quarter * 32);
#pragma unroll
            for (int i = 0; i < 4; ++i) { const v4u vv = vp[i];
                o[8 * i + 0] += pe * bflo(vv.x); o[8 * i + 1] += pe * bfhi(vv.x); o[8 * i + 2] += pe * bflo(vv.y); o[8 * i + 3] += pe * bfhi(vv.y);
                o[8 * i + 4] += pe * bflo(vv.z); o[8 * i + 5] += pe * bfhi(vv.z); o[8 * i + 6] += pe * bflo(vv.w); o[8 * i + 7] += pe * bfhi(vv.w); }
        } }
    const float inv = 1.f / l;
    GAS v4u* op = (GAS v4u*)(MIX + (size_t)(b * SEQ + s) * DM + h * HD + quarter * 32);
#pragma unroll
    for (int i = 0; i < 4; ++i) { v4u w; w.x = pk2(o[8 * i] * inv, o[8 * i + 1] * inv); w.y = pk2(o[8 * i + 2] * inv, o[8 * i + 3] * inv); w.z = pk2(o[8 * i + 4] * inv, o[8 * i + 5] * inv); w.w = pk2(o[8 * i + 6] * inv, o[8 * i + 7] * inv); op[i] = w; }
}
__device__ __forceinline__ void naive_diff_item(const bf16* proj, bf16* MIX, const float* BIAS, const float* g_subln, float lam, int item, int layer, int tid) {
    const int b = item >> 10, h = (item >> 6) & 15, qc = item & 63;
    const int s = qc * 64 + (tid >> 3), oct = tid & 7;
    const GAS v4u* qp = (const GAS v4u*)(proj + (size_t)(b * SEQ + s) * NPROJ + COL_QD + h * HD);
    unsigned q[64];
#pragma unroll
    for (int i = 0; i < 16; ++i) { const v4u t = qp[i]; q[4 * i] = t.x; q[4 * i + 1] = t.y; q[4 * i + 2] = t.z; q[4 * i + 3] = t.w; }
    float m0 = -1e30f, l0 = 0.f, m1 = -1e30f, l1 = 0.f; float o0[16], o1[16];
#pragma unroll
    for (int i = 0; i < 16; ++i) { o0[i] = 0.f; o1[i] = 0.f; }
    const float* bt = BIAS + (NHA + h) * 8192 + 4095 - s;
    const bf16* kbase = proj + (size_t)(b * SEQ) * NPROJ + COL_KD + h * HD; const bf16* vbase = proj + (size_t)(b * SEQ) * NPROJ + COL_VD + h * HD + oct * 16;
#pragma unroll 1
    for (int p = 0; p < SEQ; ++p) {
        const GAS v4u* kp = (const GAS v4u*)(kbase + (size_t)p * NPROJ);
        float d0 = 0.f, d1 = 0.f;
#pragma unroll
        for (int i = 0; i < 8; ++i) { const v4u kv = kp[i];
            d0 += bflo(q[4 * i]) * bflo(kv.x) + bfhi(q[4 * i]) * bfhi(kv.x); d0 += bflo(q[4 * i + 1]) * bflo(kv.y) + bfhi(q[4 * i + 1]) * bfhi(kv.y);
            d0 += bflo(q[4 * i + 2]) * bflo(kv.z) + bfhi(q[4 * i + 2]) * bfhi(kv.z); d0 += bflo(q[4 * i + 3]) * bflo(kv.w) + bfhi(q[4 * i + 3]) * bfhi(kv.w); }
#pragma unroll
        for (int i = 8; i < 16; ++i) { const v4u kv = kp[i];
            d1 += bflo(q[4 * i]) * bflo(kv.x) + bfhi(q[4 * i]) * bfhi(kv.x); d1 += bflo(q[4 * i + 1]) * bflo(kv.y) + bfhi(q[4 * i + 1]) * bfhi(kv.y);
            d1 += bflo(q[4 * i + 2]) * bflo(kv.z) + bfhi(q[4 * i + 2]) * bfhi(kv.z); d1 += bflo(q[4 * i + 3]) * bflo(kv.w) + bfhi(q[4 * i + 3]) * bfhi(kv.w); }
        const float bias = bt[p]; const float s0 = d0 + bias, s1 = d1 + bias;
        if (s0 > m0) { const float a = exp2f(m0 - s0); l0 *= a;
#pragma unroll
            for (int i = 0; i < 16; ++i) o0[i] *= a;
            m0 = s0; }
        if (s1 > m1) { const float a = exp2f(m1 - s1); l1 *= a;
#pragma unroll
            for (int i = 0; i < 16; ++i) o1[i] *= a;
            m1 = s1; }
        const float p0 = exp2f(s0 - m0), p1 = exp2f(s1 - m1); l0 += p0; l1 += p1;
        const GAS v4u* vp = (const GAS v4u*)(vbase + (size_t)p * NPROJ);
#pragma unroll
        for (int i = 0; i < 2; ++i) { const v4u vv = vp[i]; const float v0 = bflo(vv.x), v1 = bfhi(vv.x), v2 = bflo(vv.y), v3 = bfhi(vv.y), v4 = bflo(vv.z), v5 = bfhi(vv.z), v6 = bflo(vv.w), v7 = bfhi(vv.w);
            o0[8 * i + 0] += p0 * v0; o0[8 * i + 1] += p0 * v1; o0[8 * i + 2] += p0 * v2; o0[8 * i + 3] += p0 * v3; o0[8 * i + 4] += p0 * v4; o0[8 * i + 5] += p0 * v5; o0[8 * i + 6] += p0 * v6; o0[8 * i + 7] += p0 * v7;
            o1[8 * i + 0] += p1 * v0; o1[8 * i + 1] += p1 * v1; o1[8 * i + 2] += p1 * v2; o1[8 * i + 3] += p1 * v3; o1[8 * i + 4] += p1 * v4; o1[8 * i + 5] += p1 * v5; o1[8 * i + 6] += p1 * v6; o1[8 * i + 7] += p1 * v7; }
    }
    const float li = 0.8f - 0.6f * expf(-0.3f * (float)layer);
    const float i0 = 1.f / l0, i1 = lam / l1; float ssq = 0.f;
#pragma unroll
    for (int i = 0; i < 16; ++i) { o0[i] = o0[i] * i0 - o1[i] * i1; ssq += o0[i] * o0[i]; }
    ssq += __shfl_xor(ssq, 1); ssq += __shfl_xor(ssq, 2); ssq += __shfl_xor(ssq, 4);
    const float r = (1.f - li) / sqrtf(ssq * (1.f / HD) + SUBLN_EPS);
    const float* g = g_subln + layer * HD + oct * 16;
    GAS v4u* op = (GAS v4u*)(MIX + (size_t)(b * SEQ + s) * DM + DILW + h * HD + oct * 16);
#pragma unroll
    for (int i = 0; i < 2; ++i) { v4u w; w.x = pk2(o0[8 * i] * r * g[8 * i], o0[8 * i + 1] * r * g[8 * i + 1]); w.y = pk2(o0[8 * i + 2] * r * g[8 * i + 2], o0[8 * i + 3] * r * g[8 * i + 3]);
        w.z = pk2(o0[8 * i + 4] * r * g[8 * i + 4], o0[8 * i + 5] * r * g[8 * i + 5]); w.w = pk2(o0[8 * i + 6] * r * g[8 * i + 6], o0[8 * i + 7] * r * g[8 * i + 7]); op[i] = w; }
}

constexpr int DIL_V_OFF = 0, DIL_T_OFF = 131072;
template <int STAGE> __device__ __forceinline__ void dilated_phase(Frame& F, unsigned char* ws) {
    const int tid_ = opaque_tid();
    bf16* part_o = (bf16*)(ws + WS_U); float* part_ml = (float*)(ws + WS_U + (size_t)M * 16 * 2 * 128 * 2);
    LAS float* tsub = (LAS float*)(F.lds + DIL_T_OFF);
    for (int u = blockIdx.x; u < (STAGE == 0 ? 1024 : 512); u += F.G) {
        const int xg = u & 7, j = u >> 3; int bh, dil, res, S0, slot;
        if (STAGE == 0) { bh = 4 * xg + (j >> 5); const int idx = j & 31; if (idx < 16) { dil = 16; res = idx; S0 = 0; slot = 0; } else { dil = 4; res = (idx - 16) & 3; S0 = 256 * ((idx - 16) >> 2); slot = 1; } }
        else { bh = 4 * xg + (j >> 4); dil = 1; res = 0; S0 = 256 * (j & 15); slot = 0; }
        const int b = bh >> 4, h = bh & 15;
        asm volatile("s_waitcnt vmcnt(0) lgkmcnt(0)\n\ts_barrier" ::: "memory");
        for (int i = tid_; i < 576; i += NWAVES * 64) { const int br = i / 192, rel = (i % 192) - 96, d = br == 0 ? 1 : (br == 1 ? 4 : 16);
            tsub[i] = (rel >= -64 && rel <= 64) ? F.BIAS[h * 8192 + 4095 + rel * d] : -1e30f; }
        asm volatile("s_waitcnt vmcnt(0) lgkmcnt(0)\n\ts_barrier" ::: "memory");
        att::dilated_unit<STAGE>(F.PROJ, part_o, part_ml, F.MIX, F.lds, tsub + (dil == 1 ? 0 : (dil == 4 ? 192 : 384)), b, h, dil, res, S0, slot, tid_);
    }
    asm volatile("s_waitcnt vmcnt(0)" ::: "memory");
    __syncthreads();
}

#define IN(k) (lo <= (k) && (k) < hi)
#define SEAM(k) do { if (IN(k) && IN((k) + 1)) xcd_barrier(bar); } while (0)
template <int l> __device__ __forceinline__ void layer_phases(Frame& F, const XcdBarrier& bar, const int lo, const int hi) {
        const int pb = 1 + 7 * l;
        if (IN(pb + 0)) {
            pg8::Gemm g{F.H, F.Win_t + (size_t)l * NPROJ * DM, M, NPROJ, DM}; pg8::StaticOrder S; S.init(M, NPROJ, F.G, (int)blockIdx.x);
            pg8::EpiBf16s<0> E{F.PROJ, NPROJ, COL_KA, COL_QD, COL_KD, SC_A, SC_D, 0};
            for (int dup_ = 0; dup_ < DUPN(2); ++dup_) pg8::gemm_phase<pg8::EpiBf16s<0>, pg8::StaticOrder, PG8_ALIGN, PG8_SP2>(F.lds + RING_OFF, g, S, E);
            SEAM(pb + 0);
        }
        if (IN(pb + 1)) {
            dilated_phase<0>(F, (unsigned char*)F.Y - WS_Y);
            { const float lam = __uint_as_float(__hip_atomic_load(F.ctl + CW_LAM + l, RLX_AGENT)); const float post = 1.f - (0.8f - 0.6f * expf(-0.3f * (float)l));
              for (int dup_ = 0; dup_ < DUPN(4); ++dup_) for (int u = blockIdx.x; u < 1024; u += F.G) { const int j = u >> 3, bh = (u & 7) * 4 + (j >> 5), qb = j & 31;
                  att::diff_unit<0>(F.PROJ, F.MIX, F.BIAS, F.g_subln + l * HD, lam, post, F.lds, bh >> 4, bh & 15, qb, opaque_tid()); }
              if (PROBE_GV > 0) for (int u = blockIdx.x; u < 1024; u += F.G) { const int j = u >> 3, bh = (u & 7) * 4 + (j >> 5), qb = j & 31;
                  att::diff_unit<PROBE_GV>(F.PROJ, F.MIX, F.BIAS, F.g_subln + l * HD, lam, post, F.lds, bh >> 4, bh & 15, qb, opaque_tid()); }
              __syncthreads(); }
            xcd_barrier(bar);
            dilated_phase<1>(F, (unsigned char*)F.Y - WS_Y);
            SEAM(pb + 1);
        }
        if (IN(pb + 2)) {
            pg8::Gemm g{F.MIX, F.Wout_t + (size_t)l * DM * DM, M, DM, DM}; pg8::StaticOrder S; S.init(M, DM, F.G, (int)blockIdx.x);
            pg8::EpiBf16Ssq E{F.Y, DM, F.PART, NPART};
            for (int dup_ = 0; dup_ < DUPN(5); ++dup_) pg8::gemm_phase<pg8::EpiBf16Ssq, pg8::StaticOrder, PG8_ALIGN, PG8_SP2>(F.lds + RING_OFF, g, S, E);
            SEAM(pb + 2);
        }
        if (IN(pb + 3)) { bf16* XB = (bf16*)((unsigned char*)F.Y + 64 * MiB);
            if (l == 0) thin_phase<false, true>(F, F.x, XB, F.g_post_mix + l * DM, F.g_pre_mlp + l * DM, true); else thin_phase<true, true>(F, XB, XB, F.g_post_mix + l * DM, F.g_pre_mlp + l * DM, true);
            SEAM(pb + 3); }
        if (IN(pb + 4)) {
            pg8::Gemm g{F.H, F.Wup_t + (size_t)l * DFF * DM, M, DFF, DM}; pg8::StaticOrder S; S.init(M, DFF, F.G, (int)blockIdx.x);
            pg8::EpiBf16s<1> E{F.U, DFF, 0, 0, 0, 1.f, 1.f, DFF / 64};
            for (int dup_ = 0; dup_ < DUPN(6); ++dup_) pg8::gemm_phase<pg8::EpiBf16s<1>, pg8::StaticOrder, PG8_ALIGN, PG8_SP2>(F.lds + RING_OFF, g, S, E);
            if (PROBE_GG > 0) { pg8::EpiBf16s<1> Eg{(bf16*)((unsigned char*)F.Y - WS_Y + WS_END), DFF, 0, 0, 0, 1.f, 1.f};
                if (PROBE_GG == 5) { pg8::Gemm gp = g; gp.lda = DM + 64; gp.ldb = DM + 64; pg8::gemm_phase<pg8::EpiBf16s<1>, pg8::StaticOrder, PG8_ALIGN, PG8_SP2>(F.lds + RING_OFF, gp, S, Eg); }
                else if (PROBE_GG == 1) pg8::gemm_phase<pg8::EpiBf16s<1>, pg8::StaticOrder, PG8_ALIGN, PG8_SP2>(F.lds + RING_OFF, g, S, Eg);
                else { pg8::FixedOrder Sf; Sf.init(M, DFF, F.G, (int)blockIdx.x); Sf.mode = PROBE_GG; pg8::gemm_phase<pg8::EpiBf16s<1>, pg8::FixedOrder, PG8_ALIGN, PG8_SP2>(F.lds + RING_OFF, g, Sf, Eg); } }
            SEAM(pb + 4);
        }
        if (IN(pb + 5)) {
            pg8::Gemm g{F.U, F.Wdn_t + (size_t)l * DM * DFF, M, DM, DFF}; pg8::StaticOrder S; S.init(M, DM, F.G, (int)blockIdx.x);
            pg8::EpiBf16Ssq E{F.Y, DM, F.PART, NPART};
            for (int dup_ = 0; dup_ < DUPN(7); ++dup_) pg8::gemm_phase<pg8::EpiBf16Ssq, pg8::StaticOrder, PG8_ALIGN, PG8_SP2>(F.lds + RING_OFF, g, S, E);
            SEAM(pb + 5);
        }
        if (IN(pb + 6)) { bf16* XB = (bf16*)((unsigned char*)F.Y + 64 * MiB);
            if (l + 1 < DEPTH) thin_phase<true, true>(F, XB, XB, F.g_post_mlp + l * DM, F.g_pre_mix + (l + 1) * DM, true); else thin_phase<true, false>(F, XB, F.out, F.g_post_mlp + l * DM, F.g_post_mlp + l * DM, false);
            SEAM(pb + 6); }
    }
#undef IN
#undef SEAM

struct Args { const float* in[15]; float* out; unsigned char* ws; int ph_lo, ph_hi, pad0, pad1; };
__global__ void __launch_bounds__(NWAVES * 64, 2) mk_fwd(Args args) {
    extern __shared__ __attribute__((aligned(16))) unsigned char lds[];
    Frame F;
    F.lds = (LAS unsigned char*)lds;
    F.MISC = (volatile LAS unsigned*)(F.lds + MISC_OFF);
    F.tid = threadIdx.x; F.lane = F.tid & 63; F.wave = __builtin_amdgcn_readfirstlane(F.tid >> 6);
    F.G = gridDim.x; { const int bx = blockIdx.x; F.vcu = (F.G % 8 == 0) ? (bx % 8) * (F.G / 8) + bx / 8 : bx; }
    unsigned char* ws = args.ws;
    F.ctl = (gu32*)(ws + WS_CTL);
    F.x = args.in[0]; F.rel_bias = args.in[1]; F.g_pre_mix = args.in[2]; F.w_in = args.in[3]; F.lq1 = args.in[4]; F.lk1 = args.in[5]; F.lq2 = args.in[6]; F.lk2 = args.in[7];
    F.g_subln = args.in[8]; F.w_out = args.in[9]; F.g_post_mix = args.in[10]; F.g_pre_mlp = args.in[11]; F.w_up = args.in[12]; F.w_down = args.in[13]; F.g_post_mlp = args.in[14];
    F.out = args.out;
    F.Win_t = (bf16*)(ws + WS_WIN); F.Wout_t = (bf16*)(ws + WS_WOUT); F.Wup_t = (bf16*)(ws + WS_WUP); F.Wdn_t = (bf16*)(ws + WS_WDN);
    F.H = (bf16*)(ws + WS_H); F.PROJ = (bf16*)(ws + WS_PROJ); F.MIX = (bf16*)(ws + WS_MIX); F.U = (bf16*)(ws + WS_U);
    F.Y = (bf16*)(ws + WS_Y); F.PART = (float*)(ws + WS_PART); F.BIAS = (float*)(ws + WS_BIAS);
    for (int u = F.tid; u < (LDS_BYTES - LDSCTL_OFF) / 4; u += NWAVES * 64) ((LAS unsigned*)(F.lds + LDSCTL_OFF))[u] = 0u;
    __syncthreads();
    XcdBarrier bar; bar.bar = (unsigned*)(F.ctl + CW_BAR); bar.x = 0; bar.st = nullptr;
    const bool one = (args.ph_hi - args.ph_lo) > 1;
    if (one) bar = xcd_barrier_post((unsigned*)(F.ctl + CW_BAR), F.MISC + 8);
    const int lo = args.ph_lo, hi = args.ph_hi;
#define IN(k) (lo <= (k) && (k) < hi)
#define SEAM(k) do { if (IN(k) && IN((k) + 1)) xcd_barrier(bar); } while (0)

    if (PROBE_CLK > 0 && IN(0)) {
        const int w_ = F.wave;
        if (PROBE_CLK != 9 || w_ < 4) {
            if (PROBE_CLK == 8 && w_ >= 4) __builtin_amdgcn_s_setprio(1);
            att::f32x16 a0 = {}, a1 = {}, a2 = {}, a3 = {}; att::bf16x8 x = {0x3f80, 0x4000, 0x3fc0, 0x4040, 0x3f80, 0x4000, 0x3fc0, 0x4040}, y = {0x3f80, 0x3f00, 0x3e80, 0x3f80, 0x3f80, 0x3f00, 0x3e80, 0x3f80}; asm volatile("" : "+v"(x), "+v"(y));
            float v0 = (float)threadIdx.x, v1 = v0 + 1.f, v2 = v0 + 2.f, v3 = v0 + 3.f, v4 = v0 + 4.f, v5 = v0 + 5.f; const float c = 0.999f;
#define PC_V6() do { v0 = fmaf(v0, c, 0.5f); v1 = fmaf(v1, c, 0.5f); v2 = fmaf(v2, c, 0.5f); if (PROBE_CLK != 7) { v3 = fmaf(v3, c, 0.5f); v4 = fmaf(v4, c, 0.5f); v5 = fmaf(v5, c, 0.5f); } } while (0)
#pragma unroll 1
            for (int i = 0; i < 6250; ++i) {
                a0 = __builtin_amdgcn_mfma_f32_32x32x16_bf16(x, y, a0, 0, 0, 0); PC_V6(); __builtin_amdgcn_sched_barrier(0);
                a1 = __builtin_amdgcn_mfma_f32_32x32x16_bf16(x, y, a1, 0, 0, 0); PC_V6(); __builtin_amdgcn_sched_barrier(0);
                a2 = __builtin_amdgcn_mfma_f32_32x32x16_bf16(x, y, a2, 0, 0, 0); PC_V6(); __builtin_amdgcn_sched_barrier(0);
                a3 = __builtin_amdgcn_mfma_f32_32x32x16_bf16(x, y, a3, 0, 0, 0); PC_V6(); __builtin_amdgcn_sched_barrier(0); }
#undef PC_V6
            if (a0[0] + a1[1] + a2[2] + a3[3] + v0 + v1 + v2 + v3 + v4 + v5 == -1.2345f) F.out[threadIdx.x] = 0.f;
            if (PROBE_CLK == 8 && w_ >= 4) __builtin_amdgcn_s_setprio(0); }
        __syncthreads(); }
    if (IN(0)) { for (int dup_ = 0; dup_ < DUPN(1); ++dup_) p0_prologue(F); SEAM(0); for (int eb_ = 0; eb_ < PROBE_BAR; ++eb_) xcd_barrier(bar); }

    layer_phases<0>(F, bar, lo, hi);
    layer_phases<1>(F, bar, lo, hi);
#undef IN
#undef SEAM
}

extern "C" void kernel_launch(void* const* d_in, const int* in_sizes, int n_in, void* d_out, int out_size, void* d_ws, size_t ws_size, hipStream_t stream) {
    static int grid = 0;
    if (grid == 0) {
        if (n_in != 15 || in_sizes[0] != M * DM || out_size != M * DM || ws_size < WS_END) { fprintf(stderr, "kernel_launch: shape mismatch (n_in %d, in0 %d, out %d, ws %zu < %zu); nothing launched\n", n_in, n_in > 0 ? in_sizes[0] : -1, out_size, ws_size, (size_t)WS_END); grid = -1; return; }
        int dev = 0, cus = 0, per_cu = 0;
        if (hipGetDevice(&dev) != hipSuccess || hipDeviceGetAttribute(&cus, hipDeviceAttributeMultiprocessorCount, dev) != hipSuccess) { grid = -1; return; }
        if (hipFuncSetAttribute((const void*)mk_fwd, hipFuncAttributeMaxDynamicSharedMemorySize, LDS_BYTES) != hipSuccess) { fprintf(stderr, "kernel_launch: hipFuncSetAttribute failed\n"); grid = -1; return; }
        if (hipOccupancyMaxActiveBlocksPerMultiprocessor(&per_cu, (const void*)mk_fwd, NWAVES * 64, LDS_BYTES) != hipSuccess || per_cu < 1)
            fprintf(stderr, "kernel_launch: note: occupancy query reports %d workgroups per CU\n", per_cu);
        (void)hipGetLastError();
        grid = cus;
    }
    if (grid < 0) return;
    if (hipMemsetAsync((char*)d_ws + WS_CTL, 0, CTL_ZERO_BYTES, stream) != hipSuccess) { fprintf(stderr, "kernel_launch: memset failed\n"); return; }
    Args a{};
    for (int i = 0; i < 15; ++i) a.in[i] = (const float*)d_in[i];
    a.out = (float*)d_out; a.ws = (unsigned char*)d_ws; a.pad0 = 0; a.pad1 = 0;
#if MK_ONE_LAUNCH
    a.ph_lo = 0; a.ph_hi = N_PHASES;
    hipLaunchKernelGGL(mk_fwd, dim3(grid), dim3(NWAVES * 64), LDS_BYTES, stream, a);
#else
    for (int p = 0; p < N_PHASES; ++p) {
        a.ph_lo = p; a.ph_hi = p + 1; hipLaunchKernelGGL(mk_fwd, dim3(grid), dim3(NWAVES * 64), LDS_BYTES, stream, a); }
#endif
    const hipError_t le = hipPeekAtLastError();
    if (le != hipSuccess) fprintf(stderr, "kernel_launch: launch failed: %s\n", hipGetErrorName(le));
}
```

```cpp
#include <hip/hip_runtime.h>
#include <cstdio>
#include <cstdint>
namespace pg8 {
#define PG8_LAS __attribute__((address_space(3)))
typedef unsigned short bf16_t;
typedef short bf16x8 __attribute__((ext_vector_type(8)));
typedef float f32x4 __attribute__((ext_vector_type(4)));
typedef unsigned u32x4 __attribute__((ext_vector_type(4)));
constexpr int BM = 256, BK = 64, HALF = 128, HTB = HALF * BK * 2  , STAGE_BYTES = 8 * HTB, NXCD = 8, WGM = 8;

__host__ __device__ __forceinline__ int lds_byte(int r, int c) { const int st = (r >> 4) * 2 + (c >> 5), rr = r & 15, cc = c & 31, ob = rr * 64 + cc * 2; return st * 1024 + (ob ^ (((ob >> 9) & 1) << 5)); }
__host__ __device__ __forceinline__ void stage_rc(int b, int& R, int& C) { const int st = b / 1024, sb = b % 1024, swz = sb ^ (((sb >> 9) & 1) << 5); R = (st >> 1) * 16 + swz / 64; C = (st & 1) * 32 + (swz % 64) / 2; }
__host__ __device__ __forceinline__ int perm32(int rho) { const int n = rho >> 4, i = rho & 15; return 8 * (i >> 2) + 4 * n + (i & 3); }

__host__ __device__ __forceinline__ size_t tiled_elem(int row, int col, int nKt) { return ((((size_t)(row >> 8) * nKt + (col >> 6)) * 2 + ((row >> 7) & 1)) * 8192) + (size_t)(lds_byte(row & 127, col & 63) >> 1); }
__host__ __device__ __forceinline__ int inv_perm32(int v) { return 16 * ((v >> 2) & 1) + 4 * (v >> 3) + (v & 3); }
__host__ __device__ __forceinline__ size_t tiled_w_elem(int n, int k, int nKt) { const int nl = n & 127, R = (nl & ~31) + inv_perm32(nl & 31); return ((((size_t)(n >> 8) * nKt + (k >> 6)) * 2 + ((n >> 7) & 1)) * 8192) + (size_t)(lds_byte(R, k & 63) >> 1); }

struct Unit { int pm, pn; };
struct Gemm { const bf16_t* A; const bf16_t* Bt; int M, N, K; int lda = 0, ldb = 0; };

struct StaticOrder {
    int nM, nN, nwg, G, c;
    __host__ __device__ void init(int M, int N, int G_, int c_) { nM = M / BM; nN = N / BM; nwg = nM * nN; G = G_; c = c_; }
    __host__ __device__ bool next(int i, Unit& u) const {
        const long L = (long)i * G + c; if (L >= nwg) return false;
        int wgid = (int)L; { const int q = nwg / NXCD, r = nwg % NXCD, xcd = wgid % NXCD, off = wgid / NXCD; wgid = (xcd < r ? xcd * (q + 1) : r * (q + 1) + (xcd - r) * q) + off; }
        const int nig = WGM * nN, gid = wgid / nig, fm = gid * WGM, gsz = (nM - fm) < WGM ? (nM - fm) : WGM;
        u.pm = fm + ((wgid % nig) % gsz); u.pn = (wgid % nig) / gsz; return true;
    }
    __device__ __forceinline__ void a_ready(const Unit&) const {}
    __device__ __forceinline__ void done(const Unit&) const {}
};

__device__ __forceinline__ unsigned cvt_pk_bf16(float lo, float hi) { unsigned r; asm volatile("v_cvt_pk_bf16_f32 %0, %1, %2" : "=v"(r) : "v"(lo), "v"(hi)); return r; }
typedef float f32x2 __attribute__((ext_vector_type(2)));
template <int MODE> struct EpiBf16s {
    static constexpr bool PERM = true, AFTER_DRAIN = false;
    bf16_t* O; int ldc; int qa_end, qd_lo, qd_hi; float sc_a, sc_d; int tiled_nkt;
    __device__ __forceinline__ void operator()(const f32x4 (&acc)[2][2][4][2], const Unit& u, int wr, int wc, int fr, int fq) const {
        const int row0 = u.pm * BM + wr * 64 + fr; const int colt = u.pn * BM;
        float sc = 1.f; if (MODE == 0) { if (colt < qa_end) sc = sc_a; else if (colt >= qd_lo && colt < qd_hi) sc = sc_d; }
        const int col0 = colt + wc * 32 + 8 * fq;
        bf16_t* tb_ = O + ((size_t)(u.pm * tiled_nkt + (colt >> 6) + (wc >> 1)) * 2) * 8192 + (wr * 4 * 2 + (wc & 1)) * 512 + (((fr * 64 + fq * 16) ^ ((((fr * 64 + fq * 16) >> 9) & 1) << 5)) >> 1);
#pragma unroll
        for (int ai = 0; ai < 2; ++ai)
#pragma unroll
            for (int m = 0; m < 4; ++m) { bf16_t* rowp = O + (size_t)(row0 + ai * HALF + m * 16) * ldc + col0;
#pragma unroll
                for (int bj = 0; bj < 2; ++bj) { f32x4 v0 = acc[ai][bj][m][0], v1 = acc[ai][bj][m][1];
                    if (MODE == 1) {
#pragma unroll
                        for (int e = 0; e < 4; ++e) { const float a = fmaxf(v0[e], 0.f), b = fmaxf(v1[e], 0.f); v0[e] = a * a; v1[e] = b * b; }
                    } else { v0 = v0 * sc; v1 = v1 * sc; }
                    u32x4 w; w.x = cvt_pk_bf16(v0[0], v0[1]); w.y = cvt_pk_bf16(v0[2], v0[3]); w.z = cvt_pk_bf16(v1[0], v1[1]); w.w = cvt_pk_bf16(v1[2], v1[3]);
                    if (tiled_nkt) *(u32x4*)(tb_ + (size_t)(bj * 2 * 2 + ai) * 8192 + m * 1024) = w; else *(u32x4*)(rowp + bj * HALF) = w; } }
    }
};
struct EpiF32Ssq {
    static constexpr bool PERM = false, AFTER_DRAIN = false;
    float* C; int ldc; float* part; int npart;
    __device__ __forceinline__ void operator()(const f32x4 (&acc)[2][2][4][2], const Unit& u, int wr, int wc, int fr, int fq) const {
        const int row0 = u.pm * BM + wr * 64 + fr, col0 = u.pn * BM + wc * 32 + 4 * fq;
#pragma unroll
        for (int ai = 0; ai < 2; ++ai)
#pragma unroll
            for (int m = 0; m < 4; ++m) { const int row = row0 + ai * HALF + m * 16; float* rowp = C + (size_t)row * ldc + col0; float s = 0.f;
#pragma unroll
                for (int bj = 0; bj < 2; ++bj)
#pragma unroll
                    for (int n = 0; n < 2; ++n) { const f32x4 x = acc[ai][bj][m][n]; *(f32x4*)(rowp + bj * HALF + n * 16) = x; s += (x[0] * x[0] + x[1] * x[1]) + (x[2] * x[2] + x[3] * x[3]); }
                s += __shfl_xor(s, 16); s += __shfl_xor(s, 32);
                if (fq == 0) part[(size_t)row * npart + u.pn * 4 + wc] = s; }
    }
};

struct EpiBf16Ssq {
    static constexpr bool PERM = true, AFTER_DRAIN = false;
    bf16_t* C; int ldc; float* part; int npart;
    __device__ __forceinline__ void operator()(const f32x4 (&acc)[2][2][4][2], const Unit& u, int wr, int wc, int fr, int fq) const {
        const int row0 = u.pm * BM + wr * 64 + fr, col0 = u.pn * BM + wc * 32 + 8 * fq;
#pragma unroll
        for (int ai = 0; ai < 2; ++ai)
#pragma unroll
            for (int m = 0; m < 4; ++m) { const int row = row0 + ai * HALF + m * 16; bf16_t* rowp = C + (size_t)row * ldc + col0; float s = 0.f;
#pragma unroll
                for (int bj = 0; bj < 2; ++bj) { const f32x4 v0 = acc[ai][bj][m][0], v1 = acc[ai][bj][m][1];
                    s += (v0[0] * v0[0] + v0[1] * v0[1]) + (v0[2] * v0[2] + v0[3] * v0[3]) + (v1[0] * v1[0] + v1[1] * v1[1]) + (v1[2] * v1[2] + v1[3] * v1[3]);
                    u32x4 w; w.x = cvt_pk_bf16(v0[0], v0[1]); w.y = cvt_pk_bf16(v0[2], v0[3]); w.z = cvt_pk_bf16(v1[0], v1[1]); w.w = cvt_pk_bf16(v1[2], v1[3]);
                    *(u32x4*)(rowp + bj * HALF) = w; }
                s += __shfl_xor(s, 16); s += __shfl_xor(s, 32);
                if (fq == 0) part[(size_t)row * npart + u.pn * 4 + wc] = s; }
    }
};
struct FixedOrder : StaticOrder { int mode;
    __host__ __device__ bool next(int i, Unit& u) const { const long L = (long)i * G + c; if (L >= nwg) return false; if (mode == 2) { u.pm = 0; u.pn = 0; } else { u.pm = c % 8; u.pn = (c / 8) % 2; } return true; }
};
template <class Epi, class Sched, bool ALIGN_EPI = false, bool SP2 = false>
__device__ __forceinline__ void gemm_phase(PG8_LAS unsigned char* lds, const Gemm g, const Sched& S, const Epi& E) {
    int tid = threadIdx.x; asm volatile("" : "+v"(tid)); const int wid = __builtin_amdgcn_readfirstlane(tid >> 6), lane = tid & 63, wr = wid >> 2, wc = wid & 3, fr = lane & 15, fq = lane >> 4;
    static_assert(Epi::PERM, "the weight image has the perm32 row order baked in");
    const int K = g.K, nt = K / BK;
    unsigned voffA[2], voffB[2];
#pragma unroll
    for (int i = 0; i < 2; ++i) { voffA[i] = (unsigned)(tid * 16 + i * 8192); voffB[i] = voffA[i]; }
    const size_t kstep = 32768;
    const size_t hstepA = 16384, hstepB = 16384;
    const size_t tstepA = (size_t)nt * 32768, tstepB = tstepA;
    const unsigned ldsw = (unsigned)wid * 1024u;
    const int aoff = lds_byte(wr * 64 + fr, fq * 8), boff = lds_byte(wc * 32 + fr, fq * 8);
#define PG8_SA(b, h) (((b) * 2 + (h)) * HTB)
#define PG8_SB(b, h) ((4 + (b) * 2 + (h)) * HTB)
#define PG8_STAGE(bufoff, gbase, voff) do { _Pragma("unroll") for (int _i = 0; _i < 2; ++_i) \
        __builtin_amdgcn_global_load_lds((const unsigned*)((const char*)(gbase) + (voff)[_i]), (PG8_LAS unsigned*)(lds + (bufoff) + ldsw + _i * 8192), 16, 0, 0); } while (0)
#define PG8_LDA(dst, b, h) do { _Pragma("unroll") for (int m = 0; m < 4; ++m) _Pragma("unroll") for (int k = 0; k < 2; ++k) dst[m][k] = *(const PG8_LAS bf16x8*)(lds + PG8_SA(b, h) + aoff + m * 2048 + k * 1024); } while (0)
#define PG8_LDB(dst, b, h) do { _Pragma("unroll") for (int n = 0; n < 2; ++n) _Pragma("unroll") for (int k = 0; k < 2; ++k) dst[n][k] = *(const PG8_LAS bf16x8*)(lds + PG8_SB(b, h) + boff + n * 2048 + k * 1024); } while (0)
#define PG8_MMA(ai, bj, At, Bt) do { __builtin_amdgcn_s_setprio(1); _Pragma("unroll") for (int m = 0; m < 4; ++m) _Pragma("unroll") for (int n = 0; n < 2; ++n) _Pragma("unroll") for (int k = 0; k < 2; ++k) \
        acc[ai][bj][m][n] = __builtin_amdgcn_mfma_f32_16x16x32_bf16(Bt[n][k], At[m][k], acc[ai][bj][m][n], 0, 0, 0); __builtin_amdgcn_s_setprio(0); } while (0)
#define PG8_WAIT_V(n) asm volatile("s_waitcnt vmcnt(" #n ")" ::: "memory")
#define PG8_WAIT_L(n) asm volatile("s_waitcnt lgkmcnt(" #n ")" ::: "memory")
#define PG8_BAR __builtin_amdgcn_s_barrier()
#define PG8_SCHED __builtin_amdgcn_sched_barrier(0)
    Unit cur, nxt; int ui = 0;
    if (!S.next(0, cur)) return;
    f32x4 acc[2][2][4][2];
#pragma unroll
    for (int a = 0; a < 2; ++a)
#pragma unroll
        for (int b = 0; b < 2; ++b)
#pragma unroll
            for (int m = 0; m < 4; ++m)
#pragma unroll
                for (int n = 0; n < 2; ++n) acc[a][b][m][n] = (f32x4){0.f, 0.f, 0.f, 0.f};
    bf16x8 At[4][2], B0[2][2], B1[2][2];
    const char* cA = (const char*)g.A + (size_t)cur.pm * tstepA; const char* cB = (const char*)g.Bt + (size_t)cur.pn * tstepB;
    S.a_ready(cur);
    if constexpr (SP2) {
        PG8_STAGE(PG8_SB(0, 0), cB, voffB); PG8_STAGE(PG8_SB(0, 1), cB + hstepB, voffB); PG8_STAGE(PG8_SA(0, 0), cA, voffA); PG8_STAGE(PG8_SA(0, 1), cA + hstepA, voffA);
        if (wr == 1) PG8_BAR;
        PG8_WAIT_V(2); PG8_BAR;
        PG8_STAGE(PG8_SB(1, 0), cB + kstep, voffB); PG8_STAGE(PG8_SA(1, 0), cA + kstep, voffA); PG8_STAGE(PG8_SB(1, 1), cB + hstepB + kstep, voffB);
        PG8_WAIT_V(6); PG8_BAR;
    } else {
        PG8_STAGE(PG8_SB(0, 0), cB, voffB); PG8_STAGE(PG8_SA(0, 0), cA, voffA); PG8_STAGE(PG8_SB(0, 1), cB + hstepB, voffB); PG8_STAGE(PG8_SA(0, 1), cA + hstepA, voffA);
        if (wr == 1) PG8_BAR;
        PG8_WAIT_V(4); PG8_BAR;
        PG8_STAGE(PG8_SB(1, 0), cB + kstep, voffB); PG8_STAGE(PG8_SA(1, 0), cA + kstep, voffA); PG8_STAGE(PG8_SB(1, 1), cB + hstepB + kstep, voffB);
        PG8_WAIT_V(6); PG8_BAR;
    }
    for (;;) {
        const bool has_next = S.next(ui + 1, nxt);
        const char* nA = has_next ? (const char*)g.A + (size_t)nxt.pm * tstepA : cA; const char* nB = has_next ? (const char*)g.Bt + (size_t)nxt.pn * tstepB : cB;
        for (int t = 0; t < nt; t += 2) {
            const bool last = (t == nt - 2);
            const char* a1 = cA + (size_t)(t + 1) * kstep;
            const char* a2 = last ? nA : cA + (size_t)(t + 2) * kstep; const char* b2 = last ? nB : cB + (size_t)(t + 2) * kstep;
            const char* a3 = a2 + kstep; const char* b3 = b2 + kstep;
            if (last && has_next) S.a_ready(nxt);
            if constexpr (SP2) {
            PG8_LDB(B0, 0, 0); PG8_LDB(B1, 0, 1); PG8_SCHED; PG8_LDA(At, 0, 0); PG8_STAGE(PG8_SA(1, 1), a1 + hstepA, voffA);
            PG8_WAIT_V(8); PG8_WAIT_L(0); PG8_BAR; PG8_MMA(0, 0, At, B0); PG8_MMA(0, 1, At, B1); PG8_BAR; PG8_SCHED;
            PG8_LDA(At, 0, 1); PG8_STAGE(PG8_SB(0, 0), b2, voffB); PG8_STAGE(PG8_SB(0, 1), b2 + hstepB, voffB); PG8_STAGE(PG8_SA(0, 0), a2, voffA);
            PG8_WAIT_V(8); PG8_WAIT_L(0); PG8_BAR; PG8_MMA(1, 0, At, B0); PG8_MMA(1, 1, At, B1); PG8_BAR; PG8_SCHED;
            PG8_LDB(B0, 1, 0); PG8_LDB(B1, 1, 1); PG8_SCHED; PG8_LDA(At, 1, 0); PG8_STAGE(PG8_SA(0, 1), a2 + hstepA, voffA);
            PG8_WAIT_V(8); PG8_WAIT_L(0); PG8_BAR; PG8_MMA(0, 0, At, B0); PG8_MMA(0, 1, At, B1); PG8_BAR; PG8_SCHED;
            PG8_LDA(At, 1, 1); PG8_STAGE(PG8_SB(1, 0), b3, voffB); PG8_STAGE(PG8_SB(1, 1), b3 + hstepB, voffB); PG8_STAGE(PG8_SA(1, 0), a3, voffA);
            PG8_WAIT_V(8); PG8_WAIT_L(0); PG8_BAR; PG8_MMA(1, 0, At, B0); PG8_MMA(1, 1, At, B1); PG8_BAR; PG8_SCHED;
            } else {
            PG8_LDB(B0, 0, 0); PG8_SCHED; PG8_LDA(At, 0, 0); PG8_STAGE(PG8_SA(1, 1), a1 + hstepA, voffA);
            PG8_WAIT_L(8); PG8_BAR; PG8_WAIT_L(0); PG8_MMA(0, 0, At, B0); PG8_BAR; PG8_SCHED;
            PG8_LDB(B1, 0, 1); PG8_STAGE(PG8_SB(0, 0), b2, voffB);
            PG8_BAR; PG8_WAIT_L(0); PG8_MMA(0, 1, At, B1); PG8_BAR;
            PG8_LDA(At, 0, 1); PG8_STAGE(PG8_SA(0, 0), a2, voffA);
            PG8_BAR; PG8_WAIT_L(0); PG8_MMA(1, 0, At, B0); PG8_BAR; PG8_SCHED;
            PG8_STAGE(PG8_SB(0, 1), b2 + hstepB, voffB);
            PG8_WAIT_V(6); PG8_BAR; PG8_MMA(1, 1, At, B1); PG8_BAR;
            PG8_LDB(B0, 1, 0); PG8_SCHED; PG8_LDA(At, 1, 0); PG8_STAGE(PG8_SA(0, 1), a2 + hstepA, voffA);
            PG8_WAIT_L(8); PG8_BAR; PG8_WAIT_L(0); PG8_MMA(0, 0, At, B0); PG8_BAR; PG8_SCHED;
            PG8_LDB(B1, 1, 1); PG8_STAGE(PG8_SB(1, 0), b3, voffB);
            PG8_BAR; PG8_WAIT_L(0); PG8_MMA(0, 1, At, B1); PG8_BAR;
            PG8_LDA(At, 1, 1); PG8_STAGE(PG8_SA(1, 0), a3, voffA);
            PG8_BAR; PG8_WAIT_L(0); PG8_MMA(1, 0, At, B0); PG8_BAR; PG8_SCHED;
            PG8_STAGE(PG8_SB(1, 1), b3 + hstepB, voffB);
            PG8_WAIT_V(6); PG8_BAR; PG8_MMA(1, 1, At, B1); PG8_BAR;
            }
        }
        if constexpr (ALIGN_EPI) { if (wr == 0) PG8_BAR; }
        if constexpr (!Epi::AFTER_DRAIN) { E(acc, cur, wr, wc, fr, fq); S.done(cur); }
        if (!has_next) break;
#pragma unroll
        for (int a = 0; a < 2; ++a)
#pragma unroll
            for (int b = 0; b < 2; ++b)
#pragma unroll
                for (int m = 0; m < 4; ++m)
#pragma unroll
                    for (int n = 0; n < 2; ++n) acc[a][b][m][n] = (f32x4){0.f, 0.f, 0.f, 0.f};
        cur = nxt; cA = nA; cB = nB; ++ui;
        if constexpr (ALIGN_EPI) { if (wr == 1) PG8_BAR; }
    }
    PG8_WAIT_V(0);
    if constexpr (!ALIGN_EPI) { if (wr == 0) PG8_BAR; }
    PG8_BAR;
    if constexpr (Epi::AFTER_DRAIN) { E.fused(acc, cur, wr, wc, fr, fq, lds, wid, lane); S.done(cur); }
#undef PG8_SA
#undef PG8_SB
#undef PG8_STAGE
#undef PG8_LDA
#undef PG8_LDB
#undef PG8_MMA
#undef PG8_WAIT_V
#undef PG8_WAIT_L
#undef PG8_BAR
#undef PG8_SCHED
}
}

#ifndef PG8_SP2
#define PG8_SP2 true
#endif
#ifndef PG8_ALIGN
#define PG8_ALIGN true
#endif
#define GAS __attribute__((address_space(1)))
#define LAS __attribute__((address_space(3)))
typedef unsigned short bf16;
typedef unsigned v4u __attribute__((ext_vector_type(4)));
typedef float f32x4 __attribute__((ext_vector_type(4)));
typedef short bf16x8 __attribute__((ext_vector_type(8)));
typedef GAS unsigned gu32;
typedef GAS unsigned long long gu64;
#define RLX_AGENT __ATOMIC_RELAXED, __HIP_MEMORY_SCOPE_AGENT
#define LDS_WAIT() asm volatile("s_waitcnt lgkmcnt(0)" ::: "memory")
#define VM_WAIT() asm volatile("s_waitcnt vmcnt(0)" ::: "memory")
__device__ __forceinline__ unsigned long long rt() { return __builtin_amdgcn_s_memrealtime(); }
__device__ __forceinline__ unsigned f2bf(float f) { unsigned u = __builtin_bit_cast(unsigned, f); return (u + 0x7fffu + ((u >> 16) & 1u)) >> 16; }
__device__ __forceinline__ unsigned pk2(float lo, float hi) { return f2bf(lo) | (f2bf(hi) << 16); }

#define XB_TMO      128
#define XB_XCNT(j)  (256  + 64 * (j))
#define XB_XSUB(j)  (1280 + 64 * (j))
#define XB_XGEN(j)  (2304 + 64 * (j))
#define XB_TOP      3328
#define XB_TOPGEN   3392
#define XCD_BAR_WORDS 3456
#define XB_SPIN_CAP (1u << 18)

__device__ __forceinline__ unsigned xb_ld(unsigned* p)              { return __hip_atomic_load(p, __ATOMIC_RELAXED, __HIP_MEMORY_SCOPE_AGENT); }
__device__ __forceinline__ unsigned xb_add(unsigned* p, unsigned v) { return __hip_atomic_fetch_add(p, v, __ATOMIC_RELAXED, __HIP_MEMORY_SCOPE_AGENT); }
__device__ __forceinline__ unsigned xb_xcc_id() { return (unsigned)__builtin_amdgcn_s_getreg((3 << 11) | 20) & 0xFu; }
#define XB_SPIN(cond, bar) do { unsigned _sp = 0; while (cond) { __builtin_amdgcn_s_sleep(1); \
    if ((++_sp & 255u) == 0u) { if (xb_ld(&(bar)[XB_TMO])) break; if (_sp > XB_SPIN_CAP) { atomicAdd(&(bar)[XB_TMO], 1u); break; } } } } while (0)

struct XcdBarrier {
    unsigned* bar; unsigned x;
    volatile LAS unsigned* st;
};

__device__ __forceinline__ XcdBarrier xcd_barrier_post(unsigned* bar, volatile LAS unsigned* st) {
    XcdBarrier b; b.bar = bar; b.x = xb_xcc_id(); b.st = st;
    if (threadIdx.x == 0) (void)xb_add(&bar[XB_XCNT(b.x)], 1u);
    return b;
}
__device__ __forceinline__ void xcd_barrier_complete(unsigned* bar, unsigned x, unsigned& nloc, unsigned& nx) {
    const unsigned G = gridDim.x * gridDim.y * gridDim.z;
    unsigned sum, cnt, mine, sp = 0u;
    for (;;) {
        sum = 0u; cnt = 0u; mine = 0u;
#pragma unroll
        for (unsigned j = 0; j < 16; ++j) { const unsigned c = xb_ld(&bar[XB_XCNT(j)]); sum += c; cnt += (c > 0u) ? 1u : 0u; mine = (j == x) ? c : mine; }
        if (sum == G) break;
        __builtin_amdgcn_s_sleep(1);
        if ((++sp & 255u) == 0u) { if (xb_ld(&bar[XB_TMO])) break; if (sp > XB_SPIN_CAP) { atomicAdd(&bar[XB_TMO], 1u); break; } }
    }
    nloc = mine > 0u ? mine : 1u; nx = cnt > 0u ? cnt : 1u;
}

__device__ __forceinline__ void xcd_barrier(const XcdBarrier& b) {
    asm volatile("s_waitcnt vmcnt(0)" ::: "memory");
    __syncthreads();
    if (threadIdx.x == 0) {
        unsigned* bar = b.bar;
        __builtin_amdgcn_s_waitcnt(0);
        unsigned nloc = b.st[0], nx = b.st[1];
        if (nloc == 0u) { xcd_barrier_complete(bar, b.x, nloc, nx); b.st[0] = nloc; b.st[1] = nx; }
        const unsigned old = xb_add(&bar[XB_XSUB(b.x)], 1u);
        const unsigned gen = old / nloc;
        if (old + 1u == (gen + 1u) * nloc) {
            __builtin_amdgcn_fence(__ATOMIC_RELEASE, "agent");
            asm volatile("s_waitcnt vmcnt(0)" ::: "memory");
            const unsigned og = xb_add(&bar[XB_TOP], 1u);
            const unsigned tg = og / nx;
            if (og + 1u == (tg + 1u) * nx) xb_add(&bar[XB_TOPGEN], 1u);
            else XB_SPIN(xb_ld(&bar[XB_TOPGEN]) == tg, bar);
            __builtin_amdgcn_fence(__ATOMIC_ACQUIRE, "agent");
            xb_add(&bar[XB_XGEN(b.x)], 1u);
            asm volatile("s_waitcnt vmcnt(0)" ::: "memory");
        } else {
            XB_SPIN(xb_ld(&bar[XB_XGEN(b.x)]) == gen, bar);
            __builtin_amdgcn_fence(__ATOMIC_ACQUIRE, "agent");
            asm volatile("s_waitcnt vmcnt(0)" ::: "memory");
        }
    }
    __syncthreads();
}
namespace att {
typedef short bf16x8 __attribute__((ext_vector_type(8)));
typedef short s16x4 __attribute__((ext_vector_type(4)));
typedef float f32x16 __attribute__((ext_vector_type(16)));
typedef float f32x4 __attribute__((ext_vector_type(4)));
typedef float f32x2 __attribute__((ext_vector_type(2)));
typedef unsigned u32x4 __attribute__((ext_vector_type(4)));
#define ATT_LAS __attribute__((address_space(3)))
#define ATT_SBAR() __builtin_amdgcn_sched_barrier(0)
__device__ __forceinline__ int crow(int r, int hi) { return (r & 3) + 8 * (r >> 2) + 4 * hi; }
__device__ __forceinline__ unsigned cvtpk(float lo, float hi) { unsigned r; asm volatile("v_cvt_pk_bf16_f32 %0, %1, %2" : "=v"(r) : "v"(lo), "v"(hi)); return r; }
__device__ __forceinline__ int v_st(int k, int c) { const int kk = (k & ~0xC) | ((k & 4) << 1) | ((k & 8) >> 1); return ((kk >> 3) * 4 + (c >> 5)) * 512 + ((kk & 7) * 32 + (c & 31)) * 2; }
__device__ __forceinline__ int v_rd_base(int lane) { return ((lane & 3) << 3) | (((lane >> 2) & 3) << 6) | (((lane >> 4) & 1) << 5) | (((lane >> 5) & 1) << 8); }
constexpr int v_rd_off(int d0, int ks, int half) { return d0 * 512 + ks * 4096 + half * 2048; }
template <int OFF> __device__ __forceinline__ s16x4 tr_read(int vb) { s16x4 r; asm volatile("ds_read_b64_tr_b16 %0, %1 offset:%2" : "=&v"(r) : "v"(vb), "i"(OFF) : "memory"); return r; }
#define ATT_PK(L, H) (att::bf16x8){L[0], L[1], L[2], L[3], H[0], H[1], H[2], H[3]}
#define ATT_PK4(P, BASE, OUT) do { unsigned a0_ = att::cvtpk(P[BASE + 0], P[BASE + 1]), a1_ = att::cvtpk(P[BASE + 2], P[BASE + 3]);   \
    unsigned b0_ = att::cvtpk(P[BASE + 4], P[BASE + 5]), b1_ = att::cvtpk(P[BASE + 6], P[BASE + 7]);                              \
    auto r0_ = __builtin_amdgcn_permlane32_swap(a0_, b0_, false, false); auto r1_ = __builtin_amdgcn_permlane32_swap(a1_, b1_, false, false); \
    att::u32x4 w_ = {r0_[0], r1_[0], r0_[1], r1_[1]}; OUT = __builtin_bit_cast(att::bf16x8, w_); } while (0)
template <int D0> __device__ __forceinline__ void pv32_one(f32x16& od, int vb, bf16x8 pa0, bf16x8 pa1) {
    const s16x4 l0 = tr_read<v_rd_off(D0, 0, 0)>(vb), h0 = tr_read<v_rd_off(D0, 0, 1)>(vb), l1 = tr_read<v_rd_off(D0, 1, 0)>(vb), h1 = tr_read<v_rd_off(D0, 1, 1)>(vb);
    asm volatile("s_waitcnt lgkmcnt(0)" ::: "memory"); ATT_SBAR();
    od = __builtin_amdgcn_mfma_f32_32x32x16_bf16(pa0, ATT_PK(l0, h0), od, 0, 0, 0);
    od = __builtin_amdgcn_mfma_f32_32x32x16_bf16(pa1, ATT_PK(l1, h1), od, 0, 0, 0);
}
constexpr float THR2 = 11.5f;

__device__ __forceinline__ void glds16(const void* gsrc, unsigned lds_dst) { unsigned keep;
    asm volatile("s_mov_b32 %0, m0\n\ts_mov_b32 m0, %2\n\ts_nop 0\n\tglobal_load_lds_dwordx4 %1, off\n\ts_mov_b32 m0, %0" : "=&s"(keep) : "v"(gsrc), "s"(lds_dst) : "memory"); }
template <int D0> __device__ __forceinline__ void pv32t_one(f32x16& od, int vb, bf16x8 pa0, bf16x8 pa1) {
    const s16x4 l0 = tr_read<v_rd_off(D0, 0, 0)>(vb), h0 = tr_read<v_rd_off(D0, 0, 1)>(vb), l1 = tr_read<v_rd_off(D0, 1, 0)>(vb), h1 = tr_read<v_rd_off(D0, 1, 1)>(vb);
    asm volatile("s_waitcnt lgkmcnt(0)" ::: "memory"); ATT_SBAR();
    od = __builtin_amdgcn_mfma_f32_32x32x16_bf16(ATT_PK(l0, h0), pa0, od, 0, 0, 0);
    od = __builtin_amdgcn_mfma_f32_32x32x16_bf16(ATT_PK(l1, h1), pa1, od, 0, 0, 0);
}
template <int D0> __device__ __forceinline__ void pv64t_one(f32x16& od, int vb, bf16x8 pa0, bf16x8 pa1, bf16x8 pa2, bf16x8 pa3) {
    const s16x4 l0 = tr_read<v_rd_off(D0, 0, 0)>(vb), h0 = tr_read<v_rd_off(D0, 0, 1)>(vb), l1 = tr_read<v_rd_off(D0, 1, 0)>(vb), h1 = tr_read<v_rd_off(D0, 1, 1)>(vb);
    const s16x4 l2 = tr_read<v_rd_off(D0, 2, 0)>(vb), h2 = tr_read<v_rd_off(D0, 2, 1)>(vb), l3 = tr_read<v_rd_off(D0, 3, 0)>(vb), h3 = tr_read<v_rd_off(D0, 3, 1)>(vb);
    asm volatile("s_waitcnt lgkmcnt(0)" ::: "memory"); ATT_SBAR();
    od = __builtin_amdgcn_mfma_f32_32x32x16_bf16(ATT_PK(l0, h0), pa0, od, 0, 0, 0);
    od = __builtin_amdgcn_mfma_f32_32x32x16_bf16(ATT_PK(l1, h1), pa1, od, 0, 0, 0);
    od = __builtin_amdgcn_mfma_f32_32x32x16_bf16(ATT_PK(l2, h2), pa2, od, 0, 0, 0);
    od = __builtin_amdgcn_mfma_f32_32x32x16_bf16(ATT_PK(l3, h3), pa3, od, 0, 0, 0);
}

template <int MODE> __device__ __forceinline__ void dilated_wave_item(const unsigned short* proj, unsigned short* part_o, float* part_ml, unsigned short* MIX, ATT_LAS unsigned char* vlds, const ATT_LAS float* tsub,
                                                  int b, int h, int dil, int res, int tq0, int branch, int lane) {
    const int r32 = lane & 31, hi = lane >> 5;
    const unsigned short* pb = proj + (size_t)b * 4096 * 12288 + h * 128;
    const size_t rstr = (size_t)dil * 12288;
    const unsigned short* qrow = pb + ((size_t)(tq0 + r32) * dil + res) * 12288 + hi * 8;
    bf16x8 qr[8];
#pragma unroll
    for (int d0 = 0; d0 < 8; ++d0) qr[d0] = *(const bf16x8*)(qrow + d0 * 16);
    float m_reg = -1e30f, l_reg = 0.f; f32x16 o[4];
#pragma unroll
    for (int d = 0; d < 4; ++d)
#pragma unroll
        for (int r = 0; r < 16; ++r) o[d][r] = 0.f;
    const int L = 4096 / dil;
    int kb_lo = 2 - (tq0 >> 5); if (kb_lo < 0) kb_lo = 0;
    int kb_hi = ((L - tq0) >> 5) + 1; if (kb_hi > 4) kb_hi = 4;
    const unsigned vl0 = (unsigned)(uintptr_t)vlds;
    const int kl = (lane & 31) >> 2, cl = (lane >> 5) * 32 + (lane & 3) * 8;
    const int krl = lane >> 4, kcl = lane & 15;
#define DL_ISSUE_K(kbx) do { const unsigned short* krow0_ = pb + ((size_t)(tq0 - 64 + 32 * (kbx)) * dil + res) * 12288 + 2048; \
        _Pragma("unroll") for (int p = 0; p < 8; ++p) { const int row = 4 * p + krl, c = kcl ^ (row & 7); \
            glds16(krow0_ + (size_t)row * rstr + c * 8, (unsigned)__builtin_amdgcn_readfirstlane(vl0 + (unsigned)p * 1024u)); } } while (0)
#define DL_ISSUE_V(kbx) do { const unsigned short* vrow0_ = pb + ((size_t)(tq0 - 64 + 32 * (kbx)) * dil + res) * 12288 + 4096; \
        _Pragma("unroll") for (int p = 0; p < 8; ++p) { const int kk = 8 * (p >> 1) + kl, k = (kk & ~0xC) | ((kk & 4) << 1) | ((kk & 8) >> 1), col = (p & 1) * 64 + cl; \
            glds16(vrow0_ + (size_t)k * rstr + col, (unsigned)__builtin_amdgcn_readfirstlane(vl0 + 8192u + (unsigned)p * 1024u)); } } while (0)
    DL_ISSUE_K(kb_lo); DL_ISSUE_V(kb_lo);
    const int vb = (int)(vl0 + 8192u) + v_rd_base(lane);
    const ATT_LAS unsigned char* krd = vlds + r32 * 256;
#pragma unroll 1
    for (int kb = kb_lo; kb <= kb_hi; ++kb) {
        asm volatile("s_waitcnt vmcnt(8)" ::: "memory");
        bf16x8 kc[8];
#pragma unroll
        for (int d0 = 0; d0 < 8; ++d0) kc[d0] = *(const ATT_LAS bf16x8*)(krd + (((2 * d0 + hi) ^ (r32 & 7)) << 4));
        asm volatile("s_waitcnt lgkmcnt(0)" ::: "memory");
        asm volatile("" : "+v"(kc[0]), "+v"(kc[1]), "+v"(kc[2]), "+v"(kc[3]), "+v"(kc[4]), "+v"(kc[5]), "+v"(kc[6]), "+v"(kc[7]));
        if (kb < kb_hi) DL_ISSUE_K(kb + 1);
        const ATT_LAS float* tb = tsub + (32 - r32 + 4 * hi + 32 * kb);
        f32x16 p;
#pragma unroll
        for (int r = 0; r < 16; ++r) p[r] = tb[(r & 3) + 8 * (r >> 2)];
#pragma unroll
        for (int d0 = 0; d0 < 8; ++d0) p = __builtin_amdgcn_mfma_f32_32x32x16_bf16(kc[d0], qr[d0], p, 0, 0, 0);
        float pmax = p[0];
#pragma unroll
        for (int r = 1; r < 16; ++r) pmax = fmaxf(pmax, p[r]);
        { auto rr = __builtin_amdgcn_permlane32_swap(__float_as_uint(pmax), __float_as_uint(pmax), false, false); pmax = fmaxf(__uint_as_float(rr[0]), __uint_as_float(rr[1])); }
        float alpha = 1.f;
        if (!__all(pmax - m_reg <= THR2)) { const float mn = fmaxf(m_reg, pmax); alpha = __builtin_amdgcn_exp2f(m_reg - mn); m_reg = mn; }
        float ps = 0.f;
#pragma unroll
        for (int r = 0; r < 16; ++r) { p[r] = __builtin_amdgcn_exp2f(p[r] - m_reg); ps += p[r]; }
        { auto rr = __builtin_amdgcn_permlane32_swap(__float_as_uint(ps), __float_as_uint(ps), false, false); ps = __uint_as_float(rr[0]) + __uint_as_float(rr[1]); }
        l_reg = l_reg * alpha + ps;
        bf16x8 pa0, pa1; ATT_PK4(p, 0, pa0); ATT_PK4(p, 8, pa1);
        if (__any(alpha < 1.f)) {
#pragma unroll
            for (int d = 0; d < 4; ++d)
#pragma unroll
                for (int r = 0; r < 16; ++r) o[d][r] *= alpha;
        }
        if (kb < kb_hi) asm volatile("s_waitcnt vmcnt(8)" ::: "memory"); else asm volatile("s_waitcnt vmcnt(0)" ::: "memory");
        ATT_SBAR();
        pv32t_one<0>(o[0], vb, pa0, pa1); pv32t_one<1>(o[1], vb, pa0, pa1); pv32t_one<2>(o[2], vb, pa0, pa1); pv32t_one<3>(o[3], vb, pa0, pa1);
        if (kb < kb_hi) DL_ISSUE_V(kb + 1);
    }
#undef DL_ISSUE_K
#undef DL_ISSUE_V
    const size_t rec = (((size_t)b * 4096 + (size_t)(tq0 + r32) * dil + res) * 16 + h) * 2;
    if (MODE == 0) {
        const float inv = 1.f / l_reg;
        if (hi == 0) *(f32x2*)(part_ml + (rec + branch) * 2) = (f32x2){m_reg, l_reg};
        unsigned short* op = part_o + (rec + branch) * 128 + 4 * hi;
#pragma unroll
        for (int d0 = 0; d0 < 4; ++d0)
#pragma unroll
            for (int g = 0; g < 4; ++g) { f32x2 w; w[0] = __uint_as_float(cvtpk(o[d0][4 * g] * inv, o[d0][4 * g + 1] * inv)); w[1] = __uint_as_float(cvtpk(o[d0][4 * g + 2] * inv, o[d0][4 * g + 3] * inv));
                *(f32x2*)(op + 32 * d0 + 8 * g) = w; }
    } else {
        const f32x4 ml = *(const f32x4*)(part_ml + rec * 2);
        const float mx = fmaxf(fmaxf(m_reg, ml[0]), ml[2]);
        const float w1 = __builtin_amdgcn_exp2f(m_reg - mx), wA = __builtin_amdgcn_exp2f(ml[0] - mx) * ml[1], wB = __builtin_amdgcn_exp2f(ml[2] - mx) * ml[3];
        const float inv = 1.f / (w1 * l_reg + wA + wB), s1 = w1 * inv, sA = wA * inv, sB = wB * inv;
        const unsigned short* pa_ = part_o + rec * 128 + 4 * hi; const unsigned short* pb_ = pa_ + 128;
        const int orow = b * 4096 + (tq0 + r32) * dil + res, ocol = h * 128 + 4 * hi;
#pragma unroll
        for (int d0 = 0; d0 < 4; ++d0)
#pragma unroll
            for (int g = 0; g < 4; ++g) { const f32x2 ua = *(const f32x2*)(pa_ + 32 * d0 + 8 * g), ub = *(const f32x2*)(pb_ + 32 * d0 + 8 * g);
                const unsigned a0 = __float_as_uint(ua[0]), a1 = __float_as_uint(ua[1]), b0 = __float_as_uint(ub[0]), b1 = __float_as_uint(ub[1]);
                const float y0 = o[d0][4 * g] * s1 + __uint_as_float(a0 << 16) * sA + __uint_as_float(b0 << 16) * sB, y1 = o[d0][4 * g + 1] * s1 + __uint_as_float(a0 & 0xffff0000u) * sA + __uint_as_float(b0 & 0xffff0000u) * sB;
                const float y2 = o[d0][4 * g + 2] * s1 + __uint_as_float(a1 << 16) * sA + __uint_as_float(b1 << 16) * sB, y3 = o[d0][4 * g + 3] * s1 + __uint_as_float(a1 & 0xffff0000u) * sA + __uint_as_float(b1 & 0xffff0000u) * sB;
                f32x2 w; w[0] = __uint_as_float(cvtpk(y0, y1)); w[1] = __uint_as_float(cvtpk(y2, y3)); *(f32x2*)(MIX + pg8::tiled_elem(orow, ocol + 32 * d0 + 8 * g, 64)) = w; }
    }
}

#define ATT_VRD8(D0, L, H) do { L[0] = tr_read<v_rd_off(D0, 0, 0)>(vb); H[0] = tr_read<v_rd_off(D0, 0, 1)>(vb); L[1] = tr_read<v_rd_off(D0, 1, 0)>(vb); H[1] = tr_read<v_rd_off(D0, 1, 1)>(vb); \
        L[2] = tr_read<v_rd_off(D0, 2, 0)>(vb); H[2] = tr_read<v_rd_off(D0, 2, 1)>(vb); L[3] = tr_read<v_rd_off(D0, 3, 0)>(vb); H[3] = tr_read<v_rd_off(D0, 3, 1)>(vb); } while (0)
#define ATT_PV4(OD, L, H) do { OD = __builtin_amdgcn_mfma_f32_32x32x16_bf16(ATT_PK(L[0], H[0]), pa0, OD, 0, 0, 0); OD = __builtin_amdgcn_mfma_f32_32x32x16_bf16(ATT_PK(L[1], H[1]), pa1, OD, 0, 0, 0); \
        OD = __builtin_amdgcn_mfma_f32_32x32x16_bf16(ATT_PK(L[2], H[2]), pa2, OD, 0, 0, 0); OD = __builtin_amdgcn_mfma_f32_32x32x16_bf16(ATT_PK(L[3], H[3]), pa3, OD, 0, 0, 0); } while (0)
template <int GV> __device__ __forceinline__ void pv64t_all(f32x16 (&o)[4], int vb, bf16x8 pa0, bf16x8 pa1, bf16x8 pa2, bf16x8 pa3) {
    s16x4 la[4], ha[4], lb[4], hb[4];
    if (GV == 7) {
#pragma unroll
        for (int i = 0; i < 4; ++i) { la[i] = (s16x4){1, 2, 3, 4}; ha[i] = (s16x4){5, 6, 7, 8}; lb[i] = la[i]; hb[i] = ha[i]; asm volatile("" : "+v"(la[i]), "+v"(ha[i]), "+v"(lb[i]), "+v"(hb[i])); }
        ATT_PV4(o[0], la, ha); ATT_PV4(o[1], lb, hb); ATT_PV4(o[2], la, ha); ATT_PV4(o[3], lb, hb); return; }
    if (GV == 8) {
        ATT_VRD8(0, la, ha); ATT_VRD8(1, lb, hb); asm volatile("s_waitcnt lgkmcnt(8)" ::: "memory");
#pragma unroll
        for (int i = 0; i < 4; ++i) asm volatile("" :: "v"(la[i]), "v"(ha[i]));
        ATT_VRD8(2, la, ha); asm volatile("s_waitcnt lgkmcnt(8)" ::: "memory");
#pragma unroll
        for (int i = 0; i < 4; ++i) asm volatile("" :: "v"(lb[i]), "v"(hb[i]));
        ATT_VRD8(3, lb, hb); asm volatile("s_waitcnt lgkmcnt(0)" ::: "memory");
#pragma unroll
        for (int i = 0; i < 4; ++i) asm volatile("" :: "v"(la[i]), "v"(ha[i]), "v"(lb[i]), "v"(hb[i]));
        o[0][0] += __builtin_bit_cast(f32x4, pa0)[0] + __builtin_bit_cast(f32x4, pa1)[1] + __builtin_bit_cast(f32x4, pa2)[2] + __builtin_bit_cast(f32x4, pa3)[3]; return; }
    ATT_VRD8(0, la, ha); ATT_VRD8(1, lb, hb);
    asm volatile("s_waitcnt lgkmcnt(8)" ::: "memory"); ATT_SBAR(); ATT_PV4(o[0], la, ha); ATT_SBAR();
    ATT_VRD8(2, la, ha);
    asm volatile("s_waitcnt lgkmcnt(8)" ::: "memory"); ATT_SBAR(); ATT_PV4(o[1], lb, hb); ATT_SBAR();
    ATT_VRD8(3, lb, hb);
    asm volatile("s_waitcnt lgkmcnt(8)" ::: "memory"); ATT_SBAR(); ATT_PV4(o[2], la, ha); ATT_SBAR();
    asm volatile("s_waitcnt lgkmcnt(0)" ::: "memory"); ATT_SBAR(); ATT_PV4(o[3], lb, hb);
}

constexpr int DF_TB = 131072, DF_TBN = 1312, DF_TB0 = 656, DF_XROW = 528;
#define ATT_WAIT_BAR() asm volatile("s_waitcnt vmcnt(0) lgkmcnt(0)\n\ts_barrier" ::: "memory")
#define ATT_WAIT4_BAR() asm volatile("s_waitcnt vmcnt(4) lgkmcnt(0)\n\ts_barrier" ::: "memory")
template <int GV> __device__ __forceinline__ void df_qkt(f32x16& p0, f32x16& p1, const ATT_LAS unsigned char* ks, const bf16x8 (&qr)[4], const ATT_LAS float* tb, bool lookup, const f32x16& cinit, float m_reg, int map, int r32, int hi) {
    const int sw = r32 & 7; const ATT_LAS unsigned char* kr = ks + r32 * 256 + map * 128;
    bf16x8 kf0[4], kf1[4];
#pragma unroll
    for (int d0 = 0; d0 < 4; ++d0) { const int off = ((2 * d0 + hi) ^ sw) << 4;
        if (GV == 7) { kf0[d0] = qr[d0]; kf1[d0] = qr[3 - d0]; asm volatile("" : "+v"(kf0[d0]), "+v"(kf1[d0])); } else { kf0[d0] = *(const ATT_LAS bf16x8*)(kr + off); kf1[d0] = *(const ATT_LAS bf16x8*)(kr + 8192 + off); } }
    if (GV == 8) {
#pragma unroll
        for (int d0 = 0; d0 < 4; ++d0) asm volatile("" :: "v"(kf0[d0]), "v"(kf1[d0]));
        p0 = cinit; p1 = cinit; return; }
    if (lookup) {
#pragma unroll
        for (int r = 0; r < 16; ++r) { p0[r] = tb[(r & 3) + 8 * (r >> 2)] - m_reg; p1[r] = tb[32 + (r & 3) + 8 * (r >> 2)] - m_reg; }
        p0 = __builtin_amdgcn_mfma_f32_32x32x16_bf16(kf0[0], qr[0], p0, 0, 0, 0); p1 = __builtin_amdgcn_mfma_f32_32x32x16_bf16(kf1[0], qr[0], p1, 0, 0, 0);
    } else {
        p0 = __builtin_amdgcn_mfma_f32_32x32x16_bf16(kf0[0], qr[0], cinit, 0, 0, 0); p1 = __builtin_amdgcn_mfma_f32_32x32x16_bf16(kf1[0], qr[0], cinit, 0, 0, 0);
    }
#pragma unroll
    for (int d0 = 1; d0 < 4; ++d0) { p0 = __builtin_amdgcn_mfma_f32_32x32x16_bf16(kf0[d0], qr[d0], p0, 0, 0, 0); p1 = __builtin_amdgcn_mfma_f32_32x32x16_bf16(kf1[d0], qr[d0], p1, 0, 0, 0); }
}
template <bool FIRST> __device__ __forceinline__ void df_partial(f32x16& p0, f32x16& p1, float& m_reg, float& alpha, f32x16& cinit) {
    float pmax = p0[0];
#pragma unroll
    for (int r = 1; r < 16; ++r) pmax = fmaxf(pmax, p0[r]);
#pragma unroll
    for (int r = 0; r < 16; ++r) pmax = fmaxf(pmax, p1[r]);
    { auto rr = __builtin_amdgcn_permlane32_swap(__float_as_uint(pmax), __float_as_uint(pmax), false, false); pmax = fmaxf(__uint_as_float(rr[0]), __uint_as_float(rr[1])); }
    alpha = 1.f;
    if (FIRST || !__builtin_expect(__all(pmax <= THR2), 1)) { const float dl = FIRST ? pmax : fmaxf(pmax, 0.f); m_reg += dl; alpha = FIRST ? 1.f : __builtin_amdgcn_exp2f(-dl);
#pragma unroll
        for (int r = 0; r < 16; ++r) { p0[r] -= dl; p1[r] -= dl; cinit[r] -= dl; } }
#pragma unroll
    for (int r = 0; r < 16; ++r) p0[r] = __builtin_amdgcn_exp2f(p0[r]);
}
__device__ __forceinline__ void df_finish(f32x16& p0, f32x16& p1, float alpha, float& l_reg, bf16x8& pa0, bf16x8& pa1, bf16x8& pa2, bf16x8& pa3) {
#pragma unroll
    for (int r = 0; r < 16; ++r) p1[r] = __builtin_amdgcn_exp2f(p1[r]);
    float ps = 0.f;
#pragma unroll
    for (int r = 0; r < 16; ++r) ps += p0[r];
#pragma unroll
    for (int r = 0; r < 16; ++r) ps += p1[r];
    { auto rr = __builtin_amdgcn_permlane32_swap(__float_as_uint(ps), __float_as_uint(ps), false, false); ps = __uint_as_float(rr[0]) + __uint_as_float(rr[1]); }
    l_reg = l_reg * alpha + ps;
    ATT_PK4(p0, 0, pa0); ATT_PK4(p0, 8, pa1); ATT_PK4(p1, 0, pa2); ATT_PK4(p1, 8, pa3);
}
struct NoHook { __device__ __forceinline__ void step(int) {} };
template <int GV, class HK> __device__ __forceinline__ void diff_unit(const unsigned short* proj, unsigned short* MIX, const float* BIAS, const float* gsub, float lam, float post, ATT_LAS unsigned char* lds, int b, int h, int qb, int tid, HK& hk) {
    const int lane = tid & 63, wid = __builtin_amdgcn_readfirstlane(tid >> 6), r32 = lane & 31, hi = lane >> 5, rg = wid & 3, map = wid >> 2;
    const unsigned lds0 = (unsigned)(uintptr_t)lds;
    ATT_LAS float* tbl = (ATT_LAS float*)(lds + DF_TB);
    const int qw = qb * 128 + rg * 32;
    const unsigned short* pb = proj + (size_t)b * 4096 * 12288 + h * 128;
    const float* bh = BIAS + (16 + h) * 8192 + 4095;
    ATT_WAIT_BAR();
    for (int i = tid; i < DF_TBN; i += 512) tbl[i] = bh[i - DF_TB0];
    const float cpos = bh[600], cneg = bh[-600];
    bf16x8 qr[4];
    { const unsigned short* qrow = pb + (size_t)(qw + r32) * 12288 + 6144 + map * 64 + hi * 8;
#pragma unroll
      for (int d0 = 0; d0 < 4; ++d0) qr[d0] = *(const bf16x8*)(qrow + d0 * 16); }
    unsigned koff[2], voff[2];
#pragma unroll
    for (int e = 0; e < 2; ++e) { const int p = 2 * wid + e; { const int row = 4 * p + (lane >> 4), c = (lane & 15) ^ (row & 7); koff[e] = (unsigned)(row * 24576 + c * 16); }
        { const int j = 64 * p + lane, st = j >> 5, kk = (st >> 2) * 8 + ((j & 31) >> 2), col = (st & 3) * 32 + (j & 3) * 8, k = (kk & ~0xC) | ((kk & 4) << 1) | ((kk & 8) >> 1); voff[e] = (unsigned)(k * 24576 + col * 2); } }
    const char* kbase = (const char*)(pb + 8192); const char* vbase = (const char*)(pb + 10240);
#define DF_DMA(t, slot) do { const size_t tb_ = (size_t)(t) * (64 * 24576); const unsigned sl_ = lds0 + (unsigned)(slot) * 32768u + (unsigned)(2 * wid) * 1024u; \
        glds16(kbase + tb_ + koff[0], (unsigned)__builtin_amdgcn_readfirstlane(sl_)); glds16(kbase + tb_ + koff[1], (unsigned)__builtin_amdgcn_readfirstlane(sl_ + 1024u)); \
        glds16(vbase + tb_ + voff[0], (unsigned)__builtin_amdgcn_readfirstlane(sl_ + 16384u)); glds16(vbase + tb_ + voff[1], (unsigned)__builtin_amdgcn_readfirstlane(sl_ + 16384u + 1024u)); } while (0)
    if (GV < 5) { DF_DMA(0, 0); DF_DMA(1, 1); }
    float m_reg = 0.f, l_reg = 0.f, cbk = 0.f; f32x16 o[4], cinit;
#pragma unroll
    for (int d = 0; d < 4; ++d)
#pragma unroll
        for (int r = 0; r < 16; ++r) o[d][r] = 0.f;
#pragma unroll
    for (int r = 0; r < 16; ++r) cinit[r] = 0.f;
    f32x16 pA0, pA1, pB0, pB1; float alA = 1.f, alB = 1.f; bf16x8 pa0, pa1, pa2, pa3;
    const int vrb = (int)(lds0 + 16384u) + v_rd_base(lane);
#define DF_MODE(j, LK, CB, TB) const int k0_ = (j) * 64, rmin_ = k0_ - (qw + 31), rmax_ = k0_ + 63 - qw; const bool LK = !(rmin_ >= 559 || rmax_ <= -559); \
        const float CB = LK ? 0.f : (rmin_ >= 559 ? cpos : cneg); const ATT_LAS float* TB = tbl + (LK ? (k0_ - qw - r32 + 4 * hi + DF_TB0) : 0); \
        if (!LK && CB != cbk) { cbk = CB; _Pragma("unroll") for (int r_ = 0; r_ < 16; ++r_) cinit[r_] = CB - m_reg; }
#define DF_RESC(al) do { if (__any((al) < 1.f)) { _Pragma("unroll") for (int d_ = 0; d_ < 4; ++d_) _Pragma("unroll") for (int r_ = 0; r_ < 16; ++r_) o[d_][r_] *= (al); } } while (0)
#define DF_STEP(PC0, PC1, ALC, PP0, PP1, ALP, j) do { \
        if (GV < 5 && (j) + 2 < 64) DF_DMA((j) + 2, ((j) + 2) & 3); \
        { DF_MODE(j, lk_, cb_, tb_); ATT_SBAR(); \
          if (GV != 4) df_qkt<GV>(PC0, PC1, lds + ((j) & 3) * 32768, qr, tb_, lk_, cinit, m_reg, map, r32, hi); else { PC0 = cinit; PC1 = cinit; } \
          if (GV != 2) df_finish(PP0, PP1, ALP, l_reg, pa0, pa1, pa2, pa3); else { pa0 = __builtin_bit_cast(bf16x8, (f32x4){PP0[0], PP0[1], PP0[2], PP0[3]}); pa1 = __builtin_bit_cast(bf16x8, (f32x4){PP0[4], PP0[5], PP0[6], PP0[7]}); pa2 = __builtin_bit_cast(bf16x8, (f32x4){PP1[0], PP1[1], PP1[2], PP1[3]}); pa3 = __builtin_bit_cast(bf16x8, (f32x4){PP1[4], PP1[5], PP1[6], PP1[7]}); l_reg += PP0[8] + PP1[8]; } ATT_SBAR(); \
          if (GV != 3) { const int vb_ = vrb + (((j) - 1) & 3) * 32768; \
            pv64t_all<GV>(o, vb_, pa0, pa1, pa2, pa3); } \
          else { o[0][0] += __builtin_bit_cast(f32x4, pa0)[0] + __builtin_bit_cast(f32x4, pa1)[1] + __builtin_bit_cast(f32x4, pa2)[2] + __builtin_bit_cast(f32x4, pa3)[3]; } \
          if (GV != 2) df_partial<false>(PC0, PC1, m_reg, ALC, cinit); else ALC = 1.f; } \
        DF_RESC(ALC); \
        if (GV >= 6) { asm volatile("s_waitcnt lgkmcnt(0)" ::: "memory"); } else if (GV == 5) { asm volatile("s_waitcnt lgkmcnt(0)\n\ts_barrier" ::: "memory"); } else if ((j) + 2 < 64) ATT_WAIT4_BAR(); else ATT_WAIT_BAR(); \
        if (GV == 0) hk.step(lane); } while (0)
    ATT_WAIT4_BAR();
    { if (GV < 5) DF_DMA(2, 2); DF_MODE(0, lk_, cb_, tb_); df_qkt<GV>(pA0, pA1, lds, qr, tb_, lk_, cinit, m_reg, map, r32, hi); df_partial<true>(pA0, pA1, m_reg, alA, cinit); ATT_WAIT4_BAR(); }
#pragma unroll 1
    for (int j = 1; j < 63; j += 2) { DF_STEP(pB0, pB1, alB, pA0, pA1, alA, j); DF_STEP(pA0, pA1, alA, pB0, pB1, alB, j + 1); }
    DF_STEP(pB0, pB1, alB, pA0, pA1, alA, 63);
    df_finish(pB0, pB1, alB, l_reg, pa0, pa1, pa2, pa3); ATT_SBAR();
    { const int vb_ = vrb + (63 & 3) * 32768;
      pv64t_all<GV>(o, vb_, pa0, pa1, pa2, pa3); }
#undef DF_STEP
#undef DF_RESC
#undef DF_MODE
#undef DF_DMA
    ATT_WAIT_BAR();
    ATT_LAS unsigned char* xr = lds + rg * (32 * DF_XROW) + r32 * DF_XROW + hi * 16;
    if (map == 1) { const float s1 = lam / l_reg;
#pragma unroll
        for (int d0 = 0; d0 < 4; ++d0)
#pragma unroll
            for (int g = 0; g < 4; ++g) *(ATT_LAS f32x4*)(xr + (32 * d0 + 8 * g) * 4) = (f32x4){o[d0][4 * g] * s1, o[d0][4 * g + 1] * s1, o[d0][4 * g + 2] * s1, o[d0][4 * g + 3] * s1}; }
    ATT_WAIT_BAR();
    if (map == 0 && (GV == 0 || l_reg == -123.456f)) { const float s0 = 1.f / l_reg; float ss = 0.f;
#pragma unroll
        for (int d0 = 0; d0 < 4; ++d0)
#pragma unroll
            for (int g = 0; g < 4; ++g) { const f32x4 y = *(const ATT_LAS f32x4*)(xr + (32 * d0 + 8 * g) * 4);
#pragma unroll
                for (int i = 0; i < 4; ++i) { const float x = o[d0][4 * g + i] * s0 - y[i]; o[d0][4 * g + i] = x; ss += x * x; } }
        { auto rr = __builtin_amdgcn_permlane32_swap(__float_as_uint(ss), __float_as_uint(ss), false, false); ss = __uint_as_float(rr[0]) + __uint_as_float(rr[1]); }
        const float rs = post / sqrtf(ss * (1.f / 128.f) + 1e-5f);
        const int orow = b * 4096 + qw + r32, ocol = 2048 + h * 128 + 4 * hi; const float* gp = gsub + 4 * hi;
#pragma unroll
        for (int d0 = 0; d0 < 4; ++d0)
#pragma unroll
            for (int g = 0; g < 4; ++g) { const f32x4 gg = *(const f32x4*)(gp + 32 * d0 + 8 * g);
                f32x2 w; { const unsigned lo = cvtpk(o[d0][4 * g] * rs * gg[0], o[d0][4 * g + 1] * rs * gg[1]), hi2 = cvtpk(o[d0][4 * g + 2] * rs * gg[2], o[d0][4 * g + 3] * rs * gg[3]); w[0] = __uint_as_float(lo); w[1] = __uint_as_float(hi2); }
                *(f32x2*)(MIX + pg8::tiled_elem(orow, ocol + 32 * d0 + 8 * g, 64)) = w; } }
}
}

constexpr int NWAVES = 8;
#ifndef MK_ONE_LAUNCH
#define MK_ONE_LAUNCH 1
#endif

#ifndef PROBE_DUP
#define PROBE_DUP 0
#endif
#define DUPN(k) ((PROBE_DUP == (k)) ? 2 : 1)
#ifndef PROBE_CLK
#define PROBE_CLK 0
#endif
#ifndef PROBE_GG
#define PROBE_GG 0
#endif
#ifndef PROBE_BAR
#define PROBE_BAR 0
#endif
#ifndef PROBE_THIN
#define PROBE_THIN 0
#endif
#ifndef PROBE_GV
#define PROBE_GV 0
#endif

constexpr int BATCH = 2, SEQ = 4096, DM = 4096, DEPTH = 2, NHA = 16, NHD = 16, HD = 128, DQ = 64;
constexpr int M = BATCH * SEQ;
constexpr int NPROJ = 12288, DFF = 16384, DILW = 2048;
constexpr int COL_QA = 0, COL_KA = 2048, COL_VA = 4096, COL_QD = 6144, COL_KD = 8192, COL_VD = 10240;
constexpr float RMS_EPS = 1e-6f, SUBLN_EPS = 1e-5f, LOG2E = 1.4426950408889634f;
constexpr float SC_A = 0.08838834764831845f * LOG2E;
constexpr float SC_D = 0.125f * LOG2E;
constexpr int NPART = 64;
constexpr int N_PHASES = 1 + 7 * DEPTH;

constexpr size_t MiB = 1u << 20;
constexpr size_t WS_CTL = 0, CTL_ZERO_BYTES = 1 * MiB;
constexpr size_t WS_BIAS = 1 * MiB;
constexpr size_t WS_PART = 2 * MiB;
constexpr size_t WS_WIN = 4 * MiB;
constexpr size_t WS_WOUT = WS_WIN + 192 * MiB;
constexpr size_t WS_WUP = WS_WOUT + 64 * MiB;
constexpr size_t WS_WDN = WS_WUP + 256 * MiB;
constexpr size_t WS_H = WS_WDN + 256 * MiB;
constexpr size_t WS_PROJ = WS_H + 64 * MiB;
constexpr size_t WS_MIX = WS_PROJ + 192 * MiB;
constexpr size_t WS_U = WS_MIX + 64 * MiB;
constexpr size_t WS_Y = WS_U + 256 * MiB;
constexpr size_t WS_END = WS_Y + 128 * MiB;
constexpr int CW_TMO = 0, CW_CODE = 1;
constexpr int CW_LAM = 16;
constexpr int CW_BAR = 4096;

constexpr int RING_OFF = 0, RING_BYTES = 131072;
constexpr int LDSCTL_OFF = 143360, MISC_OFF = LDSCTL_OFF + 320;
constexpr int CONV_OFF = 147456;
constexpr int LDS_BYTES = 163840;
static_assert(MISC_OFF + 128 <= LDS_BYTES, "LDS map");

struct Frame {
    LAS unsigned char* lds;
    volatile LAS unsigned* MISC;
    gu32* ctl;
    int tid, lane, wave;
    int vcu, G;
    const float* x; float* out;
    const float *rel_bias, *g_pre_mix, *w_in, *lq1, *lk1, *lq2, *lk2, *g_subln, *w_out, *g_post_mix, *g_pre_mlp, *w_up, *w_down, *g_post_mlp;
    bf16 *Win_t, *Wout_t, *Wup_t, *Wdn_t;
    bf16 *H, *PROJ, *MIX, *U;
    bf16* Y; float *PART, *BIAS;
};

__device__ __forceinline__ float wave_sum(float v) {
#pragma unroll
    for (int o = 1; o < 64; o <<= 1) v += __shfl_xor(v, o);
    return v;
}
__device__ __forceinline__ int opaque_tid() { int t = threadIdx.x; asm volatile("" : "+v"(t)); return t; }
__device__ __forceinline__ float bflo(unsigned u) { return __uint_as_float(u << 16); }
__device__ __forceinline__ float bfhi(unsigned u) { return __uint_as_float(u & 0xffff0000u); }

__device__ __forceinline__ void p0_transpose_item(const float* W, int K, int N, bf16* WT, LAS float* scr, int item, int lane) {
    const int nblk = N / 32, kb = item / nblk, nb = item % nblk, k0 = 64 * kb, n0 = 32 * nb;
    const GAS float* src = (const GAS float*)W + (size_t)(k0 + (lane >> 5)) * N + n0 + (lane & 31);
    float v[32];
#pragma unroll
    for (int i = 0; i < 32; ++i) v[i] = src[(size_t)(2 * i) * N];
#pragma unroll
    for (int i = 0; i < 32; ++i) scr[(2 * i + (lane >> 5)) * 33 + (lane & 31)] = v[i];
    LDS_WAIT(); asm volatile("" ::: "memory");
    const int c = lane & 7;
#pragma unroll
    for (int j = 0; j < 4; ++j) { const int n = (lane >> 3) + 8 * j; const LAS float* s = scr + (8 * c) * 33 + n;
        v4u o; o.x = pk2(s[0 * 33], s[1 * 33]); o.y = pk2(s[2 * 33], s[3 * 33]); o.z = pk2(s[4 * 33], s[5 * 33]); o.w = pk2(s[6 * 33], s[7 * 33]);
        *(GAS v4u*)(WT + pg8::tiled_w_elem(n0 + n, k0 + 8 * c, K / 64)) = o; }
    LDS_WAIT(); asm volatile("" ::: "memory");
}
__device__ __forceinline__ int t5_bucket(int rel) {
    const int n = rel < 0 ? -rel : rel; int bk;
    if (n < 8) bk = n; else if (n < 15) bk = 8; else if (n < 27) bk = 9; else if (n < 50) bk = 10; else if (n < 91) bk = 11; else if (n < 166) bk = 12; else if (n < 305) bk = 13; else if (n < 559) bk = 14; else bk = 15;
    return bk + (rel > 0 ? 16 : 0);
}
__device__ __forceinline__ void rms_row_to_bf16(const float* xrow, const float* g, bf16* H, int row, int lane) {
    const GAS f32x4* xr = (const GAS f32x4*)xrow + lane; const GAS f32x4* gr = (const GAS f32x4*)g + lane;
    f32x4 v[16]; float s = 0.f;
#pragma unroll
    for (int j = 0; j < 16; ++j) { v[j] = xr[64 * j]; s += (v[j].x * v[j].x + v[j].y * v[j].y) + (v[j].z * v[j].z + v[j].w * v[j].w); }
    const float rstd = 1.f / sqrtf(wave_sum(s) * (1.f / DM) + RMS_EPS);
#pragma unroll
    for (int j = 0; j < 16; ++j) { const f32x4 gg = gr[64 * j];
        *(GAS unsigned long long*)(H + pg8::tiled_elem(row, 4 * (64 * j + lane), DM / 64)) = (unsigned long long)pk2(v[j].x * rstd * gg.x, v[j].y * rstd * gg.y) | ((unsigned long long)pk2(v[j].z * rstd * gg.z, v[j].w * rstd * gg.w) << 32); }
}
__device__ __forceinline__ void p0_prologue(Frame& F) {
    const int tid_ = opaque_tid(), lane_ = tid_ & 63;
    LAS float* scr = (LAS float*)(F.lds + RING_OFF + F.wave * 16384);
    const int gw = F.vcu * NWAVES + F.wave, NGW = F.G * NWAVES;
    constexpr int I_IN = (DM / 64) * (NPROJ / 32);
    for (int it = gw; it < I_IN; it += NGW) p0_transpose_item(F.w_in, DM, NPROJ, F.Win_t, scr, it, lane_);
    for (int m = gw; m < M; m += NGW) rms_row_to_bf16(F.x + (size_t)m * DM, F.g_pre_mix, F.H, m, lane_);
    for (int i = blockIdx.x * (NWAVES * 64) + tid_; i < 32 * 8192; i += F.G * NWAVES * 64) { const int h = i >> 13, rel = (i & 8191) - 4095;
        F.BIAS[i] = (rel <= 4095) ? F.rel_bias[t5_bucket(rel) * 32 + h] * LOG2E : 0.f; }
    if (blockIdx.x == 0 && tid_ < DEPTH) { const int l = tid_; float a = 0.f, b = 0.f;
        for (int i = 0; i < DQ; ++i) { a += F.lq1[l * DQ + i] * F.lk1[l * DQ + i]; b += F.lq2[l * DQ + i] * F.lk2[l * DQ + i]; }
        const float li = 0.8f - 0.6f * expf(-0.3f * (float)l);
        F.ctl[CW_LAM + l] = __float_as_uint(expf(a) - expf(b) + li); }
}
template <bool XIN_BF, bool XOUT_BF> __device__ __forceinline__ void thin_phase(Frame& F, const void* xin, void* xout, const float* g_post, const float* g_next, bool want_h) {
    const int lane_ = opaque_tid() & 63;
    const int gw = F.vcu * NWAVES + F.wave, NGW = F.G * NWAVES;
    for (int row = gw; row < M; row += NGW) {
        const float ssq = wave_sum(F.PART[(size_t)row * NPART + lane_]);
        const float rstd = 1.f / sqrtf(ssq * (1.f / DM) + RMS_EPS);
        const GAS unsigned long long* yr = (const GAS unsigned long long*)(F.Y + (size_t)row * DM) + lane_;
        const GAS f32x4* xr = (const GAS f32x4*)((const float*)xin + (size_t)row * DM) + lane_; const GAS unsigned long long* xrb = (const GAS unsigned long long*)((const bf16*)xin + (size_t)row * DM) + lane_;
        const GAS f32x4* gp = (const GAS f32x4*)g_post + lane_;
        GAS f32x4* xo = (GAS f32x4*)((float*)xout + (size_t)row * DM) + lane_; GAS unsigned long long* xob = (GAS unsigned long long*)((bf16*)xout + (size_t)row * DM) + lane_;
        f32x4 v[16]; float s = 0.f;
#pragma unroll
        for (int j = 0; j < 16; ++j) { const unsigned long long yb = yr[64 * j]; const f32x4 y = {bflo((unsigned)yb), bfhi((unsigned)yb), bflo((unsigned)(yb >> 32)), bfhi((unsigned)(yb >> 32))}; const f32x4 g = gp[64 * j];
            f32x4 xx; if (XIN_BF) { const unsigned long long xb = xrb[64 * j]; xx = (f32x4){bflo((unsigned)xb), bfhi((unsigned)xb), bflo((unsigned)(xb >> 32)), bfhi((unsigned)(xb >> 32))}; } else xx = xr[64 * j];
            v[j] = xx + y * rstd * g;
            if (XOUT_BF) xob[64 * j] = (unsigned long long)pk2(v[j].x, v[j].y) | ((unsigned long long)pk2(v[j].z, v[j].w) << 32); else xo[64 * j] = v[j];
            s += (v[j].x * v[j].x + v[j].y * v[j].y) + (v[j].z * v[j].z + v[j].w * v[j].w); }
        if (want_h) {
            const float r2 = 1.f / sqrtf(wave_sum(s) * (1.f / DM) + RMS_EPS);
            const GAS f32x4* gn = (const GAS f32x4*)g_next + lane_;
#pragma unroll
            for (int j = 0; j < 16; ++j) { const f32x4 gg = gn[64 * j];
                *(GAS unsigned long long*)(F.H + pg8::tiled_elem(row, 4 * (64 * j + lane_), DM / 64)) = (unsigned long long)pk2(v[j].x * r2 * gg.x, v[j].y * r2 * gg.y) | ((unsigned long long)pk2(v[j].z * r2 * gg.z, v[j].w * r2 * gg.w) << 32); }
        }
    }
}
__device__ __forceinline__ void naive_dilated_item(const bf16* proj, bf16* MIX, const float* BIAS, int item, int tid) {
    const int b = item >> 9, h = (item >> 5) & 15, qc = item & 31;
    const int s = qc * 128 + (tid >> 2), quarter = tid & 3;
    const GAS v4u* qp = (const GAS v4u*)(proj + (size_t)(b * SEQ + s) * NPROJ + COL_QA + h * HD);
    unsigned q[64];
#pragma unroll
    for (int i = 0; i < 16; ++i) { const v4u t = qp[i]; q[4 * i] = t.x; q[4 * i + 1] = t.y; q[4 * i + 2] = t.z; q[4 * i + 3] = t.w; }
    float m = -1e30f, l = 0.f; float o[32];
#pragma unroll
    for (int i = 0; i < 32; ++i) o[i] = 0.f;
    const float* bt = BIAS + h * 8192 + 4095;
#pragma unroll 1
    for (int br = 0; br < 3; ++br) { const int dil = br == 0 ? 1 : (br == 1 ? 4 : 16);
#pragma unroll 1
        for (int j = -64; j <= 64; ++j) { const int p = s + j * dil; if (p < 0 || p >= SEQ) continue;
            const GAS v4u* kp = (const GAS v4u*)(proj + (size_t)(b * SEQ + p) * NPROJ + COL_KA + h * HD);
            float dot = 0.f;
#pragma unroll
            for (int i = 0; i < 16; ++i) { const v4u kv = kp[i];
                dot += bflo(q[4 * i]) * bflo(kv.x) + bfhi(q[4 * i]) * bfhi(kv.x); dot += bflo(q[4 * i + 1]) * bflo(kv.y) + bfhi(q[4 * i + 1]) * bfhi(kv.y);
                dot += bflo(q[4 * i + 2]) * bflo(kv.z) + bfhi(q[4 * i + 2]) * bfhi(kv.z); dot += bflo(q[4 * i + 3]) * bflo(kv.w) + bfhi(q[4 * i + 3]) * bfhi(kv.w); }
            const float sc = dot + bt[j * dil];
            if (sc > m) { const float a = exp2f(m - sc); l *= a;
#pragma unroll
                for (int i = 0; i < 32; ++i) o[i] *= a;
                m = sc; }
            const float pe = exp2f(sc - m); l += pe;
            const GAS v4u* vp = (const GAS v4u*)(proj + (size_t)(b * SEQ + p) * NPROJ + COL_VA + h * HD + quarter * 32);
#pragma unroll
            for (int i = 0; i < 4; ++i) { const v4u vv = vp[i];
                o[8 * i + 0] += pe * bflo(vv.x); o[8 * i + 1] += pe * bfhi(vv.x); o[8 * i + 2] += pe * bflo(vv.y); o[8 * i + 3] += pe * bfhi(vv.y);
                o[8 * i + 4] += pe * bflo(vv.z); o[8 * i + 5] += pe * bfhi(vv.z); o[8 * i + 6] += pe * bflo(vv.w); o[8 * i + 7] += pe * bfhi(vv.w); }
        } }
    const float inv = 1.f / l;
    GAS v4u* op = (GAS v4u*)(MIX + (size_t)(b * SEQ + s) * DM + h * HD + quarter * 32);
#pragma unroll
    for (int i = 0; i < 4; ++i) { v4u w; w.x = pk2(o[8 * i] * inv, o[8 * i + 1] * inv); w.y = pk2(o[8 * i + 2] * inv, o[8 * i + 3] * inv); w.z = pk2(o[8 * i + 4] * inv, o[8 * i + 5] * inv); w.w = pk2(o[8 * i + 6] * inv, o[8 * i + 7] * inv); op[i] = w; }
}
__device__ __forceinline__ void naive_diff_item(const bf16* proj, bf16* MIX, const float* BIAS, const float* g_subln, float lam, int item, int layer, int tid) {
    const int b = item >> 10, h = (item >> 6) & 15, qc = item & 63;
    const int s = qc * 64 + (tid >> 3), oct = tid & 7;
    const GAS v4u* qp = (const GAS v4u*)(proj + (size_t)(b * SEQ + s) * NPROJ + COL_QD + h * HD);
    unsigned q[64];
#pragma unroll
    for (int i = 0; i < 16; ++i) { const v4u t = qp[i]; q[4 * i] = t.x; q[4 * i + 1] = t.y; q[4 * i + 2] = t.z; q[4 * i + 3] = t.w; }
    float m0 = -1e30f, l0 = 0.f, m1 = -1e30f, l1 = 0.f; float o0[16], o1[16];
#pragma unroll
    for (int i = 0; i < 16; ++i) { o0[i] = 0.f; o1[i] = 0.f; }
    const float* bt = BIAS + (NHA + h) * 8192 + 4095 - s;
    const bf16* kbase = proj + (size_t)(b * SEQ) * NPROJ + COL_KD + h * HD; const bf16* vbase = proj + (size_t)(b * SEQ) * NPROJ + COL_VD + h * HD + oct * 16;
#pragma unroll 1
    for (int p = 0; p < SEQ; ++p) {
        const GAS v4u* kp = (const GAS v4u*)(kbase + (size_t)p * NPROJ);
        float d0 = 0.f, d1 = 0.f;
#pragma unroll
        for (int i = 0; i < 8; ++i) { const v4u kv = kp[i];
            d0 += bflo(q[4 * i]) * bflo(kv.x) + bfhi(q[4 * i]) * bfhi(kv.x); d0 += bflo(q[4 * i + 1]) * bflo(kv.y) + bfhi(q[4 * i + 1]) * bfhi(kv.y);
            d0 += bflo(q[4 * i + 2]) * bflo(kv.z) + bfhi(q[4 * i + 2]) * bfhi(kv.z); d0 += bflo(q[4 * i + 3]) * bflo(kv.w) + bfhi(q[4 * i + 3]) * bfhi(kv.w); }
#pragma unroll
        for (int i = 8; i < 16; ++i) { const v4u kv = kp[i];
            d1 += bflo(q[4 * i]) * bflo(kv.x) + bfhi(q[4 * i]) * bfhi(kv.x); d1 += bflo(q[4 * i + 1]) * bflo(kv.y) + bfhi(q[4 * i + 1]) * bfhi(kv.y);
            d1 += bflo(q[4 * i + 2]) * bflo(kv.z) + bfhi(q[4 * i + 2]) * bfhi(kv.z); d1 += bflo(q[4 * i + 3]) * bflo(kv.w) + bfhi(q[4 * i + 3]) * bfhi(kv.w); }
        const float bias = bt[p]; const float s0 = d0 + bias, s1 = d1 + bias;
        if (s0 > m0) { const float a = exp2f(m0 - s0); l0 *= a;
#pragma unroll
            for (int i = 0; i < 16; ++i) o0[i] *= a;
            m0 = s0; }
        if (s1 > m1) { const float a = exp2f(m1 - s1); l1 *= a;
#pragma unroll
            for (int i = 0; i < 16; ++i) o1[i] *= a;
            m1 = s1; }
        const float p0 = exp2f(s0 - m0), p1 = exp2f(s1 - m1); l0 += p0; l1 += p1;
        const GAS v4u* vp = (const GAS v4u*)(vbase + (size_t)p * NPROJ);
#pragma unroll
        for (int i = 0; i < 2; ++i) { const v4u vv = vp[i]; const float v0 = bflo(vv.x), v1 = bfhi(vv.x), v2 = bflo(vv.y), v3 = bfhi(vv.y), v4 = bflo(vv.z), v5 = bfhi(vv.z), v6 = bflo(vv.w), v7 = bfhi(vv.w);
            o0[8 * i + 0] += p0 * v0; o0[8 * i + 1] += p0 * v1; o0[8 * i + 2] += p0 * v2; o0[8 * i + 3] += p0 * v3; o0[8 * i + 4] += p0 * v4; o0[8 * i + 5] += p0 * v5; o0[8 * i + 6] += p0 * v6; o0[8 * i + 7] += p0 * v7;
            o1[8 * i + 0] += p1 * v0; o1[8 * i + 1] += p1 * v1; o1[8 * i + 2] += p1 * v2; o1[8 * i + 3] += p1 * v3; o1[8 * i + 4] += p1 * v4; o1[8 * i + 5] += p1 * v5; o1[8 * i + 6] += p1 * v6; o1[8 * i + 7] += p1 * v7; }
    }
    const float li = 0.8f - 0.6f * expf(-0.3f * (float)layer);
    const float i0 = 1.f / l0, i1 = lam / l1; float ssq = 0.f;
#pragma unroll
    for (int i = 0; i < 16; ++i) { o0[i] = o0[i] * i0 - o1[i] * i1; ssq += o0[i] * o0[i]; }
    ssq += __shfl_xor(ssq, 1); ssq += __shfl_xor(ssq, 2); ssq += __shfl_xor(ssq, 4);
    const float r = (1.f - li) / sqrtf(ssq * (1.f / HD) + SUBLN_EPS);
    const float* g = g_subln + layer * HD + oct * 16;
    GAS v4u* op = (GAS v4u*)(MIX + (size_t)(b * SEQ + s) * DM + DILW + h * HD + oct * 16);
#pragma unroll
    for (int i = 0; i < 2; ++i) { v4u w; w.x = pk2(o0[8 * i] * r * g[8 * i], o0[8 * i + 1] * r * g[8 * i + 1]); w.y = pk2(o0[8 * i + 2] * r * g[8 * i + 2], o0[8 * i + 3] * r * g[8 * i + 3]);
        w.z = pk2(o0[8 * i + 4] * r * g[8 * i + 4], o0[8 * i + 5] * r * g[8 * i + 5]); w.w = pk2(o0[8 * i + 6] * r * g[8 * i + 6], o0[8 * i + 7] * r * g[8 * i + 7]); op[i] = w; }
}

constexpr int DIL_V_OFF = 0, DIL_T_OFF = 131072;
__device__ __forceinline__ void dilated_phase(Frame& F, unsigned char* ws) {
    const int tid_ = opaque_tid(), lane_ = tid_ & 63;
    bf16* part_o = (bf16*)(ws + WS_U); float* part_ml = (float*)(ws + WS_U + (size_t)M * 16 * 2 * 128 * 2);
    LAS unsigned char* vl = F.lds + DIL_V_OFF + F.wave * 16384; LAS float* tsub = (LAS float*)(F.lds + DIL_T_OFF);
    for (int item = blockIdx.x; item < 256; item += F.G) {
        const int xg = item & 7, jj = item >> 3, bh = 4 * xg + (jj >> 3), b = bh >> 4, h = bh & 15, c = jj & 7, P0 = c * 512;
        __syncthreads();
        for (int i = tid_; i < 576; i += NWAVES * 64) { const int br = i / 192, rel = (i % 192) - 96, d = br == 0 ? 1 : (br == 1 ? 4 : 16);
            tsub[i] = (rel >= -64 && rel <= 64) ? F.BIAS[h * 8192 + 4095 + rel * d] : -1e30f; }
        __syncthreads();
#pragma unroll 1
        for (int k = 0; k < 4; ++k) { const int wi = F.wave + 8 * k, is4 = wi >> 4, sub = wi & 15;
            const int dil = is4 ? 4 : 16, res = is4 ? (sub & 3) : sub, tq0 = is4 ? P0 / 4 + 32 * (sub >> 2) : P0 / 16;
            att::dilated_wave_item<0>(F.PROJ, part_o, part_ml, F.MIX, vl, tsub + (is4 ? 192 : 384), b, h, dil, res, tq0, is4, lane_); }
        asm volatile("s_waitcnt vmcnt(0)" ::: "memory");
        __syncthreads();
#pragma unroll 1
        for (int k = 0; k < 2; ++k) { const int sub = F.wave + 8 * k;
            att::dilated_wave_item<1>(F.PROJ, part_o, part_ml, F.MIX, vl, tsub, b, h, 1, 0, P0 + 32 * sub, 0, lane_); }
        asm volatile("s_waitcnt vmcnt(0)" ::: "memory");
    }
}

#define IN(k) (lo <= (k) && (k) < hi)
#define SEAM(k) do { if (IN(k) && IN((k) + 1)) xcd_barrier(bar); } while (0)
template <int l> struct ConvHook {
    static constexpr int T_IN = DM * (NPROJ / 512), T_OUT = DM * (DM / 512), T_UP = DM * (DFF / 512), T_DN = DFF * (DM / 512);
    static constexpr int TOT = T_OUT + T_UP + T_DN + (l + 1 < DEPTH ? T_IN : 0);
    const float *w_out, *w_up, *w_dn, *w_in; bf16 *o_out, *o_up, *o_dn, *o_in;
    const LAS float* stg; unsigned stg_u; int g0, gstride, slot, nslot, pend;
    __device__ __forceinline__ void locate(int g, const float*& W, bf16*& WT, int& K, int& N, int& k0, int& n0) const {
        if (g < T_OUT) { W = w_out; WT = o_out; K = DM; N = DM; k0 = 64 * (g / (DM / 8)); n0 = 8 * (g % (DM / 8)); }
        else if (g < T_OUT + T_UP) { g -= T_OUT; W = w_up; WT = o_up; K = DM; N = DFF; k0 = 64 * (g / (DFF / 8)); n0 = 8 * (g % (DFF / 8)); }
        else if (g < T_OUT + T_UP + T_DN) { g -= T_OUT + T_UP; W = w_dn; WT = o_dn; K = DFF; N = DM; k0 = 64 * (g / (DM / 8)); n0 = 8 * (g % (DM / 8)); }
        else { g -= T_OUT + T_UP + T_DN; W = w_in; WT = o_in; K = DM; N = NPROJ; k0 = 64 * (g / (NPROJ / 8)); n0 = 8 * (g % (NPROJ / 8)); }
    }
    __device__ __forceinline__ void issue(int g, int lane) const { const float* W; bf16* WT; int K, N, k0, n0; locate(g, W, WT, K, N, k0, n0);
        const float* src = W + (size_t)(k0 + ((lane >> 1) & 7) * 8 + (lane >> 4)) * N + n0 + 4 * (lane & 1);
        att::glds16(src, stg_u); att::glds16(src + (size_t)4 * N, stg_u + 1024u); }
    __device__ __forceinline__ void consume(int g, int lane) const { const float* W; bf16* WT; int K, N, k0, n0; locate(g, W, WT, K, N, k0, n0);
        const int n = lane & 7, c = lane >> 3; const LAS float* s = stg + c * 8 + n;
        v4u o; o.x = pk2(s[0], s[64]); o.y = pk2(s[128], s[192]); o.z = pk2(s[256], s[320]); o.w = pk2(s[384], s[448]);
        *(GAS v4u*)(WT + pg8::tiled_w_elem(n0 + n, k0 + 8 * c, K / 64)) = o; }
    __device__ __forceinline__ void step(int lane) {
        if (pend >= 0) consume(pend, lane);
        pend = -1;
        if (slot < nslot) { const int g = slot * gstride + g0; ++slot; if (g < TOT) { issue(g, lane); pend = g; } }
    }
    __device__ __forceinline__ void init(const Frame& F) {
        w_out = F.w_out + (size_t)l * DM * DM; w_up = F.w_up + (size_t)l * DM * DFF; w_dn = F.w_down + (size_t)l * DFF * DM; w_in = F.w_in + (size_t)(l + 1 < DEPTH ? l + 1 : 0) * DM * NPROJ;
        o_out = F.Wout_t + (size_t)l * DM * DM; o_up = F.Wup_t + (size_t)l * DFF * DM; o_dn = F.Wdn_t + (size_t)l * DM * DFF; o_in = F.Win_t + (size_t)(l + 1 < DEPTH ? l + 1 : 0) * NPROJ * DM;
        stg = (const LAS float*)(F.lds + CONV_OFF + F.wave * 2048); stg_u = (unsigned)__builtin_amdgcn_readfirstlane((int)(unsigned)(uintptr_t)(F.lds + CONV_OFF + F.wave * 2048));
        g0 = (int)blockIdx.x * NWAVES + F.wave; gstride = F.G * NWAVES; slot = 0; nslot = (TOT + gstride - 1) / gstride; pend = -1; }
    __device__ __forceinline__ void flush(int lane) { while (pend >= 0 || slot < nslot) { asm volatile("s_waitcnt vmcnt(0)" ::: "memory"); step(lane); } asm volatile("s_waitcnt vmcnt(0)" ::: "memory"); }
};

template <int l> __device__ __forceinline__ void layer_phases(Frame& F, const XcdBarrier& bar, const int lo, const int hi) {
        const int pb = 1 + 7 * l;
        if (IN(pb + 0)) {
            pg8::Gemm g{F.H, F.Win_t + (size_t)l * NPROJ * DM, M, NPROJ, DM}; pg8::StaticOrder S; S.init(M, NPROJ, F.G, (int)blockIdx.x);
            pg8::EpiBf16s<0> E{F.PROJ, NPROJ, COL_KA, COL_QD, COL_KD, SC_A, SC_D, 0};
            for (int dup_ = 0; dup_ < DUPN(2); ++dup_) pg8::gemm_phase<pg8::EpiBf16s<0>, pg8::StaticOrder, PG8_ALIGN, PG8_SP2>(F.lds + RING_OFF, g, S, E);
            SEAM(pb + 0);
        }
        if (IN(pb + 1)) {
            for (int dup_ = 0; dup_ < DUPN(3); ++dup_) dilated_phase(F, (unsigned char*)F.Y - WS_Y);
            { const float lam = __uint_as_float(__hip_atomic_load(F.ctl + CW_LAM + l, RLX_AGENT)); const float post = 1.f - (0.8f - 0.6f * expf(-0.3f * (float)l));
              ConvHook<l> hk; hk.init(F); att::NoHook nohk;
              for (int dup_ = 0; dup_ < DUPN(4); ++dup_) for (int u = blockIdx.x; u < 1024; u += F.G) { const int j = u >> 3, bh = (u & 7) * 4 + (j >> 5), qb = j & 31;
                  att::diff_unit<0>(F.PROJ, F.MIX, F.BIAS, F.g_subln + l * HD, lam, post, F.lds, bh >> 4, bh & 15, qb, opaque_tid(), hk); }
              hk.flush(opaque_tid() & 63);
              if (PROBE_GV > 0) for (int u = blockIdx.x; u < 1024; u += F.G) { const int j = u >> 3, bh = (u & 7) * 4 + (j >> 5), qb = j & 31;
                  att::diff_unit<PROBE_GV>(F.PROJ, F.MIX, F.BIAS, F.g_subln + l * HD, lam, post, F.lds, bh >> 4, bh & 15, qb, opaque_tid(), nohk); }
              __syncthreads(); }
            SEAM(pb + 1);
        }
        if (IN(pb + 2)) {
            pg8::Gemm g{F.MIX, F.Wout_t + (size_t)l * DM * DM, M, DM, DM}; pg8::StaticOrder S; S.init(M, DM, F.G, (int)blockIdx.x);
            pg8::EpiBf16Ssq E{F.Y, DM, F.PART, NPART};
            for (int dup_ = 0; dup_ < DUPN(5); ++dup_) pg8::gemm_phase<pg8::EpiBf16Ssq, pg8::StaticOrder, PG8_ALIGN, PG8_SP2>(F.lds + RING_OFF, g, S, E);
            SEAM(pb + 2);
        }
        if (IN(pb + 3)) { bf16* XB = (bf16*)((unsigned char*)F.Y + 64 * MiB);
            if (l == 0) thin_phase<false, true>(F, F.x, XB, F.g_post_mix + l * DM, F.g_pre_mlp + l * DM, true); else thin_phase<true, true>(F, XB, XB, F.g_post_mix + l * DM, F.g_pre_mlp + l * DM, true);
            SEAM(pb + 3); }
        if (IN(pb + 4)) {
            pg8::Gemm g{F.H, F.Wup_t + (size_t)l * DFF * DM, M, DFF, DM}; pg8::StaticOrder S; S.init(M, DFF, F.G, (int)blockIdx.x);
            pg8::EpiBf16s<1> E{F.U, DFF, 0, 0, 0, 1.f, 1.f, DFF / 64};
            for (int dup_ = 0; dup_ < DUPN(6); ++dup_) pg8::gemm_phase<pg8::EpiBf16s<1>, pg8::StaticOrder, PG8_ALIGN, PG8_SP2>(F.lds + RING_OFF, g, S, E);
            if (PROBE_GG > 0) { pg8::EpiBf16s<1> Eg{(bf16*)((unsigned char*)F.Y - WS_Y + WS_END), DFF, 0, 0, 0, 1.f, 1.f};
                if (PROBE_GG == 5) { pg8::Gemm gp = g; gp.lda = DM + 64; gp.ldb = DM + 64; pg8::gemm_phase<pg8::EpiBf16s<1>, pg8::StaticOrder, PG8_ALIGN, PG8_SP2>(F.lds + RING_OFF, gp, S, Eg); }
                else if (PROBE_GG == 1) pg8::gemm_phase<pg8::EpiBf16s<1>, pg8::StaticOrder, PG8_ALIGN, PG8_SP2>(F.lds + RING_OFF, g, S, Eg);
                else { pg8::FixedOrder Sf; Sf.init(M, DFF, F.G, (int)blockIdx.x); Sf.mode = PROBE_GG; pg8::gemm_phase<pg8::EpiBf16s<1>, pg8::FixedOrder, PG8_ALIGN, PG8_SP2>(F.lds + RING_OFF, g, Sf, Eg); } }
            SEAM(pb + 4);
        }
        if (IN(pb + 5)) {
            pg8::Gemm g{F.U, F.Wdn_t + (size_t)l * DM * DFF, M, DM, DFF}; pg8::StaticOrder S; S.init(M, DM, F.G, (int)blockIdx.x);
            pg8::EpiBf16Ssq E{F.Y, DM, F.PART, NPART};
            for (int dup_ = 0; dup_ < DUPN(7); ++dup_) pg8::gemm_phase<pg8::EpiBf16Ssq, pg8::StaticOrder, PG8_ALIGN, PG8_SP2>(F.lds + RING_OFF, g, S, E);
            SEAM(pb + 5);
        }
        if (IN(pb + 6)) { bf16* XB = (bf16*)((unsigned char*)F.Y + 64 * MiB);
            if (l + 1 < DEPTH) thin_phase<true, true>(F, XB, XB, F.g_post_mlp + l * DM, F.g_pre_mix + (l + 1) * DM, true); else thin_phase<true, false>(F, XB, F.out, F.g_post_mlp + l * DM, F.g_post_mlp + l * DM, false);
            SEAM(pb + 6); }
    }
#undef IN
#undef SEAM

struct Args { const float* in[15]; float* out; unsigned char* ws; int ph_lo, ph_hi, pad0, pad1; };
__global__ void __launch_bounds__(NWAVES * 64, 2) mk_fwd(Args args) {
    extern __shared__ __attribute__((aligned(16))) unsigned char lds[];
    Frame F;
    F.lds = (LAS unsigned char*)lds;
    F.MISC = (volatile LAS unsigned*)(F.lds + MISC_OFF);
    F.tid = threadIdx.x; F.lane = F.tid & 63; F.wave = __builtin_amdgcn_readfirstlane(F.tid >> 6);
    F.G = gridDim.x; { const int bx = blockIdx.x; F.vcu = (F.G % 8 == 0) ? (bx % 8) * (F.G / 8) + bx / 8 : bx; }
    unsigned char* ws = args.ws;
    F.ctl = (gu32*)(ws + WS_CTL);
    F.x = args.in[0]; F.rel_bias = args.in[1]; F.g_pre_mix = args.in[2]; F.w_in = args.in[3]; F.lq1 = args.in[4]; F.lk1 = args.in[5]; F.lq2 = args.in[6]; F.lk2 = args.in[7];
    F.g_subln = args.in[8]; F.w_out = args.in[9]; F.g_post_mix = args.in[10]; F.g_pre_mlp = args.in[11]; F.w_up = args.in[12]; F.w_down = args.in[13]; F.g_post_mlp = args.in[14];
    F.out = args.out;
    F.Win_t = (bf16*)(ws + WS_WIN); F.Wout_t = (bf16*)(ws + WS_WOUT); F.Wup_t = (bf16*)(ws + WS_WUP); F.Wdn_t = (bf16*)(ws + WS_WDN);
    F.H = (bf16*)(ws + WS_H); F.PROJ = (bf16*)(ws + WS_PROJ); F.MIX = (bf16*)(ws + WS_MIX); F.U = (bf16*)(ws + WS_U);
    F.Y = (bf16*)(ws + WS_Y); F.PART = (float*)(ws + WS_PART); F.BIAS = (float*)(ws + WS_BIAS);
    for (int u = F.tid; u < (LDS_BYTES - LDSCTL_OFF) / 4; u += NWAVES * 64) ((LAS unsigned*)(F.lds + LDSCTL_OFF))[u] = 0u;
    __syncthreads();
    XcdBarrier bar; bar.bar = (unsigned*)(F.ctl + CW_BAR); bar.x = 0; bar.st = nullptr;
    const bool one = (args.ph_hi - args.ph_lo) > 1;
    if (one) bar = xcd_barrier_post((unsigned*)(F.ctl + CW_BAR), F.MISC + 8);
    const int lo = args.ph_lo, hi = args.ph_hi;
#define IN(k) (lo <= (k) && (k) < hi)
#define SEAM(k) do { if (IN(k) && IN((k) + 1)) xcd_barrier(bar); } while (0)

    if (PROBE_CLK > 0 && IN(0)) {
        const int w_ = F.wave;
        if (PROBE_CLK != 9 || w_ < 4) {
            if (PROBE_CLK == 8 && w_ >= 4) __builtin_amdgcn_s_setprio(1);
            att::f32x16 a0 = {}, a1 = {}, a2 = {}, a3 = {}; att::bf16x8 x = {0x3f80, 0x4000, 0x3fc0, 0x4040, 0x3f80, 0x4000, 0x3fc0, 0x4040}, y = {0x3f80, 0x3f00, 0x3e80, 0x3f80, 0x3f80, 0x3f00, 0x3e80, 0x3f80}; asm volatile("" : "+v"(x), "+v"(y));
            float v0 = (float)threadIdx.x, v1 = v0 + 1.f, v2 = v0 + 2.f, v3 = v0 + 3.f, v4 = v0 + 4.f, v5 = v0 + 5.f; const float c = 0.999f;
#define PC_V6() do { v0 = fmaf(v0, c, 0.5f); v1 = fmaf(v1, c, 0.5f); v2 = fmaf(v2, c, 0.5f); if (PROBE_CLK != 7) { v3 = fmaf(v3, c, 0.5f); v4 = fmaf(v4, c, 0.5f); v5 = fmaf(v5, c, 0.5f); } } while (0)
#pragma unroll 1
            for (int i = 0; i < 6250; ++i) {
                a0 = __builtin_amdgcn_mfma_f32_32x32x16_bf16(x, y, a0, 0, 0, 0); PC_V6(); __builtin_amdgcn_sched_barrier(0);
                a1 = __builtin_amdgcn_mfma_f32_32x32x16_bf16(x, y, a1, 0, 0, 0); PC_V6(); __builtin_amdgcn_sched_barrier(0);
                a2 = __builtin_amdgcn_mfma_f32_32x32x16_bf16(x, y, a2, 0, 0, 0); PC_V6(); __builtin_amdgcn_sched_barrier(0);
                a3 = __builtin_amdgcn_mfma_f32_32x32x16_bf16(x, y, a3, 0, 0, 0); PC_V6(); __builtin_amdgcn_sched_barrier(0); }
#undef PC_V6
            if (a0[0] + a1[1] + a2[2] + a3[3] + v0 + v1 + v2 + v3 + v4 + v5 == -1.2345f) F.out[threadIdx.x] = 0.f;
            if (PROBE_CLK == 8 && w_ >= 4) __builtin_amdgcn_s_setprio(0); }
        __syncthreads(); }
    if (IN(0)) { for (int dup_ = 0; dup_ < DUPN(1); ++dup_) p0_prologue(F); SEAM(0); for (int eb_ = 0; eb_ < PROBE_BAR; ++eb_) xcd_barrier(bar); }

    layer_phases<0>(F, bar, lo, hi);
    layer_phases<1>(F, bar, lo, hi);
#undef IN
#undef SEAM
}

extern "C" void kernel_launch(void* const* d_in, const int* in_sizes, int n_in, void* d_out, int out_size, void* d_ws, size_t ws_size, hipStream_t stream) {
    static int grid = 0;
    if (grid == 0) {
        if (n_in != 15 || in_sizes[0] != M * DM || out_size != M * DM || ws_size < WS_END) { fprintf(stderr, "kernel_launch: shape mismatch (n_in %d, in0 %d, out %d, ws %zu < %zu); nothing launched\n", n_in, n_in > 0 ? in_sizes[0] : -1, out_size, ws_size, (size_t)WS_END); grid = -1; return; }
        int dev = 0, cus = 0, per_cu = 0;
        if (hipGetDevice(&dev) != hipSuccess || hipDeviceGetAttribute(&cus, hipDeviceAttributeMultiprocessorCount, dev) != hipSuccess) { grid = -1; return; }
        if (hipFuncSetAttribute((const void*)mk_fwd, hipFuncAttributeMaxDynamicSharedMemorySize, LDS_BYTES) != hipSuccess) { fprintf(stderr, "kernel_launch: hipFuncSetAttribute failed\n"); grid = -1; return; }
        if (hipOccupancyMaxActiveBlocksPerMultiprocessor(&per_cu, (const void*)mk_fwd, NWAVES * 64, LDS_BYTES) != hipSuccess || per_cu < 1)
            fprintf(stderr, "kernel_launch: note: occupancy query reports %d workgroups per CU\n", per_cu);
        (void)hipGetLastError();
        grid = cus;
    }
    if (grid < 0) return;
    if (hipMemsetAsync((char*)d_ws + WS_CTL, 0, CTL_ZERO_BYTES, stream) != hipSuccess) { fprintf(stderr, "kernel_launch: memset failed\n"); return; }
    Args a{};
    for (int i = 0; i < 15; ++i) a.in[i] = (const float*)d_in[i];
    a.out = (float*)d_out; a.ws = (unsigned char*)d_ws; a.pad0 = 0; a.pad1 = 0;
#if MK_ONE_LAUNCH
    a.ph_lo = 0; a.ph_hi = N_PHASES;
    hipLaunchKernelGGL(mk_fwd, dim3(grid), dim3(NWAVES * 64), LDS_BYTES, stream, a);
#else
    for (int p = 0; p < N_PHASES; ++p) {
        a.ph_lo = p; a.ph_hi = p + 1; hipLaunchKernelGGL(mk_fwd, dim3(grid), dim3(NWAVES * 64), LDS_BYTES, stream, a); }
#endif
    const hipError_t le = hipPeekAtLastError();
    if (le != hipSuccess) fprintf(stderr, "kernel_launch: launch failed: %s\n", hipGetErrorName(le));
}
```

```cpp
#include <hip/hip_runtime.h>
#include <cstdio>
#include <cstdint>
namespace pg8 {
#define PG8_LAS __attribute__((address_space(3)))
typedef unsigned short bf16_t;
typedef short bf16x8 __attribute__((ext_vector_type(8)));
typedef float f32x4 __attribute__((ext_vector_type(4)));
typedef unsigned u32x4 __attribute__((ext_vector_type(4)));
constexpr int BM = 256, BK = 64, HALF = 128, HTB = HALF * BK * 2  , STAGE_BYTES = 8 * HTB, NXCD = 8, WGM = 8;

__host__ __device__ __forceinline__ int lds_byte(int r, int c) { const int st = (r >> 4) * 2 + (c >> 5), rr = r & 15, cc = c & 31, ob = rr * 64 + cc * 2; return st * 1024 + (ob ^ (((ob >> 9) & 1) << 5)); }
__host__ __device__ __forceinline__ void stage_rc(int b, int& R, int& C) { const int st = b / 1024, sb = b % 1024, swz = sb ^ (((sb >> 9) & 1) << 5); R = (st >> 1) * 16 + swz / 64; C = (st & 1) * 32 + (swz % 64) / 2; }
__host__ __device__ __forceinline__ int perm32(int rho) { const int n = rho >> 4, i = rho & 15; return 8 * (i >> 2) + 4 * n + (i & 3); }

__host__ __device__ __forceinline__ size_t tiled_elem(int row, int col, int nKt) { return ((((size_t)(row >> 8) * nKt + (col >> 6)) * 2 + ((row >> 7) & 1)) * 8192) + (size_t)(lds_byte(row & 127, col & 63) >> 1); }
__host__ __device__ __forceinline__ int inv_perm32(int v) { return 16 * ((v >> 2) & 1) + 4 * (v >> 3) + (v & 3); }
__host__ __device__ __forceinline__ size_t tiled_w_elem(int n, int k, int nKt) { const int nl = n & 127, R = (nl & ~31) + inv_perm32(nl & 31); return ((((size_t)(n >> 8) * nKt + (k >> 6)) * 2 + ((n >> 7) & 1)) * 8192) + (size_t)(lds_byte(R, k & 63) >> 1); }

struct Unit { int pm, pn; };
struct Gemm { const bf16_t* A; const bf16_t* Bt; int M, N, K; int lda = 0, ldb = 0; };

struct StaticOrder {
    int nM, nN, nwg, G, c;
    __host__ __device__ void init(int M, int N, int G_, int c_) { nM = M / BM; nN = N / BM; nwg = nM * nN; G = G_; c = c_; }
    __host__ __device__ bool next(int i, Unit& u) const {
        const long L = (long)i * G + c; if (L >= nwg) return false;
        int wgid = (int)L; { const int q = nwg / NXCD, r = nwg % NXCD, xcd = wgid % NXCD, off = wgid / NXCD; wgid = (xcd < r ? xcd * (q + 1) : r * (q + 1) + (xcd - r) * q) + off; }
        const int nig = WGM * nN, gid = wgid / nig, fm = gid * WGM, gsz = (nM - fm) < WGM ? (nM - fm) : WGM;
        u.pm = fm + ((wgid % nig) % gsz); u.pn = (wgid % nig) / gsz; return true;
    }
    __device__ __forceinline__ void a_ready(const Unit&) const {}
    __device__ __forceinline__ void done(const Unit&) const {}
};

__device__ __forceinline__ unsigned cvt_pk_bf16(float lo, float hi) { unsigned r; asm volatile("v_cvt_pk_bf16_f32 %0, %1, %2" : "=v"(r) : "v"(lo), "v"(hi)); return r; }
typedef float f32x2 __attribute__((ext_vector_type(2)));
template <int MODE> struct EpiBf16s {
    static constexpr bool PERM = true, AFTER_DRAIN = false;
    bf16_t* O; int ldc; int qa_end, qd_lo, qd_hi; float sc_a, sc_d; int tiled_nkt;
    __device__ __forceinline__ void operator()(const f32x4 (&acc)[2][2][4][2], const Unit& u, int wr, int wc, int fr, int fq) const {
        const int row0 = u.pm * BM + wr * 64 + fr; const int colt = u.pn * BM;
        float sc = 1.f; if (MODE == 0) { if (colt < qa_end) sc = sc_a; else if (colt >= qd_lo && colt < qd_hi) sc = sc_d; }
        const int col0 = colt + wc * 32 + 8 * fq;
        bf16_t* tb_ = O + ((size_t)(u.pm * tiled_nkt + (colt >> 6) + (wc >> 1)) * 2) * 8192 + (wr * 4 * 2 + (wc & 1)) * 512 + (((fr * 64 + fq * 16) ^ ((((fr * 64 + fq * 16) >> 9) & 1) << 5)) >> 1);
#pragma unroll
        for (int ai = 0; ai < 2; ++ai)
#pragma unroll
            for (int m = 0; m < 4; ++m) { bf16_t* rowp = O + (size_t)(row0 + ai * HALF + m * 16) * ldc + col0;
#pragma unroll
                for (int bj = 0; bj < 2; ++bj) { f32x4 v0 = acc[ai][bj][m][0], v1 = acc[ai][bj][m][1];
                    if (MODE == 1) {
#pragma unroll
                        for (int e = 0; e < 4; ++e) { const float a = fmaxf(v0[e], 0.f), b = fmaxf(v1[e], 0.f); v0[e] = a * a; v1[e] = b * b; }
                    } else { v0 = v0 * sc; v1 = v1 * sc; }
                    u32x4 w; w.x = cvt_pk_bf16(v0[0], v0[1]); w.y = cvt_pk_bf16(v0[2], v0[3]); w.z = cvt_pk_bf16(v1[0], v1[1]); w.w = cvt_pk_bf16(v1[2], v1[3]);
                    if (tiled_nkt) *(u32x4*)(tb_ + (size_t)(bj * 2 * 2 + ai) * 8192 + m * 1024) = w; else *(u32x4*)(rowp + bj * HALF) = w; } }
    }
};
struct EpiF32Ssq {
    static constexpr bool PERM = false, AFTER_DRAIN = false;
    float* C; int ldc; float* part; int npart;
    __device__ __forceinline__ void operator()(const f32x4 (&acc)[2][2][4][2], const Unit& u, int wr, int wc, int fr, int fq) const {
        const int row0 = u.pm * BM + wr * 64 + fr, col0 = u.pn * BM + wc * 32 + 4 * fq;
#pragma unroll
        for (int ai = 0; ai < 2; ++ai)
#pragma unroll
            for (int m = 0; m < 4; ++m) { const int row = row0 + ai * HALF + m * 16; float* rowp = C + (size_t)row * ldc + col0; float s = 0.f;
#pragma unroll
                for (int bj = 0; bj < 2; ++bj)
#pragma unroll
                    for (int n = 0; n < 2; ++n) { const f32x4 x = acc[ai][bj][m][n]; *(f32x4*)(rowp + bj * HALF + n * 16) = x; s += (x[0] * x[0] + x[1] * x[1]) + (x[2] * x[2] + x[3] * x[3]); }
                s += __shfl_xor(s, 16); s += __shfl_xor(s, 32);
                if (fq == 0) part[(size_t)row * npart + u.pn * 4 + wc] = s; }
    }
};

struct EpiBf16Ssq {
    static constexpr bool PERM = true, AFTER_DRAIN = false;
    bf16_t* C; int ldc; float* part; int npart;
    __device__ __forceinline__ void operator()(const f32x4 (&acc)[2][2][4][2], const Unit& u, int wr, int wc, int fr, int fq) const {
        const int row0 = u.pm * BM + wr * 64 + fr, col0 = u.pn * BM + wc * 32 + 8 * fq;
#pragma unroll
        for (int ai = 0; ai < 2; ++ai)
#pragma unroll
            for (int m = 0; m < 4; ++m) { const int row = row0 + ai * HALF + m * 16; bf16_t* rowp = C + (size_t)row * ldc + col0; float s = 0.f;
#pragma unroll
                for (int bj = 0; bj < 2; ++bj) { const f32x4 v0 = acc[ai][bj][m][0], v1 = acc[ai][bj][m][1];
                    s += (v0[0] * v0[0] + v0[1] * v0[1]) + (v0[2] * v0[2] + v0[3] * v0[3]) + (v1[0] * v1[0] + v1[1] * v1[1]) + (v1[2] * v1[2] + v1[3] * v1[3]);
                    u32x4 w; w.x = cvt_pk_bf16(v0[0], v0[1]); w.y = cvt_pk_bf16(v0[2], v0[3]); w.z = cvt_pk_bf16(v1[0], v1[1]); w.w = cvt_pk_bf16(v1[2], v1[3]);
                    *(u32x4*)(rowp + bj * HALF) = w; }
                s += __shfl_xor(s, 16); s += __shfl_xor(s, 32);
                if (fq == 0) part[(size_t)row * npart + u.pn * 4 + wc] = s; }
    }
};
struct FixedOrder : StaticOrder { int mode;
    __host__ __device__ bool next(int i, Unit& u) const { const long L = (long)i * G + c; if (L >= nwg) return false; if (mode == 2) { u.pm = 0; u.pn = 0; } else { u.pm = c % 8; u.pn = (c / 8) % 2; } return true; }
};
template <class Epi, class Sched, bool ALIGN_EPI = false, bool SP2 = false>
__device__ __forceinline__ void gemm_phase(PG8_LAS unsigned char* lds, const Gemm g, const Sched& S, const Epi& E) {
    int tid = threadIdx.x; asm volatile("" : "+v"(tid)); const int wid = __builtin_amdgcn_readfirstlane(tid >> 6), lane = tid & 63, wr = wid >> 2, wc = wid & 3, fr = lane & 15, fq = lane >> 4;
    static_assert(Epi::PERM, "the weight image has the perm32 row order baked in");
    const int K = g.K, nt = K / BK;
    unsigned voffA[2], voffB[2];
#pragma unroll
    for (int i = 0; i < 2; ++i) { voffA[i] = (unsigned)(tid * 16 + i * 8192); voffB[i] = voffA[i]; }
    const size_t kstep = 32768;
    const size_t hstepA = 16384, hstepB = 16384;
    const size_t tstepA = (size_t)nt * 32768, tstepB = tstepA;
    const unsigned ldsw = (unsigned)wid * 1024u;
    const int aoff = lds_byte(wr * 64 + fr, fq * 8), boff = lds_byte(wc * 32 + fr, fq * 8);
#define PG8_SA(b, h) (((b) * 2 + (h)) * HTB)
#define PG8_SB(b, h) ((4 + (b) * 2 + (h)) * HTB)
#define PG8_STAGE(bufoff, gbase, voff) do { _Pragma("unroll") for (int _i = 0; _i < 2; ++_i) \
        __builtin_amdgcn_global_load_lds((const unsigned*)((const char*)(gbase) + (voff)[_i]), (PG8_LAS unsigned*)(lds + (bufoff) + ldsw + _i * 8192), 16, 0, 0); } while (0)
#define PG8_LDA(dst, b, h) do { _Pragma("unroll") for (int m = 0; m < 4; ++m) _Pragma("unroll") for (int k = 0; k < 2; ++k) dst[m][k] = *(const PG8_LAS bf16x8*)(lds + PG8_SA(b, h) + aoff + m * 2048 + k * 1024); } while (0)
#define PG8_LDB(dst, b, h) do { _Pragma("unroll") for (int n = 0; n < 2; ++n) _Pragma("unroll") for (int k = 0; k < 2; ++k) dst[n][k] = *(const PG8_LAS bf16x8*)(lds + PG8_SB(b, h) + boff + n * 2048 + k * 1024); } while (0)
#define PG8_MMA(ai, bj, At, Bt) do { __builtin_amdgcn_s_setprio(1); _Pragma("unroll") for (int m = 0; m < 4; ++m) _Pragma("unroll") for (int n = 0; n < 2; ++n) _Pragma("unroll") for (int k = 0; k < 2; ++k) \
        acc[ai][bj][m][n] = __builtin_amdgcn_mfma_f32_16x16x32_bf16(Bt[n][k], At[m][k], acc[ai][bj][m][n], 0, 0, 0); __builtin_amdgcn_s_setprio(0); } while (0)
#define PG8_WAIT_V(n) asm volatile("s_waitcnt vmcnt(" #n ")" ::: "memory")
#define PG8_WAIT_L(n) asm volatile("s_waitcnt lgkmcnt(" #n ")" ::: "memory")
#define PG8_BAR __builtin_amdgcn_s_barrier()
#define PG8_SCHED __builtin_amdgcn_sched_barrier(0)
    Unit cur, nxt; int ui = 0;
    if (!S.next(0, cur)) return;
    f32x4 acc[2][2][4][2];
#pragma unroll
    for (int a = 0; a < 2; ++a)
#pragma unroll
        for (int b = 0; b < 2; ++b)
#pragma unroll
            for (int m = 0; m < 4; ++m)
#pragma unroll
                for (int n = 0; n < 2; ++n) acc[a][b][m][n] = (f32x4){0.f, 0.f, 0.f, 0.f};
    bf16x8 At[4][2], B0[2][2], B1[2][2];
    const char* cA = (const char*)g.A + (size_t)cur.pm * tstepA; const char* cB = (const char*)g.Bt + (size_t)cur.pn * tstepB;
    S.a_ready(cur);
    if constexpr (SP2) {
        PG8_STAGE(PG8_SB(0, 0), cB, voffB); PG8_STAGE(PG8_SB(0, 1), cB + hstepB, voffB); PG8_STAGE(PG8_SA(0, 0), cA, voffA); PG8_STAGE(PG8_SA(0, 1), cA + hstepA, voffA);
        if (wr == 1) PG8_BAR;
        PG8_WAIT_V(2); PG8_BAR;
        PG8_STAGE(PG8_SB(1, 0), cB + kstep, voffB); PG8_STAGE(PG8_SA(1, 0), cA + kstep, voffA); PG8_STAGE(PG8_SB(1, 1), cB + hstepB + kstep, voffB);
        PG8_WAIT_V(6); PG8_BAR;
    } else {
        PG8_STAGE(PG8_SB(0, 0), cB, voffB); PG8_STAGE(PG8_SA(0, 0), cA, voffA); PG8_STAGE(PG8_SB(0, 1), cB + hstepB, voffB); PG8_STAGE(PG8_SA(0, 1), cA + hstepA, voffA);
        if (wr == 1) PG8_BAR;
        PG8_WAIT_V(4); PG8_BAR;
        PG8_STAGE(PG8_SB(1, 0), cB + kstep, voffB); PG8_STAGE(PG8_SA(1, 0), cA + kstep, voffA); PG8_STAGE(PG8_SB(1, 1), cB + hstepB + kstep, voffB);
        PG8_WAIT_V(6); PG8_BAR;
    }
    for (;;) {
        const bool has_next = S.next(ui + 1, nxt);
        const char* nA = has_next ? (const char*)g.A + (size_t)nxt.pm * tstepA : cA; const char* nB = has_next ? (const char*)g.Bt + (size_t)nxt.pn * tstepB : cB;
        for (int t = 0; t < nt; t += 2) {
            const bool last = (t == nt - 2);
            const char* a1 = cA + (size_t)(t + 1) * kstep;
            const char* a2 = last ? nA : cA + (size_t)(t + 2) * kstep; const char* b2 = last ? nB : cB + (size_t)(t + 2) * kstep;
            const char* a3 = a2 + kstep; const char* b3 = b2 + kstep;
            if (last && has_next) S.a_ready(nxt);
            if constexpr (SP2) {
            PG8_LDB(B0, 0, 0); PG8_LDB(B1, 0, 1); PG8_SCHED; PG8_LDA(At, 0, 0); PG8_STAGE(PG8_SA(1, 1), a1 + hstepA, voffA);
            PG8_WAIT_V(8); PG8_WAIT_L(0); PG8_BAR; PG8_MMA(0, 0, At, B0); PG8_MMA(0, 1, At, B1); PG8_BAR; PG8_SCHED;
            PG8_LDA(At, 0, 1); PG8_STAGE(PG8_SB(0, 0), b2, voffB); PG8_STAGE(PG8_SB(0, 1), b2 + hstepB, voffB); PG8_STAGE(PG8_SA(0, 0), a2, voffA);
            PG8_WAIT_V(8); PG8_WAIT_L(0); PG8_BAR; PG8_MMA(1, 0, At, B0); PG8_MMA(1, 1, At, B1); PG8_BAR; PG8_SCHED;
            PG8_LDB(B0, 1, 0); PG8_LDB(B1, 1, 1); PG8_SCHED; PG8_LDA(At, 1, 0); PG8_STAGE(PG8_SA(0, 1), a2 + hstepA, voffA);
            PG8_WAIT_V(8); PG8_WAIT_L(0); PG8_BAR; PG8_MMA(0, 0, At, B0); PG8_MMA(0, 1, At, B1); PG8_BAR; PG8_SCHED;
            PG8_LDA(At, 1, 1); PG8_STAGE(PG8_SB(1, 0), b3, voffB); PG8_STAGE(PG8_SB(1, 1), b3 + hstepB, voffB); PG8_STAGE(PG8_SA(1, 0), a3, voffA);
            PG8_WAIT_V(8); PG8_WAIT_L(0); PG8_BAR; PG8_MMA(1, 0, At, B0); PG8_MMA(1, 1, At, B1); PG8_BAR; PG8_SCHED;
            } else {
            PG8_LDB(B0, 0, 0); PG8_SCHED; PG8_LDA(At, 0, 0); PG8_STAGE(PG8_SA(1, 1), a1 + hstepA, voffA);
            PG8_WAIT_L(8); PG8_BAR; PG8_WAIT_L(0); PG8_MMA(0, 0, At, B0); PG8_BAR; PG8_SCHED;
            PG8_LDB(B1, 0, 1); PG8_STAGE(PG8_SB(0, 0), b2, voffB);
            PG8_BAR; PG8_WAIT_L(0); PG8_MMA(0, 1, At, B1); PG8_BAR;
            PG8_LDA(At, 0, 1); PG8_STAGE(PG8_SA(0, 0), a2, voffA);
            PG8_BAR; PG8_WAIT_L(0); PG8_MMA(1, 0, At, B0); PG8_BAR; PG8_SCHED;
            PG8_STAGE(PG8_SB(0, 1), b2 + hstepB, voffB);
            PG8_WAIT_V(6); PG8_BAR; PG8_MMA(1, 1, At, B1); PG8_BAR;
            PG8_LDB(B0, 1, 0); PG8_SCHED; PG8_LDA(At, 1, 0); PG8_STAGE(PG8_SA(0, 1), a2 + hstepA, voffA);
            PG8_WAIT_L(8); PG8_BAR; PG8_WAIT_L(0); PG8_MMA(0, 0, At, B0); PG8_BAR; PG8_SCHED;
            PG8_LDB(B1, 1, 1); PG8_STAGE(PG8_SB(1, 0), b3, voffB);
            PG8_BAR; PG8_WAIT_L(0); PG8_MMA(0, 1, At, B1); PG8_BAR;
            PG8_LDA(At, 1, 1); PG8_STAGE(PG8_SA(1, 0), a3, voffA);
            PG8_BAR; PG8_WAIT_L(0); PG8_MMA(1, 0, At, B0); PG8_BAR; PG8_SCHED;
            PG8_STAGE(PG8_SB(1, 1), b3 + hstepB, voffB);
            PG8_WAIT_V(6); PG8_BAR; PG8_MMA(1, 1, At, B1); PG8_BAR;
            }
        }
        if constexpr (ALIGN_EPI) { if (wr == 0) PG8_BAR; }
        if constexpr (!Epi::AFTER_DRAIN) { E(acc, cur, wr, wc, fr, fq); S.done(cur); }
        if (!has_next) break;
#pragma unroll
        for (int a = 0; a < 2; ++a)
#pragma unroll
            for (int b = 0; b < 2; ++b)
#pragma unroll
                for (int m = 0; m < 4; ++m)
#pragma unroll
                    for (int n = 0; n < 2; ++n) acc[a][b][m][n] = (f32x4){0.f, 0.f, 0.f, 0.f};
        cur = nxt; cA = nA; cB = nB; ++ui;
        if constexpr (ALIGN_EPI) { if (wr == 1) PG8_BAR; }
    }
    PG8_WAIT_V(0);
    if constexpr (!ALIGN_EPI) { if (wr == 0) PG8_BAR; }
    PG8_BAR;
    if constexpr (Epi::AFTER_DRAIN) { E.fused(acc, cur, wr, wc, fr, fq, lds, wid, lane); S.done(cur); }
#undef PG8_SA
#undef PG8_SB
#undef PG8_STAGE
#undef PG8_LDA
#undef PG8_LDB
#undef PG8_MMA
#undef PG8_WAIT_V
#undef PG8_WAIT_L
#undef PG8_BAR
#undef PG8_SCHED
}
}

#ifndef PG8_SP2
#define PG8_SP2 true
#endif
#ifndef PG8_ALIGN
#define PG8_ALIGN true
#endif
#define GAS __attribute__((address_space(1)))
#define LAS __attribute__((address_space(3)))
typedef unsigned short bf16;
typedef unsigned v4u __attribute__((ext_vector_type(4)));
typedef float f32x4 __attribute__((ext_vector_type(4)));
typedef short bf16x8 __attribute__((ext_vector_type(8)));
typedef GAS unsigned gu32;
typedef GAS unsigned long long gu64;
#define RLX_AGENT __ATOMIC_RELAXED, __HIP_MEMORY_SCOPE_AGENT
#define LDS_WAIT() asm volatile("s_waitcnt lgkmcnt(0)" ::: "memory")
#define VM_WAIT() asm volatile("s_waitcnt vmcnt(0)" ::: "memory")
__device__ __forceinline__ unsigned long long rt() { return __builtin_amdgcn_s_memrealtime(); }
__device__ __forceinline__ unsigned f2bf(float f) { unsigned u = __builtin_bit_cast(unsigned, f); return (u + 0x7fffu + ((u >> 16) & 1u)) >> 16; }
__device__ __forceinline__ unsigned pk2(float lo, float hi) { return f2bf(lo) | (f2bf(hi) << 16); }

#define XB_TMO      128
#define XB_XCNT(j)  (256  + 64 * (j))
#define XB_XSUB(j)  (1280 + 64 * (j))
#define XB_XGEN(j)  (2304 + 64 * (j))
#define XB_TOP      3328
#define XB_TOPGEN   3392
#define XCD_BAR_WORDS 3456
#define XB_SPIN_CAP (1u << 18)

__device__ __forceinline__ unsigned xb_ld(unsigned* p)              { return __hip_atomic_load(p, __ATOMIC_RELAXED, __HIP_MEMORY_SCOPE_AGENT); }
__device__ __forceinline__ unsigned xb_add(unsigned* p, unsigned v) { return __hip_atomic_fetch_add(p, v, __ATOMIC_RELAXED, __HIP_MEMORY_SCOPE_AGENT); }
__device__ __forceinline__ unsigned xb_xcc_id() { return (unsigned)__builtin_amdgcn_s_getreg((3 << 11) | 20) & 0xFu; }
#define XB_SPIN(cond, bar) do { unsigned _sp = 0; while (cond) { __builtin_amdgcn_s_sleep(1); \
    if ((++_sp & 255u) == 0u) { if (xb_ld(&(bar)[XB_TMO])) break; if (_sp > XB_SPIN_CAP) { atomicAdd(&(bar)[XB_TMO], 1u); break; } } } } while (0)

struct XcdBarrier {
    unsigned* bar; unsigned x;
    volatile LAS unsigned* st;
};

__device__ __forceinline__ XcdBarrier xcd_barrier_post(unsigned* bar, volatile LAS unsigned* st) {
    XcdBarrier b; b.bar = bar; b.x = xb_xcc_id(); b.st = st;
    if (threadIdx.x == 0) (void)xb_add(&bar[XB_XCNT(b.x)], 1u);
    return b;
}
__device__ __forceinline__ void xcd_barrier_complete(unsigned* bar, unsigned x, unsigned& nloc, unsigned& nx) {
    const unsigned G = gridDim.x * gridDim.y * gridDim.z;
    unsigned sum, cnt, mine, sp = 0u;
    for (;;) {
        sum = 0u; cnt = 0u; mine = 0u;
#pragma unroll
        for (unsigned j = 0; j < 16; ++j) { const unsigned c = xb_ld(&bar[XB_XCNT(j)]); sum += c; cnt += (c > 0u) ? 1u : 0u; mine = (j == x) ? c : mine; }
        if (sum == G) break;
        __builtin_amdgcn_s_sleep(1);
        if ((++sp & 255u) == 0u) { if (xb_ld(&bar[XB_TMO])) break; if (sp > XB_SPIN_CAP) { atomicAdd(&bar[XB_TMO], 1u); break; } }
    }
    nloc = mine > 0u ? mine : 1u; nx = cnt > 0u ? cnt : 1u;
}

__device__ __forceinline__ void xcd_barrier(const XcdBarrier& b) {
    asm volatile("s_waitcnt vmcnt(0)" ::: "memory");
    __syncthreads();
    if (threadIdx.x == 0) {
        unsigned* bar = b.bar;
        __builtin_amdgcn_s_waitcnt(0);
        unsigned nloc = b.st[0], nx = b.st[1];
        if (nloc == 0u) { xcd_barrier_complete(bar, b.x, nloc, nx); b.st[0] = nloc; b.st[1] = nx; }
        const unsigned old = xb_add(&bar[XB_XSUB(b.x)], 1u);
        const unsigned gen = old / nloc;
        if (old + 1u == (gen + 1u) * nloc) {
            __builtin_amdgcn_fence(__ATOMIC_RELEASE, "agent");
            asm volatile("s_waitcnt vmcnt(0)" ::: "memory");
            const unsigned og = xb_add(&bar[XB_TOP], 1u);
            const unsigned tg = og / nx;
            if (og + 1u == (tg + 1u) * nx) xb_add(&bar[XB_TOPGEN], 1u);
            else XB_SPIN(xb_ld(&bar[XB_TOPGEN]) == tg, bar);
            __builtin_amdgcn_fence(__ATOMIC_ACQUIRE, "agent");
            xb_add(&bar[XB_XGEN(b.x)], 1u);
            asm volatile("s_waitcnt vmcnt(0)" ::: "memory");
        } else {
            XB_SPIN(xb_ld(&bar[XB_XGEN(b.x)]) == gen, bar);
            __builtin_amdgcn_fence(__ATOMIC_ACQUIRE, "agent");
            asm volatile("s_waitcnt vmcnt(0)" ::: "memory");
        }
    }
    __syncthreads();
}
namespace att {
typedef short bf16x8 __attribute__((ext_vector_type(8)));
typedef short s16x4 __attribute__((ext_vector_type(4)));
typedef float f32x16 __attribute__((ext_vector_type(16)));
typedef float f32x4 __attribute__((ext_vector_type(4)));
typedef float f32x2 __attribute__((ext_vector_type(2)));
typedef unsigned u32x4 __attribute__((ext_vector_type(4)));
#define ATT_LAS __attribute__((address_space(3)))
#define ATT_SBAR() __builtin_amdgcn_sched_barrier(0)
__device__ __forceinline__ int crow(int r, int hi) { return (r & 3) + 8 * (r >> 2) + 4 * hi; }
__device__ __forceinline__ unsigned cvtpk(float lo, float hi) { unsigned r; asm volatile("v_cvt_pk_bf16_f32 %0, %1, %2" : "=v"(r) : "v"(lo), "v"(hi)); return r; }
__device__ __forceinline__ int v_st(int k, int c) { const int kk = (k & ~0xC) | ((k & 4) << 1) | ((k & 8) >> 1); return ((kk >> 3) * 4 + (c >> 5)) * 512 + ((kk & 7) * 32 + (c & 31)) * 2; }
__device__ __forceinline__ int v_rd_base(int lane) { return ((lane & 3) << 3) | (((lane >> 2) & 3) << 6) | (((lane >> 4) & 1) << 5) | (((lane >> 5) & 1) << 8); }
constexpr int v_rd_off(int d0, int ks, int half) { return d0 * 512 + ks * 4096 + half * 2048; }
template <int OFF> __device__ __forceinline__ s16x4 tr_read(int vb) { s16x4 r; asm volatile("ds_read_b64_tr_b16 %0, %1 offset:%2" : "=&v"(r) : "v"(vb), "i"(OFF) : "memory"); return r; }
#define ATT_PK(L, H) (att::bf16x8){L[0], L[1], L[2], L[3], H[0], H[1], H[2], H[3]}
#define ATT_PK4(P, BASE, OUT) do { unsigned a0_ = att::cvtpk(P[BASE + 0], P[BASE + 1]), a1_ = att::cvtpk(P[BASE + 2], P[BASE + 3]);   \
    unsigned b0_ = att::cvtpk(P[BASE + 4], P[BASE + 5]), b1_ = att::cvtpk(P[BASE + 6], P[BASE + 7]);                              \
    auto r0_ = __builtin_amdgcn_permlane32_swap(a0_, b0_, false, false); auto r1_ = __builtin_amdgcn_permlane32_swap(a1_, b1_, false, false); \
    att::u32x4 w_ = {r0_[0], r1_[0], r0_[1], r1_[1]}; OUT = __builtin_bit_cast(att::bf16x8, w_); } while (0)
template <int D0> __device__ __forceinline__ void pv32_one(f32x16& od, int vb, bf16x8 pa0, bf16x8 pa1) {
    const s16x4 l0 = tr_read<v_rd_off(D0, 0, 0)>(vb), h0 = tr_read<v_rd_off(D0, 0, 1)>(vb), l1 = tr_read<v_rd_off(D0, 1, 0)>(vb), h1 = tr_read<v_rd_off(D0, 1, 1)>(vb);
    asm volatile("s_waitcnt lgkmcnt(0)" ::: "memory"); ATT_SBAR();
    od = __builtin_amdgcn_mfma_f32_32x32x16_bf16(pa0, ATT_PK(l0, h0), od, 0, 0, 0);
    od = __builtin_amdgcn_mfma_f32_32x32x16_bf16(pa1, ATT_PK(l1, h1), od, 0, 0, 0);
}
constexpr float THR2 = 11.5f;

__device__ __forceinline__ void glds16(const void* gsrc, unsigned lds_dst) { unsigned keep;
    asm volatile("s_mov_b32 %0, m0\n\ts_mov_b32 m0, %2\n\ts_nop 0\n\tglobal_load_lds_dwordx4 %1, off\n\ts_mov_b32 m0, %0" : "=&s"(keep) : "v"(gsrc), "s"(lds_dst) : "memory"); }
template <int D0> __device__ __forceinline__ void pv32t_one(f32x16& od, int vb, bf16x8 pa0, bf16x8 pa1) {
    const s16x4 l0 = tr_read<v_rd_off(D0, 0, 0)>(vb), h0 = tr_read<v_rd_off(D0, 0, 1)>(vb), l1 = tr_read<v_rd_off(D0, 1, 0)>(vb), h1 = tr_read<v_rd_off(D0, 1, 1)>(vb);
    asm volatile("s_waitcnt lgkmcnt(0)" ::: "memory"); ATT_SBAR();
    od = __builtin_amdgcn_mfma_f32_32x32x16_bf16(ATT_PK(l0, h0), pa0, od, 0, 0, 0);
    od = __builtin_amdgcn_mfma_f32_32x32x16_bf16(ATT_PK(l1, h1), pa1, od, 0, 0, 0);
}
template <int D0> __device__ __forceinline__ void pv64t_one(f32x16& od, int vb, bf16x8 pa0, bf16x8 pa1, bf16x8 pa2, bf16x8 pa3) {
    const s16x4 l0 = tr_read<v_rd_off(D0, 0, 0)>(vb), h0 = tr_read<v_rd_off(D0, 0, 1)>(vb), l1 = tr_read<v_rd_off(D0, 1, 0)>(vb), h1 = tr_read<v_rd_off(D0, 1, 1)>(vb);
    const s16x4 l2 = tr_read<v_rd_off(D0, 2, 0)>(vb), h2 = tr_read<v_rd_off(D0, 2, 1)>(vb), l3 = tr_read<v_rd_off(D0, 3, 0)>(vb), h3 = tr_read<v_rd_off(D0, 3, 1)>(vb);
    asm volatile("s_waitcnt lgkmcnt(0)" ::: "memory"); ATT_SBAR();
    od = __builtin_amdgcn_mfma_f32_32x32x16_bf16(ATT_PK(l0, h0), pa0, od, 0, 0, 0);
    od = __builtin_amdgcn_mfma_f32_32x32x16_bf16(ATT_PK(l1, h1), pa1, od, 0, 0, 0);
    od = __builtin_amdgcn_mfma_f32_32x32x16_bf16(ATT_PK(l2, h2), pa2, od, 0, 0, 0);
    od = __builtin_amdgcn_mfma_f32_32x32x16_bf16(ATT_PK(l3, h3), pa3, od, 0, 0, 0);
}

template <int MODE> __device__ __forceinline__ void dilated_wave_item(const unsigned short* proj, unsigned short* part_o, float* part_ml, unsigned short* MIX, ATT_LAS unsigned char* vlds, const ATT_LAS float* tsub,
                                                  int b, int h, int dil, int res, int tq0, int branch, int lane) {
    const int r32 = lane & 31, hi = lane >> 5;
    const unsigned short* pb = proj + (size_t)b * 4096 * 12288 + h * 128;
    const size_t rstr = (size_t)dil * 12288;
    const unsigned short* qrow = pb + ((size_t)(tq0 + r32) * dil + res) * 12288 + hi * 8;
    bf16x8 qr[8];
#pragma unroll
    for (int d0 = 0; d0 < 8; ++d0) qr[d0] = *(const bf16x8*)(qrow + d0 * 16);
    float m_reg = -1e30f, l_reg = 0.f; f32x16 o[4];
#pragma unroll
    for (int d = 0; d < 4; ++d)
#pragma unroll
        for (int r = 0; r < 16; ++r) o[d][r] = 0.f;
    const int L = 4096 / dil;
    int kb_lo = 2 - (tq0 >> 5); if (kb_lo < 0) kb_lo = 0;
    int kb_hi = ((L - tq0) >> 5) + 1; if (kb_hi > 4) kb_hi = 4;
    const unsigned vl0 = (unsigned)(uintptr_t)vlds;
    const int kl = (lane & 31) >> 2, cl = (lane >> 5) * 32 + (lane & 3) * 8;
    const int krl = lane >> 4, kcl = lane & 15;
#define DL_ISSUE_K(kbx) do { const unsigned short* krow0_ = pb + ((size_t)(tq0 - 64 + 32 * (kbx)) * dil + res) * 12288 + 2048; \
        _Pragma("unroll") for (int p = 0; p < 8; ++p) { const int row = 4 * p + krl, c = kcl ^ (row & 7); \
            glds16(krow0_ + (size_t)row * rstr + c * 8, (unsigned)__builtin_amdgcn_readfirstlane(vl0 + (unsigned)p * 1024u)); } } while (0)
#define DL_ISSUE_V(kbx) do { const unsigned short* vrow0_ = pb + ((size_t)(tq0 - 64 + 32 * (kbx)) * dil + res) * 12288 + 4096; \
        _Pragma("unroll") for (int p = 0; p < 8; ++p) { const int kk = 8 * (p >> 1) + kl, k = (kk & ~0xC) | ((kk & 4) << 1) | ((kk & 8) >> 1), col = (p & 1) * 64 + cl; \
            glds16(vrow0_ + (size_t)k * rstr + col, (unsigned)__builtin_amdgcn_readfirstlane(vl0 + 8192u + (unsigned)p * 1024u)); } } while (0)
    DL_ISSUE_K(kb_lo); DL_ISSUE_V(kb_lo);
    const int vb = (int)(vl0 + 8192u) + v_rd_base(lane);
    const ATT_LAS unsigned char* krd = vlds + r32 * 256;
#pragma unroll 1
    for (int kb = kb_lo; kb <= kb_hi; ++kb) {
        asm volatile("s_waitcnt vmcnt(8)" ::: "memory");
        bf16x8 kc[8];
#pragma unroll
        for (int d0 = 0; d0 < 8; ++d0) kc[d0] = *(const ATT_LAS bf16x8*)(krd + (((2 * d0 + hi) ^ (r32 & 7)) << 4));
        asm volatile("s_waitcnt lgkmcnt(0)" ::: "memory");
        asm volatile("" : "+v"(kc[0]), "+v"(kc[1]), "+v"(kc[2]), "+v"(kc[3]), "+v"(kc[4]), "+v"(kc[5]), "+v"(kc[6]), "+v"(kc[7]));
        if (kb < kb_hi) DL_ISSUE_K(kb + 1);
        const ATT_LAS float* tb = tsub + (32 - r32 + 4 * hi + 32 * kb);
        f32x16 p;
#pragma unroll
        for (int r = 0; r < 16; ++r) p[r] = tb[(r & 3) + 8 * (r >> 2)];
#pragma unroll
        for (int d0 = 0; d0 < 8; ++d0) p = __builtin_amdgcn_mfma_f32_32x32x16_bf16(kc[d0], qr[d0], p, 0, 0, 0);
        float pmax = p[0];
#pragma unroll
        for (int r = 1; r < 16; ++r) pmax = fmaxf(pmax, p[r]);
        { auto rr = __builtin_amdgcn_permlane32_swap(__float_as_uint(pmax), __float_as_uint(pmax), false, false); pmax = fmaxf(__uint_as_float(rr[0]), __uint_as_float(rr[1])); }
        float alpha = 1.f;
        if (!__all(pmax - m_reg <= THR2)) { const float mn = fmaxf(m_reg, pmax); alpha = __builtin_amdgcn_exp2f(m_reg - mn); m_reg = mn; }
        float ps = 0.f;
#pragma unroll
        for (int r = 0; r < 16; ++r) { p[r] = __builtin_amdgcn_exp2f(p[r] - m_reg); ps += p[r]; }
        { auto rr = __builtin_amdgcn_permlane32_swap(__float_as_uint(ps), __float_as_uint(ps), false, false); ps = __uint_as_float(rr[0]) + __uint_as_float(rr[1]); }
        l_reg = l_reg * alpha + ps;
        bf16x8 pa0, pa1; ATT_PK4(p, 0, pa0); ATT_PK4(p, 8, pa1);
        if (__any(alpha < 1.f)) {
#pragma unroll
            for (int d = 0; d < 4; ++d)
#pragma unroll
                for (int r = 0; r < 16; ++r) o[d][r] *= alpha;
        }
        if (kb < kb_hi) asm volatile("s_waitcnt vmcnt(8)" ::: "memory"); else asm volatile("s_waitcnt vmcnt(0)" ::: "memory");
        ATT_SBAR();
        pv32t_one<0>(o[0], vb, pa0, pa1); pv32t_one<1>(o[1], vb, pa0, pa1); pv32t_one<2>(o[2], vb, pa0, pa1); pv32t_one<3>(o[3], vb, pa0, pa1);
        if (kb < kb_hi) DL_ISSUE_V(kb + 1);
    }
#undef DL_ISSUE_K
#undef DL_ISSUE_V
    const size_t rec = (((size_t)b * 4096 + (size_t)(tq0 + r32) * dil + res) * 16 + h) * 2;
    if (MODE == 0) {
        const float inv = 1.f / l_reg;
        if (hi == 0) *(f32x2*)(part_ml + (rec + branch) * 2) = (f32x2){m_reg, l_reg};
        unsigned short* op = part_o + (rec + branch) * 128 + 4 * hi;
#pragma unroll
        for (int d0 = 0; d0 < 4; ++d0)
#pragma unroll
            for (int g = 0; g < 4; ++g) { f32x2 w; w[0] = __uint_as_float(cvtpk(o[d0][4 * g] * inv, o[d0][4 * g + 1] * inv)); w[1] = __uint_as_float(cvtpk(o[d0][4 * g + 2] * inv, o[d0][4 * g + 3] * inv));
                *(f32x2*)(op + 32 * d0 + 8 * g) = w; }
    } else {
        const f32x4 ml = *(const f32x4*)(part_ml + rec * 2);
        const float mx = fmaxf(fmaxf(m_reg, ml[0]), ml[2]);
        const float w1 = __builtin_amdgcn_exp2f(m_reg - mx), wA = __builtin_amdgcn_exp2f(ml[0] - mx) * ml[1], wB = __builtin_amdgcn_exp2f(ml[2] - mx) * ml[3];
        const float inv = 1.f / (w1 * l_reg + wA + wB), s1 = w1 * inv, sA = wA * inv, sB = wB * inv;
        const unsigned short* pa_ = part_o + rec * 128 + 4 * hi; const unsigned short* pb_ = pa_ + 128;
        const int orow = b * 4096 + (tq0 + r32) * dil + res, ocol = h * 128 + 4 * hi;
#pragma unroll
        for (int d0 = 0; d0 < 4; ++d0)
#pragma unroll
            for (int g = 0; g < 4; ++g) { const f32x2 ua = *(const f32x2*)(pa_ + 32 * d0 + 8 * g), ub = *(const f32x2*)(pb_ + 32 * d0 + 8 * g);
                const unsigned a0 = __float_as_uint(ua[0]), a1 = __float_as_uint(ua[1]), b0 = __float_as_uint(ub[0]), b1 = __float_as_uint(ub[1]);
                const float y0 = o[d0][4 * g] * s1 + __uint_as_float(a0 << 16) * sA + __uint_as_float(b0 << 16) * sB, y1 = o[d0][4 * g + 1] * s1 + __uint_as_float(a0 & 0xffff0000u) * sA + __uint_as_float(b0 & 0xffff0000u) * sB;
                const float y2 = o[d0][4 * g + 2] * s1 + __uint_as_float(a1 << 16) * sA + __uint_as_float(b1 << 16) * sB, y3 = o[d0][4 * g + 3] * s1 + __uint_as_float(a1 & 0xffff0000u) * sA + __uint_as_float(b1 & 0xffff0000u) * sB;
                f32x2 w; w[0] = __uint_as_float(cvtpk(y0, y1)); w[1] = __uint_as_float(cvtpk(y2, y3)); *(f32x2*)(MIX + pg8::tiled_elem(orow, ocol + 32 * d0 + 8 * g, 64)) = w; }
    }
}

#define ATT_VRD8(D0, L, H) do { L[0] = tr_read<v_rd_off(D0, 0, 0)>(vb); H[0] = tr_read<v_rd_off(D0, 0, 1)>(vb); L[1] = tr_read<v_rd_off(D0, 1, 0)>(vb); H[1] = tr_read<v_rd_off(D0, 1, 1)>(vb); \
        L[2] = tr_read<v_rd_off(D0, 2, 0)>(vb); H[2] = tr_read<v_rd_off(D0, 2, 1)>(vb); L[3] = tr_read<v_rd_off(D0, 3, 0)>(vb); H[3] = tr_read<v_rd_off(D0, 3, 1)>(vb); } while (0)
#define ATT_PV4(OD, L, H) do { OD = __builtin_amdgcn_mfma_f32_32x32x16_bf16(ATT_PK(L[0], H[0]), pa0, OD, 0, 0, 0); OD = __builtin_amdgcn_mfma_f32_32x32x16_bf16(ATT_PK(L[1], H[1]), pa1, OD, 0, 0, 0); \
        OD = __builtin_amdgcn_mfma_f32_32x32x16_bf16(ATT_PK(L[2], H[2]), pa2, OD, 0, 0, 0); OD = __builtin_amdgcn_mfma_f32_32x32x16_bf16(ATT_PK(L[3], H[3]), pa3, OD, 0, 0, 0); } while (0)
template <int GV> __device__ __forceinline__ void pv64t_all(f32x16 (&o)[4], int vb, bf16x8 pa0, bf16x8 pa1, bf16x8 pa2, bf16x8 pa3) {
    s16x4 la[4], ha[4], lb[4], hb[4];
    if (GV == 7) {
#pragma unroll
        for (int i = 0; i < 4; ++i) { la[i] = (s16x4){1, 2, 3, 4}; ha[i] = (s16x4){5, 6, 7, 8}; lb[i] = la[i]; hb[i] = ha[i]; asm volatile("" : "+v"(la[i]), "+v"(ha[i]), "+v"(lb[i]), "+v"(hb[i])); }
        ATT_PV4(o[0], la, ha); ATT_PV4(o[1], lb, hb); ATT_PV4(o[2], la, ha); ATT_PV4(o[3], lb, hb); return; }
    if (GV == 8) {
        ATT_VRD8(0, la, ha); ATT_VRD8(1, lb, hb); asm volatile("s_waitcnt lgkmcnt(8)" ::: "memory");
#pragma unroll
        for (int i = 0; i < 4; ++i) asm volatile("" :: "v"(la[i]), "v"(ha[i]));
        ATT_VRD8(2, la, ha); asm volatile("s_waitcnt lgkmcnt(8)" ::: "memory");
#pragma unroll
        for (int i = 0; i < 4; ++i) asm volatile("" :: "v"(lb[i]), "v"(hb[i]));
        ATT_VRD8(3, lb, hb); asm volatile("s_waitcnt lgkmcnt(0)" ::: "memory");
#pragma unroll
        for (int i = 0; i < 4; ++i) asm volatile("" :: "v"(la[i]), "v"(ha[i]), "v"(lb[i]), "v"(hb[i]));
        o[0][0] += __builtin_bit_cast(f32x4, pa0)[0] + __builtin_bit_cast(f32x4, pa1)[1] + __builtin_bit_cast(f32x4, pa2)[2] + __builtin_bit_cast(f32x4, pa3)[3]; return; }
    ATT_VRD8(0, la, ha); ATT_VRD8(1, lb, hb);
    asm volatile("s_waitcnt lgkmcnt(8)" ::: "memory"); ATT_SBAR(); ATT_PV4(o[0], la, ha); ATT_SBAR();
    ATT_VRD8(2, la, ha);
    asm volatile("s_waitcnt lgkmcnt(8)" ::: "memory"); ATT_SBAR(); ATT_PV4(o[1], lb, hb); ATT_SBAR();
    ATT_VRD8(3, lb, hb);
    asm volatile("s_waitcnt lgkmcnt(8)" ::: "memory"); ATT_SBAR(); ATT_PV4(o[2], la, ha); ATT_SBAR();
    asm volatile("s_waitcnt lgkmcnt(0)" ::: "memory"); ATT_SBAR(); ATT_PV4(o[3], lb, hb);
}

constexpr int DF_TB = 131072, DF_TBN = 1312, DF_TB0 = 656, DF_XROW = 528;
#define ATT_WAIT_BAR() asm volatile("s_waitcnt vmcnt(0) lgkmcnt(0)\n\ts_barrier" ::: "memory")
#define ATT_WAIT4_BAR() asm volatile("s_waitcnt vmcnt(4) lgkmcnt(0)\n\ts_barrier" ::: "memory")
template <int GV> __device__ __forceinline__ void df_qkt(f32x16& p0, f32x16& p1, const ATT_LAS unsigned char* ks, const bf16x8 (&qr)[4], const ATT_LAS float* tb, bool lookup, const f32x16& cinit, float m_reg, int map, int r32, int hi) {
    const int sw = r32 & 7; const ATT_LAS unsigned char* kr = ks + r32 * 256 + map * 128;
    bf16x8 kf0[4], kf1[4];
#pragma unroll
    for (int d0 = 0; d0 < 4; ++d0) { const int off = ((2 * d0 + hi) ^ sw) << 4;
        if (GV == 7) { kf0[d0] = qr[d0]; kf1[d0] = qr[3 - d0]; asm volatile("" : "+v"(kf0[d0]), "+v"(kf1[d0])); } else { kf0[d0] = *(const ATT_LAS bf16x8*)(kr + off); kf1[d0] = *(const ATT_LAS bf16x8*)(kr + 8192 + off); } }
    if (GV == 8) {
#pragma unroll
        for (int d0 = 0; d0 < 4; ++d0) asm volatile("" :: "v"(kf0[d0]), "v"(kf1[d0]));
        p0 = cinit; p1 = cinit; return; }
    if (lookup) {
#pragma unroll
        for (int r = 0; r < 16; ++r) { p0[r] = tb[(r & 3) + 8 * (r >> 2)] - m_reg; p1[r] = tb[32 + (r & 3) + 8 * (r >> 2)] - m_reg; }
        p0 = __builtin_amdgcn_mfma_f32_32x32x16_bf16(kf0[0], qr[0], p0, 0, 0, 0); p1 = __builtin_amdgcn_mfma_f32_32x32x16_bf16(kf1[0], qr[0], p1, 0, 0, 0);
    } else {
        p0 = __builtin_amdgcn_mfma_f32_32x32x16_bf16(kf0[0], qr[0], cinit, 0, 0, 0); p1 = __builtin_amdgcn_mfma_f32_32x32x16_bf16(kf1[0], qr[0], cinit, 0, 0, 0);
    }
#pragma unroll
    for (int d0 = 1; d0 < 4; ++d0) { p0 = __builtin_amdgcn_mfma_f32_32x32x16_bf16(kf0[d0], qr[d0], p0, 0, 0, 0); p1 = __builtin_amdgcn_mfma_f32_32x32x16_bf16(kf1[d0], qr[d0], p1, 0, 0, 0); }
}
template <bool FIRST> __device__ __forceinline__ void df_partial(f32x16& p0, f32x16& p1, float& m_reg, float& alpha, f32x16& cinit) {
    float pmax = p0[0];
#pragma unroll
    for (int r = 1; r < 16; ++r) pmax = fmaxf(pmax, p0[r]);
#pragma unroll
    for (int r = 0; r < 16; ++r) pmax = fmaxf(pmax, p1[r]);
    { auto rr = __builtin_amdgcn_permlane32_swap(__float_as_uint(pmax), __float_as_uint(pmax), false, false); pmax = fmaxf(__uint_as_float(rr[0]), __uint_as_float(rr[1])); }
    alpha = 1.f;
    if (FIRST || !__builtin_expect(__all(pmax <= THR2), 1)) { const float dl = FIRST ? pmax : fmaxf(pmax, 0.f); m_reg += dl; alpha = FIRST ? 1.f : __builtin_amdgcn_exp2f(-dl);
#pragma unroll
        for (int r = 0; r < 16; ++r) { p0[r] -= dl; p1[r] -= dl; cinit[r] -= dl; } }
#pragma unroll
    for (int r = 0; r < 16; ++r) p0[r] = __builtin_amdgcn_exp2f(p0[r]);
}
__device__ __forceinline__ void df_finish(f32x16& p0, f32x16& p1, float alpha, float& l_reg, bf16x8& pa0, bf16x8& pa1, bf16x8& pa2, bf16x8& pa3) {
#pragma unroll
    for (int r = 0; r < 16; ++r) p1[r] = __builtin_amdgcn_exp2f(p1[r]);
    float ps = 0.f;
#pragma unroll
    for (int r = 0; r < 16; ++r) ps += p0[r];
#pragma unroll
    for (int r = 0; r < 16; ++r) ps += p1[r];
    { auto rr = __builtin_amdgcn_permlane32_swap(__float_as_uint(ps), __float_as_uint(ps), false, false); ps = __uint_as_float(rr[0]) + __uint_as_float(rr[1]); }
    l_reg = l_reg * alpha + ps;
    ATT_PK4(p0, 0, pa0); ATT_PK4(p0, 8, pa1); ATT_PK4(p1, 0, pa2); ATT_PK4(p1, 8, pa3);
}
struct NoHook { __device__ __forceinline__ void step(int) {} __device__ __forceinline__ void pre(int) {} };
template <int GV, class HK> __device__ __forceinline__ void diff_unit(const unsigned short* proj, unsigned short* MIX, const float* BIAS, const float* gsub, float lam, float post, ATT_LAS unsigned char* lds, int b, int h, int qb, int tid, HK& hk) {
    const int lane = tid & 63, wid = __builtin_amdgcn_readfirstlane(tid >> 6), r32 = lane & 31, hi = lane >> 5, rg = wid & 3, map = wid >> 2;
    const unsigned lds0 = (unsigned)(uintptr_t)lds;
    ATT_LAS float* tbl = (ATT_LAS float*)(lds + DF_TB);
    const int qw = qb * 128 + rg * 32;
    const unsigned short* pb = proj + (size_t)b * 4096 * 12288 + h * 128;
    const float* bh = BIAS + (16 + h) * 8192 + 4095;
    ATT_WAIT_BAR();
    for (int i = tid; i < DF_TBN; i += 512) tbl[i] = bh[i - DF_TB0];
    const float cpos = bh[600], cneg = bh[-600];
    bf16x8 qr[4];
    { const unsigned short* qrow = pb + (size_t)(qw + r32) * 12288 + 6144 + map * 64 + hi * 8;
#pragma unroll
      for (int d0 = 0; d0 < 4; ++d0) qr[d0] = *(const bf16x8*)(qrow + d0 * 16); }
    unsigned koff[2], voff[2];
#pragma unroll
    for (int e = 0; e < 2; ++e) { const int p = 2 * wid + e; { const int row = 4 * p + (lane >> 4), c = (lane & 15) ^ (row & 7); koff[e] = (unsigned)(row * 24576 + c * 16); }
        { const int j = 64 * p + lane, st = j >> 5, kk = (st >> 2) * 8 + ((j & 31) >> 2), col = (st & 3) * 32 + (j & 3) * 8, k = (kk & ~0xC) | ((kk & 4) << 1) | ((kk & 8) >> 1); voff[e] = (unsigned)(k * 24576 + col * 2); } }
    const char* kbase = (const char*)(pb + 8192); const char* vbase = (const char*)(pb + 10240);
#define DF_DMA(t, slot) do { const size_t tb_ = (size_t)(t) * (64 * 24576); const unsigned sl_ = lds0 + (unsigned)(slot) * 32768u + (unsigned)(2 * wid) * 1024u; \
        glds16(kbase + tb_ + koff[0], (unsigned)__builtin_amdgcn_readfirstlane(sl_)); glds16(kbase + tb_ + koff[1], (unsigned)__builtin_amdgcn_readfirstlane(sl_ + 1024u)); \
        glds16(vbase + tb_ + voff[0], (unsigned)__builtin_amdgcn_readfirstlane(sl_ + 16384u)); glds16(vbase + tb_ + voff[1], (unsigned)__builtin_amdgcn_readfirstlane(sl_ + 16384u + 1024u)); } while (0)
    if (GV < 5) { DF_DMA(0, 0); DF_DMA(1, 1); }
    float m_reg = 0.f, l_reg = 0.f, cbk = 0.f; f32x16 o[4], cinit;
#pragma unroll
    for (int d = 0; d < 4; ++d)
#pragma unroll
        for (int r = 0; r < 16; ++r) o[d][r] = 0.f;
#pragma unroll
    for (int r = 0; r < 16; ++r) cinit[r] = 0.f;
    f32x16 pA0, pA1, pB0, pB1; float alA = 1.f, alB = 1.f; bf16x8 pa0, pa1, pa2, pa3;
    const int vrb = (int)(lds0 + 16384u) + v_rd_base(lane);
#define DF_MODE(j, LK, CB, TB) const int k0_ = (j) * 64, rmin_ = k0_ - (qw + 31), rmax_ = k0_ + 63 - qw; const bool LK = !(rmin_ >= 559 || rmax_ <= -559); \
        const float CB = LK ? 0.f : (rmin_ >= 559 ? cpos : cneg); const ATT_LAS float* TB = tbl + (LK ? (k0_ - qw - r32 + 4 * hi + DF_TB0) : 0); \
        if (!LK && CB != cbk) { cbk = CB; _Pragma("unroll") for (int r_ = 0; r_ < 16; ++r_) cinit[r_] = CB - m_reg; }
#define DF_RESC(al) do { if (__any((al) < 1.f)) { _Pragma("unroll") for (int d_ = 0; d_ < 4; ++d_) _Pragma("unroll") for (int r_ = 0; r_ < 16; ++r_) o[d_][r_] *= (al); } } while (0)
#define DF_STEP(PC0, PC1, ALC, PP0, PP1, ALP, j) do { \
        if (GV < 5 && (j) + 2 < 64) DF_DMA((j) + 2, ((j) + 2) & 3); \
        { DF_MODE(j, lk_, cb_, tb_); ATT_SBAR(); \
          if (GV != 4) df_qkt<GV>(PC0, PC1, lds + ((j) & 3) * 32768, qr, tb_, lk_, cinit, m_reg, map, r32, hi); else { PC0 = cinit; PC1 = cinit; } \
          if (GV != 2) df_finish(PP0, PP1, ALP, l_reg, pa0, pa1, pa2, pa3); else { pa0 = __builtin_bit_cast(bf16x8, (f32x4){PP0[0], PP0[1], PP0[2], PP0[3]}); pa1 = __builtin_bit_cast(bf16x8, (f32x4){PP0[4], PP0[5], PP0[6], PP0[7]}); pa2 = __builtin_bit_cast(bf16x8, (f32x4){PP1[0], PP1[1], PP1[2], PP1[3]}); pa3 = __builtin_bit_cast(bf16x8, (f32x4){PP1[4], PP1[5], PP1[6], PP1[7]}); l_reg += PP0[8] + PP1[8]; } ATT_SBAR(); \
          if (GV != 3) { const int vb_ = vrb + (((j) - 1) & 3) * 32768; \
            pv64t_all<GV>(o, vb_, pa0, pa1, pa2, pa3); } \
          else { o[0][0] += __builtin_bit_cast(f32x4, pa0)[0] + __builtin_bit_cast(f32x4, pa1)[1] + __builtin_bit_cast(f32x4, pa2)[2] + __builtin_bit_cast(f32x4, pa3)[3]; } \
          if (GV != 2) df_partial<false>(PC0, PC1, m_reg, ALC, cinit); else ALC = 1.f; } \
        DF_RESC(ALC); \
        if (GV >= 6) { asm volatile("s_waitcnt lgkmcnt(0)" ::: "memory"); } else if (GV == 5) { asm volatile("s_waitcnt lgkmcnt(0)\n\ts_barrier" ::: "memory"); } else if ((j) + 2 < 64) { asm volatile("s_waitcnt vmcnt(4) lgkmcnt(0)" ::: "memory"); if (GV == 0) hk.pre(lane); asm volatile("s_barrier" ::: "memory"); } else { asm volatile("s_waitcnt vmcnt(0) lgkmcnt(0)" ::: "memory"); if (GV == 0) hk.pre(lane); asm volatile("s_barrier" ::: "memory"); } \
        if (GV == 0) hk.step(lane); } while (0)
    ATT_WAIT4_BAR();
    { if (GV < 5) DF_DMA(2, 2); DF_MODE(0, lk_, cb_, tb_); df_qkt<GV>(pA0, pA1, lds, qr, tb_, lk_, cinit, m_reg, map, r32, hi); df_partial<true>(pA0, pA1, m_reg, alA, cinit); ATT_WAIT4_BAR(); }
#pragma unroll 1
    for (int j = 1; j < 63; j += 2) { DF_STEP(pB0, pB1, alB, pA0, pA1, alA, j); DF_STEP(pA0, pA1, alA, pB0, pB1, alB, j + 1); }
    DF_STEP(pB0, pB1, alB, pA0, pA1, alA, 63);
    df_finish(pB0, pB1, alB, l_reg, pa0, pa1, pa2, pa3); ATT_SBAR();
    { const int vb_ = vrb + (63 & 3) * 32768;
      pv64t_all<GV>(o, vb_, pa0, pa1, pa2, pa3); }
#undef DF_STEP
#undef DF_RESC
#undef DF_MODE
#undef DF_DMA
    ATT_WAIT_BAR();
    ATT_LAS unsigned char* xr = lds + rg * (32 * DF_XROW) + r32 * DF_XROW + hi * 16;
    if (map == 1) { const float s1 = lam / l_reg;
#pragma unroll
        for (int d0 = 0; d0 < 4; ++d0)
#pragma unroll
            for (int g = 0; g < 4; ++g) *(ATT_LAS f32x4*)(xr + (32 * d0 + 8 * g) * 4) = (f32x4){o[d0][4 * g] * s1, o[d0][4 * g + 1] * s1, o[d0][4 * g + 2] * s1, o[d0][4 * g + 3] * s1}; }
    ATT_WAIT_BAR();
    if (map == 0 && (GV == 0 || l_reg == -123.456f)) { const float s0 = 1.f / l_reg; float ss = 0.f;
#pragma unroll
        for (int d0 = 0; d0 < 4; ++d0)
#pragma unroll
            for (int g = 0; g < 4; ++g) { const f32x4 y = *(const ATT_LAS f32x4*)(xr + (32 * d0 + 8 * g) * 4);
#pragma unroll
                for (int i = 0; i < 4; ++i) { const float x = o[d0][4 * g + i] * s0 - y[i]; o[d0][4 * g + i] = x; ss += x * x; } }
        { auto rr = __builtin_amdgcn_permlane32_swap(__float_as_uint(ss), __float_as_uint(ss), false, false); ss = __uint_as_float(rr[0]) + __uint_as_float(rr[1]); }
        const float rs = post / sqrtf(ss * (1.f / 128.f) + 1e-5f);
        const int orow = b * 4096 + qw + r32, ocol = 2048 + h * 128 + 4 * hi; const float* gp = gsub + 4 * hi;
#pragma unroll
        for (int d0 = 0; d0 < 4; ++d0)
#pragma unroll
            for (int g = 0; g < 4; ++g) { const f32x4 gg = *(const f32x4*)(gp + 32 * d0 + 8 * g);
                f32x2 w; { const unsigned lo = cvtpk(o[d0][4 * g] * rs * gg[0], o[d0][4 * g + 1] * rs * gg[1]), hi2 = cvtpk(o[d0][4 * g + 2] * rs * gg[2], o[d0][4 * g + 3] * rs * gg[3]); w[0] = __uint_as_float(lo); w[1] = __uint_as_float(hi2); }
                *(f32x2*)(MIX + pg8::tiled_elem(orow, ocol + 32 * d0 + 8 * g, 64)) = w; } }
}
}

constexpr int NWAVES = 8;
#ifndef MK_ONE_LAUNCH
#define MK_ONE_LAUNCH 1
#endif

#ifndef PROBE_DUP
#define PROBE_DUP 0
#endif
#define DUPN(k) ((PROBE_DUP == (k)) ? 2 : 1)
#ifndef PROBE_CLK
#define PROBE_CLK 0
#endif
#ifndef PROBE_GG
#define PROBE_GG 0
#endif
#ifndef PROBE_BAR
#define PROBE_BAR 0
#endif
#ifndef PROBE_THIN
#define PROBE_THIN 0
#endif
#ifndef PROBE_GV
#define PROBE_CV 0
#define PROBE_GV 0
#endif

constexpr int BATCH = 2, SEQ = 4096, DM = 4096, DEPTH = 2, NHA = 16, NHD = 16, HD = 128, DQ = 64;
constexpr int M = BATCH * SEQ;
constexpr int NPROJ = 12288, DFF = 16384, DILW = 2048;
constexpr int COL_QA = 0, COL_KA = 2048, COL_VA = 4096, COL_QD = 6144, COL_KD = 8192, COL_VD = 10240;
constexpr float RMS_EPS = 1e-6f, SUBLN_EPS = 1e-5f, LOG2E = 1.4426950408889634f;
constexpr float SC_A = 0.08838834764831845f * LOG2E;
constexpr float SC_D = 0.125f * LOG2E;
constexpr int NPART = 64;
constexpr int N_PHASES = 1 + 7 * DEPTH;

constexpr size_t MiB = 1u << 20;
constexpr size_t WS_CTL = 0, CTL_ZERO_BYTES = 1 * MiB;
constexpr size_t WS_BIAS = 1 * MiB;
constexpr size_t WS_PART = 2 * MiB;
constexpr size_t WS_WIN = 4 * MiB;
constexpr size_t WS_WOUT = WS_WIN + 192 * MiB;
constexpr size_t WS_WUP = WS_WOUT + 64 * MiB;
constexpr size_t WS_WDN = WS_WUP + 256 * MiB;
constexpr size_t WS_H = WS_WDN + 256 * MiB;
constexpr size_t WS_PROJ = WS_H + 64 * MiB;
constexpr size_t WS_MIX = WS_PROJ + 192 * MiB;
constexpr size_t WS_U = WS_MIX + 64 * MiB;
constexpr size_t WS_Y = WS_U + 256 * MiB;
constexpr size_t WS_END = WS_Y + 128 * MiB;
constexpr int CW_TMO = 0, CW_CODE = 1;
constexpr int CW_LAM = 16;
constexpr int CW_BAR = 4096;

constexpr int RING_OFF = 0, RING_BYTES = 131072;
constexpr int LDSCTL_OFF = 143360, MISC_OFF = LDSCTL_OFF + 320;
constexpr int CONV_OFF = 147456;
constexpr int LDS_BYTES = 163840;
static_assert(MISC_OFF + 128 <= LDS_BYTES, "LDS map");

struct Frame {
    LAS unsigned char* lds;
    volatile LAS unsigned* MISC;
    gu32* ctl;
    int tid, lane, wave;
    int vcu, G;
    const float* x; float* out;
    const float *rel_bias, *g_pre_mix, *w_in, *lq1, *lk1, *lq2, *lk2, *g_subln, *w_out, *g_post_mix, *g_pre_mlp, *w_up, *w_down, *g_post_mlp;
    bf16 *Win_t, *Wout_t, *Wup_t, *Wdn_t;
    bf16 *H, *PROJ, *MIX, *U;
    bf16* Y; float *PART, *BIAS;
};

__device__ __forceinline__ float wave_sum(float v) {
#pragma unroll
    for (int o = 1; o < 64; o <<= 1) v += __shfl_xor(v, o);
    return v;
}
__device__ __forceinline__ int opaque_tid() { int t = threadIdx.x; asm volatile("" : "+v"(t)); return t; }
__device__ __forceinline__ float bflo(unsigned u) { return __uint_as_float(u << 16); }
__device__ __forceinline__ float bfhi(unsigned u) { return __uint_as_float(u & 0xffff0000u); }

__device__ __forceinline__ void p0_transpose_item(const float* W, int K, int N, bf16* WT, LAS float* scr, int item, int lane) {
    const int nblk = N / 32, kb = item / nblk, nb = item % nblk, k0 = 64 * kb, n0 = 32 * nb;
    const GAS float* src = (const GAS float*)W + (size_t)(k0 + (lane >> 5)) * N + n0 + (lane & 31);
    float v[32];
#pragma unroll
    for (int i = 0; i < 32; ++i) v[i] = src[(size_t)(2 * i) * N];
#pragma unroll
    for (int i = 0; i < 32; ++i) scr[(2 * i + (lane >> 5)) * 33 + (lane & 31)] = v[i];
    LDS_WAIT(); asm volatile("" ::: "memory");
    const int c = lane & 7;
#pragma unroll
    for (int j = 0; j < 4; ++j) { const int n = (lane >> 3) + 8 * j; const LAS float* s = scr + (8 * c) * 33 + n;
        v4u o; o.x = pk2(s[0 * 33], s[1 * 33]); o.y = pk2(s[2 * 33], s[3 * 33]); o.z = pk2(s[4 * 33], s[5 * 33]); o.w = pk2(s[6 * 33], s[7 * 33]);
        *(GAS v4u*)(WT + pg8::tiled_w_elem(n0 + n, k0 + 8 * c, K / 64)) = o; }
    LDS_WAIT(); asm volatile("" ::: "memory");
}
__device__ __forceinline__ int t5_bucket(int rel) {
    const int n = rel < 0 ? -rel : rel; int bk;
    if (n < 8) bk = n; else if (n < 15) bk = 8; else if (n < 27) bk = 9; else if (n < 50) bk = 10; else if (n < 91) bk = 11; else if (n < 166) bk = 12; else if (n < 305) bk = 13; else if (n < 559) bk = 14; else bk = 15;
    return bk + (rel > 0 ? 16 : 0);
}
__device__ __forceinline__ void rms_row_to_bf16(const float* xrow, const float* g, bf16* H, int row, int lane) {
    const GAS f32x4* xr = (const GAS f32x4*)xrow + lane; const GAS f32x4* gr = (const GAS f32x4*)g + lane;
    f32x4 v[16]; float s = 0.f;
#pragma unroll
    for (int j = 0; j < 16; ++j) { v[j] = xr[64 * j]; s += (v[j].x * v[j].x + v[j].y * v[j].y) + (v[j].z * v[j].z + v[j].w * v[j].w); }
    const float rstd = 1.f / sqrtf(wave_sum(s) * (1.f / DM) + RMS_EPS);
#pragma unroll
    for (int j = 0; j < 16; ++j) { const f32x4 gg = gr[64 * j];
        *(GAS unsigned long long*)(H + pg8::tiled_elem(row, 4 * (64 * j + lane), DM / 64)) = (unsigned long long)pk2(v[j].x * rstd * gg.x, v[j].y * rstd * gg.y) | ((unsigned long long)pk2(v[j].z * rstd * gg.z, v[j].w * rstd * gg.w) << 32); }
}
__device__ __forceinline__ void p0_prologue(Frame& F) {
    const int tid_ = opaque_tid(), lane_ = tid_ & 63;
    LAS float* scr = (LAS float*)(F.lds + RING_OFF + F.wave * 16384);
    const int gw = F.vcu * NWAVES + F.wave, NGW = F.G * NWAVES;
    constexpr int I_IN = (DM / 64) * (NPROJ / 32);
    for (int it = gw; it < I_IN; it += NGW) p0_transpose_item(F.w_in, DM, NPROJ, F.Win_t, scr, it, lane_);
#if PROBE_CV
    { constexpr int I_OUT = (DM / 64) * (DM / 32), I_UP = (DM / 64) * (DFF / 32), I_DN = (DFF / 64) * (DM / 32), I_L = I_IN + I_OUT + I_UP + I_DN, NITEMS = DEPTH * I_L;
      for (int it = gw; it < NITEMS; it += NGW) { const int l = it / I_L; int r = it % I_L;
        if (r < I_IN) { if (l > 0) p0_transpose_item(F.w_in + (size_t)l * DM * NPROJ, DM, NPROJ, F.Win_t + (size_t)l * NPROJ * DM, scr, r, lane_); continue; } r -= I_IN;
        if (r < I_OUT) { p0_transpose_item(F.w_out + (size_t)l * DM * DM, DM, DM, F.Wout_t + (size_t)l * DM * DM, scr, r, lane_); continue; } r -= I_OUT;
        if (r < I_UP) { p0_transpose_item(F.w_up + (size_t)l * DM * DFF, DM, DFF, F.Wup_t + (size_t)l * DFF * DM, scr, r, lane_); continue; } r -= I_UP;
        p0_transpose_item(F.w_down + (size_t)l * DFF * DM, DFF, DM, F.Wdn_t + (size_t)l * DM * DFF, scr, r, lane_); } }
#endif
    for (int m = gw; m < M; m += NGW) rms_row_to_bf16(F.x + (size_t)m * DM, F.g_pre_mix, F.H, m, lane_);
    for (int i = blockIdx.x * (NWAVES * 64) + tid_; i < 32 * 8192; i += F.G * NWAVES * 64) { const int h = i >> 13, rel = (i & 8191) - 4095;
        F.BIAS[i] = (rel <= 4095) ? F.rel_bias[t5_bucket(rel) * 32 + h] * LOG2E : 0.f; }
    if (blockIdx.x == 0 && tid_ < DEPTH) { const int l = tid_; float a = 0.f, b = 0.f;
        for (int i = 0; i < DQ; ++i) { a += F.lq1[l * DQ + i] * F.lk1[l * DQ + i]; b += F.lq2[l * DQ + i] * F.lk2[l * DQ + i]; }
        const float li = 0.8f - 0.6f * expf(-0.3f * (float)l);
        F.ctl[CW_LAM + l] = __float_as_uint(expf(a) - expf(b) + li); }
}
template <bool XIN_BF, bool XOUT_BF> __device__ __forceinline__ void thin_phase(Frame& F, const void* xin, void* xout, const float* g_post, const float* g_next, bool want_h) {
    const int lane_ = opaque_tid() & 63;
    const int gw = F.vcu * NWAVES + F.wave, NGW = F.G * NWAVES;
    for (int row = gw; row < M; row += NGW) {
        const float ssq = wave_sum(F.PART[(size_t)row * NPART + lane_]);
        const float rstd = 1.f / sqrtf(ssq * (1.f / DM) + RMS_EPS);
        const GAS unsigned long long* yr = (const GAS unsigned long long*)(F.Y + (size_t)row * DM) + lane_;
        const GAS f32x4* xr = (const GAS f32x4*)((const float*)xin + (size_t)row * DM) + lane_; const GAS unsigned long long* xrb = (const GAS unsigned long long*)((const bf16*)xin + (size_t)row * DM) + lane_;
        const GAS f32x4* gp = (const GAS f32x4*)g_post + lane_;
        GAS f32x4* xo = (GAS f32x4*)((float*)xout + (size_t)row * DM) + lane_; GAS unsigned long long* xob = (GAS unsigned long long*)((bf16*)xout + (size_t)row * DM) + lane_;
        f32x4 v[16]; float s = 0.f;
#pragma unroll
        for (int j = 0; j < 16; ++j) { const unsigned long long yb = yr[64 * j]; const f32x4 y = {bflo((unsigned)yb), bfhi((unsigned)yb), bflo((unsigned)(yb >> 32)), bfhi((unsigned)(yb >> 32))}; const f32x4 g = gp[64 * j];
            f32x4 xx; if (XIN_BF) { const unsigned long long xb = xrb[64 * j]; xx = (f32x4){bflo((unsigned)xb), bfhi((unsigned)xb), bflo((unsigned)(xb >> 32)), bfhi((unsigned)(xb >> 32))}; } else xx = xr[64 * j];
            v[j] = xx + y * rstd * g;
            if (XOUT_BF) xob[64 * j] = (unsigned long long)pk2(v[j].x, v[j].y) | ((unsigned long long)pk2(v[j].z, v[j].w) << 32); else xo[64 * j] = v[j];
            s += (v[j].x * v[j].x + v[j].y * v[j].y) + (v[j].z * v[j].z + v[j].w * v[j].w); }
        if (want_h) {
            const float r2 = 1.f / sqrtf(wave_sum(s) * (1.f / DM) + RMS_EPS);
            const GAS f32x4* gn = (const GAS f32x4*)g_next + lane_;
#pragma unroll
            for (int j = 0; j < 16; ++j) { const f32x4 gg = gn[64 * j];
                *(GAS unsigned long long*)(F.H + pg8::tiled_elem(row, 4 * (64 * j + lane_), DM / 64)) = (unsigned long long)pk2(v[j].x * r2 * gg.x, v[j].y * r2 * gg.y) | ((unsigned long long)pk2(v[j].z * r2 * gg.z, v[j].w * r2 * gg.w) << 32); }
        }
    }
}
__device__ __forceinline__ void naive_dilated_item(const bf16* proj, bf16* MIX, const float* BIAS, int item, int tid) {
    const int b = item >> 9, h = (item >> 5) & 15, qc = item & 31;
    const int s = qc * 128 + (tid >> 2), quarter = tid & 3;
    const GAS v4u* qp = (const GAS v4u*)(proj + (size_t)(b * SEQ + s) * NPROJ + COL_QA + h * HD);
    unsigned q[64];
#pragma unroll
    for (int i = 0; i < 16; ++i) { const v4u t = qp[i]; q[4 * i] = t.x; q[4 * i + 1] = t.y; q[4 * i + 2] = t.z; q[4 * i + 3] = t.w; }
    float m = -1e30f, l = 0.f; float o[32];
#pragma unroll
    for (int i = 0; i < 32; ++i) o[i] = 0.f;
    const float* bt = BIAS + h * 8192 + 4095;
#pragma unroll 1
    for (int br = 0; br < 3; ++br) { const int dil = br == 0 ? 1 : (br == 1 ? 4 : 16);
#pragma unroll 1
        for (int j = -64; j <= 64; ++j) { const int p = s + j * dil; if (p < 0 || p >= SEQ) continue;
            const GAS v4u* kp = (const GAS v4u*)(proj + (size_t)(b * SEQ + p) * NPROJ + COL_KA + h * HD);
            float dot = 0.f;
#pragma unroll
            for (int i = 0; i < 16; ++i) { const v4u kv = kp[i];
                dot += bflo(q[4 * i]) * bflo(kv.x) + bfhi(q[4 * i]) * bfhi(kv.x); dot += bflo(q[4 * i + 1]) * bflo(kv.y) + bfhi(q[4 * i + 1]) * bfhi(kv.y);
                dot += bflo(q[4 * i + 2]) * bflo(kv.z) + bfhi(q[4 * i + 2]) * bfhi(kv.z); dot += bflo(q[4 * i + 3]) * bflo(kv.w) + bfhi(q[4 * i + 3]) * bfhi(kv.w); }
            const float sc = dot + bt[j * dil];
            if (sc > m) { const float a = exp2f(m - sc); l *= a;
#pragma unroll
                for (int i = 0; i < 32; ++i) o[i] *= a;
                m = sc; }
            const float pe = exp2f(sc - m); l += pe;
            const GAS v4u* vp = (const GAS v4u*)(proj + (size_t)(b * SEQ + p) * NPROJ + COL_VA + h * HD + quarter * 32);
#pragma unroll
            for (int i = 0; i < 4; ++i) { const v4u vv = vp[i];
                o[8 * i + 0] += pe * bflo(vv.x); o[8 * i + 1] += pe * bfhi(vv.x); o[8 * i + 2] += pe * bflo(vv.y); o[8 * i + 3] += pe * bfhi(vv.y);
                o[8 * i + 4] += pe * bflo(vv.z); o[8 * i + 5] += pe * bfhi(vv.z); o[8 * i + 6] += pe * bflo(vv.w); o[8 * i + 7] += pe * bfhi(vv.w); }
        } }
    const float inv = 1.f / l;
    GAS v4u* op = (GAS v4u*)(MIX + (size_t)(b * SEQ + s) * DM + h * HD + quarter * 32);
#pragma unroll
    for (int i = 0; i < 4; ++i) { v4u w; w.x = pk2(o[8 * i] * inv, o[8 * i + 1] * inv); w.y = pk2(o[8 * i + 2] * inv, o[8 * i + 3] * inv); w.z = pk2(o[8 * i + 4] * inv, o[8 * i + 5] * inv); w.w = pk2(o[8 * i + 6] * inv, o[8 * i + 7] * inv); op[i] = w; }
}
__device__ __forceinline__ void naive_diff_item(const bf16* proj, bf16* MIX, const float* BIAS, const float* g_subln, float lam, int item, int layer, int tid) {
    const int b = item >> 10, h = (item >> 6) & 15, qc = item & 63;
    const int s = qc * 64 + (tid >> 3), oct = tid & 7;
    const GAS v4u* qp = (const GAS v4u*)(proj + (size_t)(b * SEQ + s) * NPROJ + COL_QD + h * HD);
    unsigned q[64];
#pragma unroll
    for (int i = 0; i < 16; ++i) { const v4u t = qp[i]; q[4 * i] = t.x; q[4 * i + 1] = t.y; q[4 * i + 2] = t.z; q[4 * i + 3] = t.w; }
    float m0 = -1e30f, l0 = 0.f, m1 = -1e30f, l1 = 0.f; float o0[16], o1[16];
#pragma unroll
    for (int i = 0; i < 16; ++i) { o0[i] = 0.f; o1[i] = 0.f; }
    const float* bt = BIAS + (NHA + h) * 8192 + 4095 - s;
    const bf16* kbase = proj + (size_t)(b * SEQ) * NPROJ + COL_KD + h * HD; const bf16* vbase = proj + (size_t)(b * SEQ) * NPROJ + COL_VD + h * HD + oct * 16;
#pragma unroll 1
    for (int p = 0; p < SEQ; ++p) {
        const GAS v4u* kp = (const GAS v4u*)(kbase + (size_t)p * NPROJ);
        float d0 = 0.f, d1 = 0.f;
#pragma unroll
        for (int i = 0; i < 8; ++i) { const v4u kv = kp[i];
            d0 += bflo(q[4 * i]) * bflo(kv.x) + bfhi(q[4 * i]) * bfhi(kv.x); d0 += bflo(q[4 * i + 1]) * bflo(kv.y) + bfhi(q[4 * i + 1]) * bfhi(kv.y);
            d0 += bflo(q[4 * i + 2]) * bflo(kv.z) + bfhi(q[4 * i + 2]) * bfhi(kv.z); d0 += bflo(q[4 * i + 3]) * bflo(kv.w) + bfhi(q[4 * i + 3]) * bfhi(kv.w); }
#pragma unroll
        for (int i = 8; i < 16; ++i) { const v4u kv = kp[i];
            d1 += bflo(q[4 * i]) * bflo(kv.x) + bfhi(q[4 * i]) * bfhi(kv.x); d1 += bflo(q[4 * i + 1]) * bflo(kv.y) + bfhi(q[4 * i + 1]) * bfhi(kv.y);
            d1 += bflo(q[4 * i + 2]) * bflo(kv.z) + bfhi(q[4 * i + 2]) * bfhi(kv.z); d1 += bflo(q[4 * i + 3]) * bflo(kv.w) + bfhi(q[4 * i + 3]) * bfhi(kv.w); }
        const float bias = bt[p]; const float s0 = d0 + bias, s1 = d1 + bias;
        if (s0 > m0) { const float a = exp2f(m0 - s0); l0 *= a;
#pragma unroll
            for (int i = 0; i < 16; ++i) o0[i] *= a;
            m0 = s0; }
        if (s1 > m1) { const float a = exp2f(m1 - s1); l1 *= a;
#pragma unroll
            for (int i = 0; i < 16; ++i) o1[i] *= a;
            m1 = s1; }
        const float p0 = exp2f(s0 - m0), p1 = exp2f(s1 - m1); l0 += p0; l1 += p1;
        const GAS v4u* vp = (const GAS v4u*)(vbase + (size_t)p * NPROJ);
#pragma unroll
        for (int i = 0; i < 2; ++i) { const v4u vv = vp[i]; const float v0 = bflo(vv.x), v1 = bfhi(vv.x), v2 = bflo(vv.y), v3 = bfhi(vv.y), v4 = bflo(vv.z), v5 = bfhi(vv.z), v6 = bflo(vv.w), v7 = bfhi(vv.w);
            o0[8 * i + 0] += p0 * v0; o0[8 * i + 1] += p0 * v1; o0[8 * i + 2] += p0 * v2; o0[8 * i + 3] += p0 * v3; o0[8 * i + 4] += p0 * v4; o0[8 * i + 5] += p0 * v5; o0[8 * i + 6] += p0 * v6; o0[8 * i + 7] += p0 * v7;
            o1[8 * i + 0] += p1 * v0; o1[8 * i + 1] += p1 * v1; o1[8 * i + 2] += p1 * v2; o1[8 * i + 3] += p1 * v3; o1[8 * i + 4] += p1 * v4; o1[8 * i + 5] += p1 * v5; o1[8 * i + 6] += p1 * v6; o1[8 * i + 7] += p1 * v7; }
    }
    const float li = 0.8f - 0.6f * expf(-0.3f * (float)layer);
    const float i0 = 1.f / l0, i1 = lam / l1; float ssq = 0.f;
#pragma unroll
    for (int i = 0; i < 16; ++i) { o0[i] = o0[i] * i0 - o1[i] * i1; ssq += o0[i] * o0[i]; }
    ssq += __shfl_xor(ssq, 1); ssq += __shfl_xor(ssq, 2); ssq += __shfl_xor(ssq, 4);
    const float r = (1.f - li) / sqrtf(ssq * (1.f / HD) + SUBLN_EPS);
    const float* g = g_subln + layer * HD + oct * 16;
    GAS v4u* op = (GAS v4u*)(MIX + (size_t)(b * SEQ + s) * DM + DILW + h * HD + oct * 16);
#pragma unroll
    for (int i = 0; i < 2; ++i) { v4u w; w.x = pk2(o0[8 * i] * r * g[8 * i], o0[8 * i + 1] * r * g[8 * i + 1]); w.y = pk2(o0[8 * i + 2] * r * g[8 * i + 2], o0[8 * i + 3] * r * g[8 * i + 3]);
        w.z = pk2(o0[8 * i + 4] * r * g[8 * i + 4], o0[8 * i + 5] * r * g[8 * i + 5]); w.w = pk2(o0[8 * i + 6] * r * g[8 * i + 6], o0[8 * i + 7] * r * g[8 * i + 7]); op[i] = w; }
}

constexpr int DIL_V_OFF = 0, DIL_T_OFF = 131072;
__device__ __forceinline__ void dilated_phase(Frame& F, unsigned char* ws) {
    const int tid_ = opaque_tid(), lane_ = tid_ & 63;
    bf16* part_o = (bf16*)(ws + WS_U); float* part_ml = (float*)(ws + WS_U + (size_t)M * 16 * 2 * 128 * 2);
    LAS unsigned char* vl = F.lds + DIL_V_OFF + F.wave * 16384; LAS float* tsub = (LAS float*)(F.lds + DIL_T_OFF);
    for (int item = blockIdx.x; item < 256; item += F.G) {
        const int xg = item & 7, jj = item >> 3, bh = 4 * xg + (jj >> 3), b = bh >> 4, h = bh & 15, c = jj & 7, P0 = c * 512;
        __syncthreads();
        for (int i = tid_; i < 576; i += NWAVES * 64) { const int br = i / 192, rel = (i % 192) - 96, d = br == 0 ? 1 : (br == 1 ? 4 : 16);
            tsub[i] = (rel >= -64 && rel <= 64) ? F.BIAS[h * 8192 + 4095 + rel * d] : -1e30f; }
        __syncthreads();
#pragma unroll 1
        for (int k = 0; k < 4; ++k) { const int wi = F.wave + 8 * k, is4 = wi >> 4, sub = wi & 15;
            const int dil = is4 ? 4 : 16, res = is4 ? (sub & 3) : sub, tq0 = is4 ? P0 / 4 + 32 * (sub >> 2) : P0 / 16;
            att::dilated_wave_item<0>(F.PROJ, part_o, part_ml, F.MIX, vl, tsub + (is4 ? 192 : 384), b, h, dil, res, tq0, is4, lane_); }
        asm volatile("s_waitcnt vmcnt(0)" ::: "memory");
        __syncthreads();
#pragma unroll 1
        for (int k = 0; k < 2; ++k) { const int sub = F.wave + 8 * k;
            att::dilated_wave_item<1>(F.PROJ, part_o, part_ml, F.MIX, vl, tsub, b, h, 1, 0, P0 + 32 * sub, 0, lane_); }
        asm volatile("s_waitcnt vmcnt(0)" ::: "memory");
    }
}

#define IN(k) (lo <= (k) && (k) < hi)
#define SEAM(k) do { if (IN(k) && IN((k) + 1)) xcd_barrier(bar); } while (0)
__device__ __forceinline__ unsigned long long uni64(const void* p) { const unsigned long long b = (unsigned long long)(uintptr_t)p;
    return ((unsigned long long)(unsigned)__builtin_amdgcn_readfirstlane((int)(unsigned)(b >> 32)) << 32) | (unsigned)__builtin_amdgcn_readfirstlane((int)(unsigned)b); }
__device__ __forceinline__ void glds16x2(const void* sbase, unsigned voff0, unsigned voff1, unsigned lds_dst) { unsigned keep;
    asm volatile("s_mov_b32 %0, m0\n\ts_mov_b32 m0, %4\n\ts_nop 0\n\tglobal_load_lds_dwordx4 %1, %3\n\ts_add_u32 m0, %4, 0x400\n\ts_nop 0\n\tglobal_load_lds_dwordx4 %2, %3\n\ts_mov_b32 m0, %0"
                 : "=&s"(keep) : "v"(voff0), "v"(voff1), "s"(sbase), "s"(lds_dst) : "memory", "scc"); }
template <int l> struct ConvHook {
    static constexpr int NSEG = (l + 1 < DEPTH ? 9 : 6), LN = (l + 1 < DEPTH ? l + 1 : 0);
    const Frame& F; unsigned stg; int ngi, kph, kphs;
    const char* src; char* dst; unsigned sstep, row4; int cnt, seg, pend;
    unsigned vsrc, vdst;
    __device__ __forceinline__ ConvHook(const Frame& F_, int lane) : F(F_) {
        stg = (unsigned)__builtin_amdgcn_readfirstlane((int)(unsigned)(uintptr_t)(F.lds + CONV_OFF + F.wave * 2048));
        const int g0 = __builtin_amdgcn_readfirstlane((int)blockIdx.x * NWAVES + F.wave), gs = __builtin_amdgcn_readfirstlane(F.G * NWAVES);
        ngi = g0 & 255; kph = g0 >> 8; kphs = gs >> 8; seg = -1; cnt = 0; pend = 0; src = nullptr; dst = nullptr; sstep = 0; row4 = 0; vsrc = 0;
        const int nl = ((ngi * 16) & 127) + (lane & 15), R = (nl & ~31) + pg8::inv_perm32(nl & 31); vdst = (unsigned)pg8::lds_byte(R, 32 * (kph & 1) + 8 * (lane >> 4)); }
    __device__ __forceinline__ void setup(int lane) {
        const float* W; bf16* WT; int stride, K, slab;
        if (seg == 0) { W = F.w_out + (size_t)l * DM * DM; WT = F.Wout_t + (size_t)l * DM * DM; stride = DM; K = DM; slab = 0; }
        else if (seg < 5) { W = F.w_up + (size_t)l * DM * DFF; WT = F.Wup_t + (size_t)l * DFF * DM; stride = DFF; K = DM; slab = seg - 1; }
        else if (seg == 5) { W = F.w_down + (size_t)l * DFF * DM; WT = F.Wdn_t + (size_t)l * DM * DFF; stride = DM; K = DFF; slab = 0; }
        else { W = F.w_in + (size_t)LN * DM * NPROJ; WT = F.Win_t + (size_t)LN * NPROJ * DM; stride = NPROJ; K = DM; slab = seg - 6; }
        const int n0 = slab * 4096 + ngi * 16, nkb = K / 64, nku = K / 32;
        cnt = kph < nku ? (nku - kph + kphs - 1) / kphs : 0;
        src = (const char*)(W + (size_t)(kph * 32) * stride + n0); sstep = (unsigned)(kphs * 32) * (unsigned)stride * 4u; row4 = 16u * (unsigned)stride;
        dst = (char*)(WT + ((size_t)((n0 >> 8) * nkb + (kph >> 1)) * 2 + ((n0 >> 7) & 1)) * 8192);
        vsrc = (unsigned)(((lane >> 2) & 3) * 8 + (lane >> 4)) * (unsigned)(stride * 4) + 16u * (unsigned)(lane & 3);
    }
    __device__ __forceinline__ void pre(int lane) {
        if (pend) { const LAS float* s = (const LAS float*)(uintptr_t)stg + lane;
            v4u o; o.x = pk2(s[0], s[64]); o.y = pk2(s[128], s[192]); o.z = pk2(s[256], s[320]); o.w = pk2(s[384], s[448]);
            if (PROBE_CV == 0 || PROBE_CV == 3) asm volatile("global_store_dwordx4 %0, %1, %2" :: "v"(vdst), "v"(o), "s"(uni64(dst)) : "memory"); else asm volatile("" :: "v"(vdst), "v"(o), "s"(uni64(dst)));
            dst += (size_t)kphs * 16384; pend = 0; } }
    __device__ __forceinline__ void step(int lane) {
        if (cnt == 0 && seg + 1 < NSEG) { ++seg; setup(lane); }
        if (cnt > 0) { if (PROBE_CV != 4) glds16x2((const void*)uni64(src), vsrc, vsrc + row4, stg); else asm volatile("" :: "s"(uni64(src)), "v"(vsrc), "v"(vsrc + row4)); src += sstep; --cnt; pend = 1; }
    }
    __device__ __forceinline__ bool busy() const { return pend || cnt > 0 || seg + 1 < NSEG; }
    __device__ __forceinline__ void flush(int lane) { while (busy()) { asm volatile("s_waitcnt vmcnt(0)" ::: "memory"); pre(lane); step(lane); } asm volatile("s_waitcnt vmcnt(0)" ::: "memory"); }
};

template <int l> __device__ __forceinline__ void layer_phases(Frame& F, const XcdBarrier& bar, const int lo, const int hi) {
        const int pb = 1 + 7 * l;
        if (IN(pb + 0)) {
            pg8::Gemm g{F.H, F.Win_t + (size_t)l * NPROJ * DM, M, NPROJ, DM}; pg8::StaticOrder S; S.init(M, NPROJ, F.G, (int)blockIdx.x);
            pg8::EpiBf16s<0> E{F.PROJ, NPROJ, COL_KA, COL_QD, COL_KD, SC_A, SC_D, 0};
            for (int dup_ = 0; dup_ < DUPN(2); ++dup_) pg8::gemm_phase<pg8::EpiBf16s<0>, pg8::StaticOrder, PG8_ALIGN, PG8_SP2>(F.lds + RING_OFF, g, S, E);
            SEAM(pb + 0);
        }
        if (IN(pb + 1)) {
            for (int dup_ = 0; dup_ < DUPN(3); ++dup_) dilated_phase(F, (unsigned char*)F.Y - WS_Y);
            { const float lam = __uint_as_float(__hip_atomic_load(F.ctl + CW_LAM + l, RLX_AGENT)); const float post = 1.f - (0.8f - 0.6f * expf(-0.3f * (float)l));
              ConvHook<l> hk(F, opaque_tid() & 63); att::NoHook nohk;
              for (int dup_ = 0; dup_ < DUPN(4); ++dup_) for (int u = blockIdx.x; u < 1024; u += F.G) { const int j = u >> 3, bh = (u & 7) * 4 + (j >> 5), qb = j & 31;
                  att::diff_unit<0>(F.PROJ, F.MIX, F.BIAS, F.g_subln + l * HD, lam, post, F.lds, bh >> 4, bh & 15, qb, opaque_tid(), hk); }
              hk.flush(opaque_tid() & 63);
              if (PROBE_GV > 0) for (int u = blockIdx.x; u < 1024; u += F.G) { const int j = u >> 3, bh = (u & 7) * 4 + (j >> 5), qb = j & 31;
                  att::diff_unit<PROBE_GV>(F.PROJ, F.MIX, F.BIAS, F.g_subln + l * HD, lam, post, F.lds, bh >> 4, bh & 15, qb, opaque_tid(), nohk); }
              __syncthreads(); }
            SEAM(pb + 1);
        }
        if (IN(pb + 2)) {
            pg8::Gemm g{F.MIX, F.Wout_t + (size_t)l * DM * DM, M, DM, DM}; pg8::StaticOrder S; S.init(M, DM, F.G, (int)blockIdx.x);
            pg8::EpiBf16Ssq E{F.Y, DM, F.PART, NPART};
            for (int dup_ = 0; dup_ < DUPN(5); ++dup_) pg8::gemm_phase<pg8::EpiBf16Ssq, pg8::StaticOrder, PG8_ALIGN, PG8_SP2>(F.lds + RING_OFF, g, S, E);
            SEAM(pb + 2);
        }
        if (IN(pb + 3)) { bf16* XB = (bf16*)((unsigned char*)F.Y + 64 * MiB);
            if (l == 0) thin_phase<false, true>(F, F.x, XB, F.g_post_mix + l * DM, F.g_pre_mlp + l * DM, true); else thin_phase<true, true>(F, XB, XB, F.g_post_mix + l * DM, F.g_pre_mlp + l * DM, true);
            SEAM(pb + 3); }
        if (IN(pb + 4)) {
            pg8::Gemm g{F.H, F.Wup_t + (size_t)l * DFF * DM, M, DFF, DM}; pg8::StaticOrder S; S.init(M, DFF, F.G, (int)blockIdx.x);
            pg8::EpiBf16s<1> E{F.U, DFF, 0, 0, 0, 1.f, 1.f, DFF / 64};
            for (int dup_ = 0; dup_ < DUPN(6); ++dup_) pg8::gemm_phase<pg8::EpiBf16s<1>, pg8::StaticOrder, PG8_ALIGN, PG8_SP2>(F.lds + RING_OFF, g, S, E);
            if (PROBE_GG > 0) { pg8::EpiBf16s<1> Eg{(bf16*)((unsigned char*)F.Y - WS_Y + WS_END), DFF, 0, 0, 0, 1.f, 1.f};
                if (PROBE_GG == 5) { pg8::Gemm gp = g; gp.lda = DM + 64; gp.ldb = DM + 64; pg8::gemm_phase<pg8::EpiBf16s<1>, pg8::StaticOrder, PG8_ALIGN, PG8_SP2>(F.lds + RING_OFF, gp, S, Eg); }
                else if (PROBE_GG == 1) pg8::gemm_phase<pg8::EpiBf16s<1>, pg8::StaticOrder, PG8_ALIGN, PG8_SP2>(F.lds + RING_OFF, g, S, Eg);
                else { pg8::FixedOrder Sf; Sf.init(M, DFF, F.G, (int)blockIdx.x); Sf.mode = PROBE_GG; pg8::gemm_phase<pg8::EpiBf16s<1>, pg8::FixedOrder, PG8_ALIGN, PG8_SP2>(F.lds + RING_OFF, g, Sf, Eg); } }
            SEAM(pb + 4);
        }
        if (IN(pb + 5)) {
            pg8::Gemm g{F.U, F.Wdn_t + (size_t)l * DM * DFF, M, DM, DFF}; pg8::StaticOrder S; S.init(M, DM, F.G, (int)blockIdx.x);
            pg8::EpiBf16Ssq E{F.Y, DM, F.PART, NPART};
            for (int dup_ = 0; dup_ < DUPN(7); ++dup_) pg8::gemm_phase<pg8::EpiBf16Ssq, pg8::StaticOrder, PG8_ALIGN, PG8_SP2>(F.lds + RING_OFF, g, S, E);
            SEAM(pb + 5);
        }
        if (IN(pb + 6)) { bf16* XB = (bf16*)((unsigned char*)F.Y + 64 * MiB);
            if (l + 1 < DEPTH) thin_phase<true, true>(F, XB, XB, F.g_post_mlp + l * DM, F.g_pre_mix + (l + 1) * DM, true); else thin_phase<true, false>(F, XB, F.out, F.g_post_mlp + l * DM, F.g_post_mlp + l * DM, false);
            SEAM(pb + 6); }
    }
#undef IN
#undef SEAM

struct Args { const float* in[15]; float* out; unsigned char* ws; int ph_lo, ph_hi, pad0, pad1; };
__global__ void __launch_bounds__(NWAVES * 64, 2) mk_fwd(Args args) {
    extern __shared__ __attribute__((aligned(16))) unsigned char lds[];
    Frame F;
    F.lds = (LAS unsigned char*)lds;
    F.MISC = (volatile LAS unsigned*)(F.lds + MISC_OFF);
    F.tid = threadIdx.x; F.lane = F.tid & 63; F.wave = __builtin_amdgcn_readfirstlane(F.tid >> 6);
    F.G = gridDim.x; { const int bx = blockIdx.x; F.vcu = (F.G % 8 == 0) ? (bx % 8) * (F.G / 8) + bx / 8 : bx; }
    unsigned char* ws = args.ws;
    F.ctl = (gu32*)(ws + WS_CTL);
    F.x = args.in[0]; F.rel_bias = args.in[1]; F.g_pre_mix = args.in[2]; F.w_in = args.in[3]; F.lq1 = args.in[4]; F.lk1 = args.in[5]; F.lq2 = args.in[6]; F.lk2 = args.in[7];
    F.g_subln = args.in[8]; F.w_out = args.in[9]; F.g_post_mix = args.in[10]; F.g_pre_mlp = args.in[11]; F.w_up = args.in[12]; F.w_down = args.in[13]; F.g_post_mlp = args.in[14];
    F.out = args.out;
    F.Win_t = (bf16*)(ws + WS_WIN); F.Wout_t = (bf16*)(ws + WS_WOUT); F.Wup_t = (bf16*)(ws + WS_WUP); F.Wdn_t = (bf16*)(ws + WS_WDN);
    F.H = (bf16*)(ws + WS_H); F.PROJ = (bf16*)(ws + WS_PROJ); F.MIX = (bf16*)(ws + WS_MIX); F.U = (bf16*)(ws + WS_U);
    F.Y = (bf16*)(ws + WS_Y); F.PART = (float*)(ws + WS_PART); F.BIAS = (float*)(ws + WS_BIAS);
    for (int u = F.tid; u < (LDS_BYTES - LDSCTL_OFF) / 4; u += NWAVES * 64) ((LAS unsigned*)(F.lds + LDSCTL_OFF))[u] = 0u;
    __syncthreads();
    XcdBarrier bar; bar.bar = (unsigned*)(F.ctl + CW_BAR); bar.x = 0; bar.st = nullptr;
    const bool one = (args.ph_hi - args.ph_lo) > 1;
    if (one) bar = xcd_barrier_post((unsigned*)(F.ctl + CW_BAR), F.MISC + 8);
    const int lo = args.ph_lo, hi = args.ph_hi;
#define IN(k) (lo <= (k) && (k) < hi)
#define SEAM(k) do { if (IN(k) && IN((k) + 1)) xcd_barrier(bar); } while (0)

    if (PROBE_CLK > 0 && IN(0)) {
        const int w_ = F.wave;
        if (PROBE_CLK != 9 || w_ < 4) {
            if (PROBE_CLK == 8 && w_ >= 4) __builtin_amdgcn_s_setprio(1);
            att::f32x16 a0 = {}, a1 = {}, a2 = {}, a3 = {}; att::bf16x8 x = {0x3f80, 0x4000, 0x3fc0, 0x4040, 0x3f80, 0x4000, 0x3fc0, 0x4040}, y = {0x3f80, 0x3f00, 0x3e80, 0x3f80, 0x3f80, 0x3f00, 0x3e80, 0x3f80}; asm volatile("" : "+v"(x), "+v"(y));
            float v0 = (float)threadIdx.x, v1 = v0 + 1.f, v2 = v0 + 2.f, v3 = v0 + 3.f, v4 = v0 + 4.f, v5 = v0 + 5.f; const float c = 0.999f;
#define PC_V6() do { v0 = fmaf(v0, c, 0.5f); v1 = fmaf(v1, c, 0.5f); v2 = fmaf(v2, c, 0.5f); if (PROBE_CLK != 7) { v3 = fmaf(v3, c, 0.5f); v4 = fmaf(v4, c, 0.5f); v5 = fmaf(v5, c, 0.5f); } } while (0)
#pragma unroll 1
            for (int i = 0; i < 6250; ++i) {
                a0 = __builtin_amdgcn_mfma_f32_32x32x16_bf16(x, y, a0, 0, 0, 0); PC_V6(); __builtin_amdgcn_sched_barrier(0);
                a1 = __builtin_amdgcn_mfma_f32_32x32x16_bf16(x, y, a1, 0, 0, 0); PC_V6(); __builtin_amdgcn_sched_barrier(0);
                a2 = __builtin_amdgcn_mfma_f32_32x32x16_bf16(x, y, a2, 0, 0, 0); PC_V6(); __builtin_amdgcn_sched_barrier(0);
                a3 = __builtin_amdgcn_mfma_f32_32x32x16_bf16(x, y, a3, 0, 0, 0); PC_V6(); __builtin_amdgcn_sched_barrier(0); }
#undef PC_V6
            if (a0[0] + a1[1] + a2[2] + a3[3] + v0 + v1 + v2 + v3 + v4 + v5 == -1.2345f) F.out[threadIdx.x] = 0.f;
            if (PROBE_CLK == 8 && w_ >= 4) __builtin_amdgcn_s_setprio(0); }
        __syncthreads(); }
    if (IN(0)) { for (int dup_ = 0; dup_ < DUPN(1); ++dup_) p0_prologue(F); SEAM(0); for (int eb_ = 0; eb_ < PROBE_BAR; ++eb_) xcd_barrier(bar); }

    layer_phases<0>(F, bar, lo, hi);
    layer_phases<1>(F, bar, lo, hi);
#undef IN
#undef SEAM
}

extern "C" void kernel_launch(void* const* d_in, const int* in_sizes, int n_in, void* d_out, int out_size, void* d_ws, size_t ws_size, hipStream_t stream) {
    static int grid = 0;
    if (grid == 0) {
        if (n_in != 15 || in_sizes[0] != M * DM || out_size != M * DM || ws_size < WS_END) { fprintf(stderr, "kernel_launch: shape mismatch (n_in %d, in0 %d, out %d, ws %zu < %zu); nothing launched\n", n_in, n_in > 0 ? in_sizes[0] : -1, out_size, ws_size, (size_t)WS_END); grid = -1; return; }
        int dev = 0, cus = 0, per_cu = 0;
        if (hipGetDevice(&dev) != hipSuccess || hipDeviceGetAttribute(&cus, hipDeviceAttributeMultiprocessorCount, dev) != hipSuccess) { grid = -1; return; }
        if (hipFuncSetAttribute((const void*)mk_fwd, hipFuncAttributeMaxDynamicSharedMemorySize, LDS_BYTES) != hipSuccess) { fprintf(stderr, "kernel_launch: hipFuncSetAttribute failed\n"); grid = -1; return; }
        if (hipOccupancyMaxActiveBlocksPerMultiprocessor(&per_cu, (const void*)mk_fwd, NWAVES * 64, LDS_BYTES) != hipSuccess || per_cu < 1)
            fprintf(stderr, "kernel_launch: note: occupancy query reports %d workgroups per CU\n", per_cu);
        (void)hipGetLastError();
        grid = cus;
    }
    if (grid < 0) return;
    if (hipMemsetAsync((char*)d_ws + WS_CTL, 0, CTL_ZERO_BYTES, stream) != hipSuccess) { fprintf(stderr, "kernel_launch: memset failed\n"); return; }
    Args a{};
    for (int i = 0; i < 15; ++i) a.in[i] = (const float*)d_in[i];
    a.out = (float*)d_out; a.ws = (unsigned char*)d_ws; a.pad0 = 0; a.pad1 = 0;
#if MK_ONE_LAUNCH
    a.ph_lo = 0; a.ph_hi = N_PHASES;
    hipLaunchKernelGGL(mk_fwd, dim3(grid), dim3(NWAVES * 64), LDS_BYTES, stream, a);
#else
    for (int p = 0; p < N_PHASES; ++p) {
        a.ph_lo = p; a.ph_hi = p + 1; hipLaunchKernelGGL(mk_fwd, dim3(grid), dim3(NWAVES * 64), LDS_BYTES, stream, a); }
#endif
    const hipError_t le = hipPeekAtLastError();
    if (le != hipSuccess) fprintf(stderr, "kernel_launch: launch failed: %s\n", hipGetErrorName(le));
}
```
